# Optimizing an MI355X kernel written in HIP

```python
import math
import jax, jax.numpy as jnp
from jax import lax
import numpy as np

D_MODEL = 1024
BATCH = 2
SEQ = 8192
DEPTH = 4
DEC_BATCH = 1
DEC_SEQ = 16384
PAST_LEN = 128

N_EVEN = (DEPTH + 1) // 2
N_ODD = DEPTH // 2
POOL_WIDTH = D_MODEL // 2
N_POOL_GROUPS = 4
POOL_GROUP_DIM = POOL_WIDTH // N_POOL_GROUPS
POOL_WINDOWS = (2, 4, 8, 16)
CONV_WIDTH_CH = D_MODEL // 2
CONV_K = 3
MIX_IN_COLS = POOL_WIDTH + 3 * CONV_WIDTH_CH
MIX_OUT_IN = POOL_WIDTH + CONV_WIDTH_CH
N_HEADS = 8
HEAD_DIM = D_MODEL // (2 * N_HEADS)
D_ATTN = 2 * N_HEADS * HEAD_DIM
ATTN_SCALE = HEAD_DIM ** -0.5
Q_BLOCK = 128
D_FF = 4 * D_MODEL
NORM_EPS = 1e-6

kernel_name = "hybrid_pool_shortconv_diffattn_encoder"


def rms_norm(x, g, eps=NORM_EPS):
    xf = x.astype(jnp.float32)
    y = xf * lax.rsqrt(jnp.mean(xf * xf, axis=-1, keepdims=True) + eps)
    return (y * g.astype(jnp.float32)).astype(x.dtype)


def centred_mean(u, w):
    S = u.shape[1]
    cs = jnp.cumsum(u.astype(jnp.float32), axis=1)
    cs = jnp.pad(cs, ((0, 0), (1, 0), (0, 0)))
    t = jnp.arange(S)
    lo = jnp.clip(t - w // 2, 0, S)
    hi = jnp.clip(t + w // 2, 0, S)
    total = cs[:, hi] - cs[:, lo]
    cnt = (hi - lo).astype(jnp.float32)
    return (total / cnt[None, :, None]).astype(u.dtype)


def pool_mixer(u, pool_w, pool_scale):
    B_, S, _ = u.shape
    ug = u.reshape(B_, S, N_POOL_GROUPS, POOL_GROUP_DIM)
    diffs = [centred_mean(ug[:, :, g], w) - ug[:, :, g] for g, w in enumerate(POOL_WINDOWS)]
    d = jnp.stack(diffs, axis=2)
    y = jnp.einsum('bsgc,gcd->bsgd', d, pool_w)
    return y.reshape(B_, S, POOL_WIDTH) * pool_scale


def short_conv_mixer(h, gate_b, gate_c, conv_w):
    z = gate_c * h
    zp = jnp.pad(z, ((0, 0), (1, 1), (0, 0)))
    conv = conv_w[0] * zp[:, :-2] + conv_w[1] * zp[:, 1:-1] + conv_w[2] * zp[:, 2:]
    return gate_b * conv


def even_mixer(h, mix_in_w, pool_w, pool_scale, conv_w, mix_out_w):
    proj = h @ mix_in_w
    u_pool = proj[..., :POOL_WIDTH]
    c0 = POOL_WIDTH
    h_conv = proj[..., c0:c0 + CONV_WIDTH_CH]
    g_b = proj[..., c0 + CONV_WIDTH_CH:c0 + 2 * CONV_WIDTH_CH]
    g_c = proj[..., c0 + 2 * CONV_WIDTH_CH:]
    a_out = pool_mixer(u_pool, pool_w, pool_scale)
    b_out = short_conv_mixer(h_conv, g_b, g_c, conv_w)
    return jnp.concatenate([a_out, b_out], axis=-1) @ mix_out_w


def diff_attention(h, qkv_w, out_w, lq1, lk1, lq2, lk2, subln_g, lambda_init):
    B_, S, _ = h.shape
    qkv = h @ qkv_w
    q, k, v = jnp.split(qkv, 3, axis=-1)
    q = q.reshape(B_, S, 2 * N_HEADS, HEAD_DIM)
    k = k.reshape(B_, S, 2 * N_HEADS, HEAD_DIM)
    v = v.reshape(B_, S, N_HEADS, 2 * HEAD_DIM)
    f32 = jnp.float32
    lam = (jnp.exp(jnp.sum(lq1.astype(f32) * lk1.astype(f32)))
           - jnp.exp(jnp.sum(lq2.astype(f32) * lk2.astype(f32))) + lambda_init)
    head_slopes = jnp.exp2(-8.0 * (jnp.arange(N_HEADS, dtype=f32) + 1.0) / N_HEADS)
    map_slopes = jnp.repeat(head_slopes, 2)
    nb = S // Q_BLOCK
    qb = q.reshape(B_, nb, Q_BLOCK, 2 * N_HEADS, HEAD_DIM).transpose(1, 0, 2, 3, 4)
    starts = jnp.arange(nb) * Q_BLOCK
    key_pos = jnp.arange(S)

    def block(args):
        qblk, t0 = args
        s = jnp.einsum('bqmd,bkmd->bmqk', qblk, k, preferred_element_type=f32) * ATTN_SCALE
        dist = jnp.abs((t0 + jnp.arange(Q_BLOCK))[:, None] - key_pos[None, :]).astype(f32)
        p = jax.nn.softmax(s - map_slopes[:, None, None] * dist, axis=-1)
        p = p.reshape(B_, N_HEADS, 2, Q_BLOCK, S)
        a = p[:, :, 0] - lam * p[:, :, 1]
        return jnp.einsum('bhqk,bkhe->bqhe', a.astype(v.dtype), v)

    o = lax.map(block, (qb, starts))
    o = o.transpose(1, 0, 2, 3, 4).reshape(B_, S, N_HEADS, 2 * HEAD_DIM)
    o = rms_norm(o, subln_g, eps=1e-5) * (1.0 - lambda_init)
    return o.reshape(B_, S, D_ATTN) @ out_w


def sq_relu_mlp(h, w1, w2):
    a = jax.nn.relu(h @ w1)
    return (a * a) @ w2


def setup_inputs(seed: int = 0) -> dict:
    key = jax.random.key(seed)
    ks = jax.random.split(key, 20)
    n = jax.random.normal
    f32 = jnp.float32
    return {
        "x_prompt": n(ks[0], (BATCH, SEQ, D_MODEL), f32),
        "x_sample": n(ks[1], (DEC_BATCH, DEC_SEQ, D_MODEL), f32),
        "norm1_g": 1.0 + 0.02 * n(ks[2], (DEPTH, D_MODEL), f32),
        "norm2_g": 1.0 + 0.02 * n(ks[3], (DEPTH, D_MODEL), f32),
        "final_g": 1.0 + 0.02 * n(ks[4], (D_MODEL,), f32),
        "mix_in_w": n(ks[5], (N_EVEN, D_MODEL, MIX_IN_COLS), f32) * D_MODEL ** -0.5,
        "pool_w": n(ks[6], (N_EVEN, N_POOL_GROUPS, POOL_GROUP_DIM, POOL_GROUP_DIM), f32) * POOL_GROUP_DIM ** -0.5,
        "pool_scale": 1.0 + 0.1 * n(ks[7], (N_EVEN, POOL_WIDTH), f32),
        "conv_w": n(ks[8], (N_EVEN, CONV_K, CONV_WIDTH_CH), f32) * CONV_K ** -0.5,
        "mix_out_w": n(ks[9], (N_EVEN, MIX_OUT_IN, D_MODEL), f32) * MIX_OUT_IN ** -0.5,
        "attn_qkv_w": n(ks[10], (N_ODD, D_MODEL, 3 * D_ATTN), f32) * D_MODEL ** -0.5,
        "attn_out_w": n(ks[11], (N_ODD, D_ATTN, D_MODEL), f32) * D_ATTN ** -0.5,
        "lambda_q1": 0.1 * n(ks[12], (N_ODD, HEAD_DIM), f32),
        "lambda_k1": 0.1 * n(ks[13], (N_ODD, HEAD_DIM), f32),
        "lambda_q2": 0.1 * n(ks[14], (N_ODD, HEAD_DIM), f32),
        "lambda_k2": 0.1 * n(ks[15], (N_ODD, HEAD_DIM), f32),
        "subln_g": 1.0 + 0.02 * n(ks[16], (N_ODD, 2 * HEAD_DIM), f32),
        "mlp_w1": n(ks[17], (DEPTH, D_MODEL, D_FF), f32) * D_MODEL ** -0.5,
        "mlp_w2": n(ks[18], (DEPTH, D_FF, D_MODEL), f32) * D_FF ** -0.5,
    }


def trunk(x, norm1_g, norm2_g, final_g, mix_in_w, pool_w, pool_scale, conv_w, mix_out_w,
          attn_qkv_w, attn_out_w, lambda_q1, lambda_k1, lambda_q2, lambda_k2, subln_g,
          mlp_w1, mlp_w2):
    for i in range(DEPTH):
        h = rms_norm(x, norm1_g[i])
        j = i // 2
        if i % 2 == 0:
            x = x + even_mixer(h, mix_in_w[j], pool_w[j], pool_scale[j], conv_w[j], mix_out_w[j])
        else:
            lambda_init = 0.8 - 0.6 * math.exp(-0.3 * i)
            x = x + diff_attention(h, attn_qkv_w[j], attn_out_w[j], lambda_q1[j], lambda_k1[j],
                                   lambda_q2[j], lambda_k2[j], subln_g[j], lambda_init)
        x = x + sq_relu_mlp(rms_norm(x, norm2_g[i]), mlp_w1[i], mlp_w2[i])
    return rms_norm(x, final_g)


def reference(x_prompt, x_sample, norm1_g, norm2_g, final_g, mix_in_w, pool_w, pool_scale,
              conv_w, mix_out_w, attn_qkv_w, attn_out_w, lambda_q1, lambda_k1, lambda_q2,
              lambda_k2, subln_g, mlp_w1, mlp_w2):
    y_prompt = trunk(x_prompt, norm1_g, norm2_g, final_g, mix_in_w, pool_w, pool_scale, conv_w,
                     mix_out_w, attn_qkv_w, attn_out_w, lambda_q1, lambda_k1, lambda_q2,
                     lambda_k2, subln_g, mlp_w1, mlp_w2)
    y_sample = trunk(x_sample, norm1_g, norm2_g, final_g, mix_in_w, pool_w, pool_scale, conv_w,
                     mix_out_w, attn_qkv_w, attn_out_w, lambda_q1, lambda_k1, lambda_q2,
                     lambda_k2, subln_g, mlp_w1, mlp_w2)
    return (y_prompt, y_sample)
```

```cpp
#include <hip/hip_runtime.h>
#include <hip/hip_cooperative_groups.h>
#include <cstdio>
#include <cstdint>
namespace cg = cooperative_groups;

#ifndef MK_WINDOW
#define MK_WINDOW 1
#endif
#ifndef MK_PER_PHASE
#define MK_PER_PHASE 0
#endif

__device__ __forceinline__ int mk_tid() { int t = threadIdx.x; asm volatile("" : "+v"(t)); return t; }

template <int M> __device__ __forceinline__ float xor_lt32(float v) { return __int_as_float(__builtin_amdgcn_ds_swizzle(__float_as_int(v), (M << 10) | 0x1f)); }
__device__ __forceinline__ float sum_x32(float v) { auto rr = __builtin_amdgcn_permlane32_swap(__float_as_uint(v), __float_as_uint(v), false, false); return __uint_as_float(rr[0]) + __uint_as_float(rr[1]); }

namespace pg8 {
#define PG8_LAS __attribute__((address_space(3)))
typedef unsigned short bf16_t;
typedef short bf16x8 __attribute__((ext_vector_type(8)));
typedef float f32x4 __attribute__((ext_vector_type(4)));
typedef unsigned u32x4 __attribute__((ext_vector_type(4)));
constexpr int BM = 256, BK = 64, HALF = 128, HTB = HALF * BK * 2  , STAGE_BYTES = 8 * HTB, NXCD = 8, WGM = 8;

__host__ __device__ __forceinline__ int lds_byte(int r, int c) { const int st = (r >> 4) * 2 + (c >> 5), rr = r & 15, cc = c & 31, ob = rr * 64 + cc * 2; return st * 1024 + (ob ^ (((ob >> 9) & 1) << 5)); }
__host__ __device__ __forceinline__ void stage_rc(int b, int& R, int& C) { const int st = b / 1024, sb = b % 1024, swz = sb ^ (((sb >> 9) & 1) << 5); R = (st >> 1) * 16 + swz / 64; C = (st & 1) * 32 + (swz % 64) / 2; }
__host__ __device__ __forceinline__ int perm32(int rho) { const int n = rho >> 4, i = rho & 15; return 8 * (i >> 2) + 4 * n + (i & 3); }

struct Unit { int pm, pn; };
struct Gemm { const bf16_t* A; const bf16_t* Bt; int M, N, K; };

struct StaticOrder {
    int nM, nN, nwg, G, c;
    __host__ __device__ void init(int M, int N, int G_, int c_) { nM = M / BM; nN = N / BM; nwg = nM * nN; G = G_; c = c_; }
    __host__ __device__ bool next(int i, Unit& u) const {
        const long L = (long)i * G + c; if (L >= nwg) return false;
        int wgid = (int)L; { const int q = nwg / NXCD, r = nwg % NXCD, xcd = wgid % NXCD, off = wgid / NXCD; wgid = (xcd < r ? xcd * (q + 1) : r * (q + 1) + (xcd - r) * q) + off; }
        const int nig = WGM * nN, gid = wgid / nig, fm = gid * WGM, gsz = (nM - fm) < WGM ? (nM - fm) : WGM;
        u.pm = fm + ((wgid % nig) % gsz); u.pn = (wgid % nig) / gsz; return true;
    }
    __device__ __forceinline__ void a_ready(const Unit&) const {}
    __device__ __forceinline__ void done(const Unit&) const {}
};

__device__ __forceinline__ unsigned cvt_pk_bf16(float lo, float hi) { unsigned r; asm volatile("v_cvt_pk_bf16_f32 %0, %1, %2" : "=v"(r) : "v"(lo), "v"(hi)); return r; }
typedef float f32x2 __attribute__((ext_vector_type(2)));
template <int MODE> struct EpiProj {
    static constexpr bool PERM = true, AFTER_DRAIN = false;
    bf16_t* O; int ldc; const float* rowsq; size_t split_stride; float scale0; unsigned* nrm; int logS;
    __device__ __forceinline__ void operator()(const f32x4 (&acc)[2][2][4][2], const Unit& u, int wr, int wc, int fr, int fq) const {
        const int row0 = u.pm * BM + wr * 64 + fr; int colt = u.pn * BM; bf16_t* base = O; float sc = 1.f; int t = 0;
        if (MODE == 1) { t = colt >> 10; base += (size_t)t * split_stride; colt &= 1023; if (t == 0) sc = scale0; }
        const int col0 = colt + wc * 32 + 8 * fq;
        float nmx[2] = {0.f, 0.f};
#pragma unroll
        for (int ai = 0; ai < 2; ++ai)
#pragma unroll
            for (int m = 0; m < 4; ++m) {
                const int row = row0 + ai * HALF + m * 16;
                float rsum;
                { const f32x4* rp = (const f32x4*)(rowsq + (size_t)row * 16); const f32x4 a0 = rp[0], a1 = rp[1], a2 = rp[2], a3 = rp[3];
                  rsum = (((a0[0] + a0[1]) + (a0[2] + a0[3])) + ((a1[0] + a1[1]) + (a1[2] + a1[3]))) + (((a2[0] + a2[1]) + (a2[2] + a2[3])) + ((a3[0] + a3[1]) + (a3[2] + a3[3]))); }
                const float rs = __builtin_amdgcn_rsqf(rsum * (1.0f / 1024.0f) + 1e-6f) * sc;
                bf16_t* rowp = base + (size_t)row * ldc + col0;
#pragma unroll
                for (int bj = 0; bj < 2; ++bj) {
                    f32x4 v0 = acc[ai][bj][m][0] * rs, v1 = acc[ai][bj][m][1] * rs;
                    if (MODE == 2) {
#pragma unroll
                        for (int e = 0; e < 4; ++e) { const float a = fmaxf(v0[e], 0.f), b = fmaxf(v1[e], 0.f); v0[e] = a * a; v1[e] = b * b; }
                    }
                    if (MODE == 1) {
                        float s = (v0[0] * v0[0] + v0[1] * v0[1]) + (v0[2] * v0[2] + v0[3] * v0[3]) + (v1[0] * v1[0] + v1[1] * v1[1]) + (v1[2] * v1[2] + v1[3] * v1[3]);
                        s += xor_lt32<16>(s); s = sum_x32(s);
                        nmx[bj] = fmaxf(nmx[bj], s);
                    }
                    u32x4 w; w.x = cvt_pk_bf16(v0[0], v0[1]); w.y = cvt_pk_bf16(v0[2], v0[3]); w.z = cvt_pk_bf16(v1[0], v1[1]); w.w = cvt_pk_bf16(v1[2], v1[3]);
                    *(u32x4*)(rowp + bj * HALF) = w;
                }
            }
        if (MODE == 1) {
            if (t < 2) {
                const int b = (u.pm * BM) >> logS;
#pragma unroll
                for (int bj = 0; bj < 2; ++bj) {
                    float v = nmx[bj];
                    v = fmaxf(v, xor_lt32<1>(v)); v = fmaxf(v, xor_lt32<2>(v)); v = fmaxf(v, xor_lt32<4>(v)); v = fmaxf(v, xor_lt32<8>(v));
                    const int map = (colt >> 6) + 2 * bj + (wc >> 1), half = wc & 1;
                    if (fr == 0 && fq == 0) atomicMax(nrm + (((t * 2 + b) * 16 + map) * 2 + half), __float_as_uint(v));
                }
            }
        }
    }
};
struct EpiRes {
    static constexpr bool PERM = false, AFTER_DRAIN = false;
    float* x; bf16_t* xb; float* rowsq;
    __device__ __forceinline__ void operator()(const f32x4 (&acc)[2][2][4][2], const Unit& u, int wr, int wc, int fr, int fq) const {
        typedef unsigned u32x2v __attribute__((ext_vector_type(2)));
        const int col0 = u.pn * BM + wc * 32 + 4 * fq;
#pragma unroll
        for (int ai = 0; ai < 2; ++ai)
#pragma unroll
            for (int m = 0; m < 4; ++m) {
                const int row = u.pm * BM + ai * HALF + wr * 64 + m * 16 + fr; const size_t off = (size_t)row * 1024 + col0;
                float ss = 0.f;
#pragma unroll
                for (int bj = 0; bj < 2; ++bj)
#pragma unroll
                    for (int n = 0; n < 2; ++n) {
                        const f32x4 xo = *(const f32x4*)(x + off + bj * HALF + n * 16);
                        const f32x4 xn = xo + acc[ai][bj][m][n];
                        *(f32x4*)(x + off + bj * HALF + n * 16) = xn;
                        ss += (xn[0] * xn[0] + xn[1] * xn[1]) + (xn[2] * xn[2] + xn[3] * xn[3]);
                        u32x2v w; w.x = cvt_pk_bf16(xn[0], xn[1]); w.y = cvt_pk_bf16(xn[2], xn[3]);
                        *(u32x2v*)(xb + off + bj * HALF + n * 16) = w;
                    }
                ss += xor_lt32<16>(ss); ss = sum_x32(ss);
                if (fq == 0) rowsq[(size_t)row * 16 + u.pn * 4 + wc] = ss;
            }
    }
};

template <class Epi, class Sched, bool ALIGN_EPI = false, bool SP2 = false>
__device__ __forceinline__ void gemm_phase(PG8_LAS unsigned char* lds, const Gemm g, const Sched& S, const Epi& E) {
    const int tid = mk_tid(), wid = __builtin_amdgcn_readfirstlane(tid >> 6), lane = tid & 63, wr = wid >> 2, wc = wid & 3, fr = lane & 15, fq = lane >> 4;
    const int K = g.K, nt = K / BK;
    unsigned voffA[2], voffB[2];
#pragma unroll
    for (int i = 0; i < 2; ++i) { int R, C; stage_rc(tid * 16 + i * 8192, R, C); const int Rb = Epi::PERM ? ((R & ~31) + perm32(R & 31)) : R;
        voffA[i] = (unsigned)(R * K + C) * 2u; voffB[i] = (unsigned)(Rb * K + C) * 2u; }
    const size_t kstep = (size_t)(BK * 2);
    const size_t hstep = (size_t)HALF * K * 2;
    const size_t tstep = 2 * hstep;
    const unsigned ldsw = (unsigned)wid * 1024u;
    const int aoff = lds_byte(wr * 64 + fr, fq * 8), boff = lds_byte(wc * 32 + fr, fq * 8);
#define PG8_SA(b, h) (((b) * 2 + (h)) * HTB)
#define PG8_SB(b, h) ((4 + (b) * 2 + (h)) * HTB)
#define PG8_STAGE(bufoff, gbase, voff) do { _Pragma("unroll") for (int _i = 0; _i < 2; ++_i) \
        __builtin_amdgcn_global_load_lds((const unsigned*)((const char*)(gbase) + (voff)[_i]), (PG8_LAS unsigned*)(lds + (bufoff) + ldsw + _i * 8192), 16, 0, 0); } while (0)
#define PG8_LDA(dst, b, h) do { _Pragma("unroll") for (int m = 0; m < 4; ++m) _Pragma("unroll") for (int k = 0; k < 2; ++k) dst[m][k] = *(const PG8_LAS bf16x8*)(lds + PG8_SA(b, h) + aoff + m * 2048 + k * 1024); } while (0)
#define PG8_LDB(dst, b, h) do { _Pragma("unroll") for (int n = 0; n < 2; ++n) _Pragma("unroll") for (int k = 0; k < 2; ++k) dst[n][k] = *(const PG8_LAS bf16x8*)(lds + PG8_SB(b, h) + boff + n * 2048 + k * 1024); } while (0)
#define PG8_MMA(ai, bj, At, Bt) do { __builtin_amdgcn_s_setprio(1); _Pragma("unroll") for (int m = 0; m < 4; ++m) _Pragma("unroll") for (int n = 0; n < 2; ++n) _Pragma("unroll") for (int k = 0; k < 2; ++k) \
        acc[ai][bj][m][n] = __builtin_amdgcn_mfma_f32_16x16x32_bf16(Bt[n][k], At[m][k], acc[ai][bj][m][n], 0, 0, 0); __builtin_amdgcn_s_setprio(0); } while (0)
#define PG8_WAIT_V(n) asm volatile("s_waitcnt vmcnt(" #n ")" ::: "memory")
#define PG8_WAIT_L(n) asm volatile("s_waitcnt lgkmcnt(" #n ")" ::: "memory")
#define PG8_BAR __builtin_amdgcn_s_barrier()
#define PG8_SCHED __builtin_amdgcn_sched_barrier(0)
    Unit cur, nxt; int ui = 0;
    if (!S.next(0, cur)) return;
    f32x4 acc[2][2][4][2];
#pragma unroll
    for (int a = 0; a < 2; ++a)
#pragma unroll
        for (int b = 0; b < 2; ++b)
#pragma unroll
            for (int m = 0; m < 4; ++m)
#pragma unroll
                for (int n = 0; n < 2; ++n) acc[a][b][m][n] = (f32x4){0.f, 0.f, 0.f, 0.f};
    bf16x8 At[4][2], B0[2][2], B1[2][2];
    const char* cA = (const char*)g.A + (size_t)cur.pm * tstep; const char* cB = (const char*)g.Bt + (size_t)cur.pn * tstep;
    S.a_ready(cur);
    if constexpr (SP2) {
        PG8_STAGE(PG8_SB(0, 0), cB, voffB); PG8_STAGE(PG8_SB(0, 1), cB + hstep, voffB); PG8_STAGE(PG8_SA(0, 0), cA, voffA); PG8_STAGE(PG8_SA(0, 1), cA + hstep, voffA);
        if (wr == 1) PG8_BAR;
        PG8_WAIT_V(2); PG8_BAR;
        PG8_STAGE(PG8_SB(1, 0), cB + kstep, voffB); PG8_STAGE(PG8_SA(1, 0), cA + kstep, voffA); PG8_STAGE(PG8_SB(1, 1), cB + hstep + kstep, voffB);
        PG8_WAIT_V(6); PG8_BAR;
    } else {
        PG8_STAGE(PG8_SB(0, 0), cB, voffB); PG8_STAGE(PG8_SA(0, 0), cA, voffA); PG8_STAGE(PG8_SB(0, 1), cB + hstep, voffB); PG8_STAGE(PG8_SA(0, 1), cA + hstep, voffA);
        if (wr == 1) PG8_BAR;
        PG8_WAIT_V(4); PG8_BAR;
        PG8_STAGE(PG8_SB(1, 0), cB + kstep, voffB); PG8_STAGE(PG8_SA(1, 0), cA + kstep, voffA); PG8_STAGE(PG8_SB(1, 1), cB + hstep + kstep, voffB);
        PG8_WAIT_V(6); PG8_BAR;
    }
    for (;;) {
        const bool has_next = S.next(ui + 1, nxt);
        const char* nA = has_next ? (const char*)g.A + (size_t)nxt.pm * tstep : cA; const char* nB = has_next ? (const char*)g.Bt + (size_t)nxt.pn * tstep : cB;
        for (int t = 0; t < nt; t += 2) {
            const bool last = (t == nt - 2);
            const char* a1 = cA + (size_t)(t + 1) * kstep;
            const char* a2 = last ? nA : cA + (size_t)(t + 2) * kstep; const char* b2 = last ? nB : cB + (size_t)(t + 2) * kstep;
            const char* a3 = a2 + kstep; const char* b3 = b2 + kstep;
            if (last && has_next) S.a_ready(nxt);
            if constexpr (SP2) {
            PG8_LDB(B0, 0, 0); PG8_LDB(B1, 0, 1); PG8_SCHED; PG8_LDA(At, 0, 0); PG8_STAGE(PG8_SA(1, 1), a1 + hstep, voffA);
            PG8_WAIT_V(8); PG8_WAIT_L(0); PG8_BAR; PG8_MMA(0, 0, At, B0); PG8_MMA(0, 1, At, B1); PG8_BAR; PG8_SCHED;
            PG8_LDA(At, 0, 1); PG8_STAGE(PG8_SB(0, 0), b2, voffB); PG8_STAGE(PG8_SB(0, 1), b2 + hstep, voffB); PG8_STAGE(PG8_SA(0, 0), a2, voffA);
            PG8_WAIT_V(8); PG8_WAIT_L(0); PG8_BAR; PG8_MMA(1, 0, At, B0); PG8_MMA(1, 1, At, B1); PG8_BAR; PG8_SCHED;
            PG8_LDB(B0, 1, 0); PG8_LDB(B1, 1, 1); PG8_SCHED; PG8_LDA(At, 1, 0); PG8_STAGE(PG8_SA(0, 1), a2 + hstep, voffA);
            PG8_WAIT_V(8); PG8_WAIT_L(0); PG8_BAR; PG8_MMA(0, 0, At, B0); PG8_MMA(0, 1, At, B1); PG8_BAR; PG8_SCHED;
            PG8_LDA(At, 1, 1); PG8_STAGE(PG8_SB(1, 0), b3, voffB); PG8_STAGE(PG8_SB(1, 1), b3 + hstep, voffB); PG8_STAGE(PG8_SA(1, 0), a3, voffA);
            PG8_WAIT_V(8); PG8_WAIT_L(0); PG8_BAR; PG8_MMA(1, 0, At, B0); PG8_MMA(1, 1, At, B1); PG8_BAR; PG8_SCHED;
            } else {
            PG8_LDB(B0, 0, 0); PG8_SCHED; PG8_LDA(At, 0, 0); PG8_STAGE(PG8_SA(1, 1), a1 + hstep, voffA);
            PG8_WAIT_L(8); PG8_BAR; PG8_WAIT_L(0); PG8_MMA(0, 0, At, B0); PG8_BAR; PG8_SCHED;
            PG8_LDB(B1, 0, 1); PG8_STAGE(PG8_SB(0, 0), b2, voffB);
            PG8_BAR; PG8_WAIT_L(0); PG8_MMA(0, 1, At, B1); PG8_BAR;
            PG8_LDA(At, 0, 1); PG8_STAGE(PG8_SA(0, 0), a2, voffA);
            PG8_BAR; PG8_WAIT_L(0); PG8_MMA(1, 0, At, B0); PG8_BAR; PG8_SCHED;
            PG8_STAGE(PG8_SB(0, 1), b2 + hstep, voffB);
            PG8_WAIT_V(6); PG8_BAR; PG8_MMA(1, 1, At, B1); PG8_BAR;
            PG8_LDB(B0, 1, 0); PG8_SCHED; PG8_LDA(At, 1, 0); PG8_STAGE(PG8_SA(0, 1), a2 + hstep, voffA);
            PG8_WAIT_L(8); PG8_BAR; PG8_WAIT_L(0); PG8_MMA(0, 0, At, B0); PG8_BAR; PG8_SCHED;
            PG8_LDB(B1, 1, 1); PG8_STAGE(PG8_SB(1, 0), b3, voffB);
            PG8_BAR; PG8_WAIT_L(0); PG8_MMA(0, 1, At, B1); PG8_BAR;
            PG8_LDA(At, 1, 1); PG8_STAGE(PG8_SA(1, 0), a3, voffA);
            PG8_BAR; PG8_WAIT_L(0); PG8_MMA(1, 0, At, B0); PG8_BAR; PG8_SCHED;
            PG8_STAGE(PG8_SB(1, 1), b3 + hstep, voffB);
            PG8_WAIT_V(6); PG8_BAR; PG8_MMA(1, 1, At, B1); PG8_BAR;
            }
        }
        if constexpr (ALIGN_EPI) { if (wr == 0) PG8_BAR; }
        if constexpr (!Epi::AFTER_DRAIN) { E(acc, cur, wr, wc, fr, fq); S.done(cur); }
        if (!has_next) break;
#pragma unroll
        for (int a = 0; a < 2; ++a)
#pragma unroll
            for (int b = 0; b < 2; ++b)
#pragma unroll
                for (int m = 0; m < 4; ++m)
#pragma unroll
                    for (int n = 0; n < 2; ++n) acc[a][b][m][n] = (f32x4){0.f, 0.f, 0.f, 0.f};
        cur = nxt; cA = nA; cB = nB; ++ui;
        if constexpr (ALIGN_EPI) { if (wr == 1) PG8_BAR; }
    }
    PG8_WAIT_V(0);
    if constexpr (!ALIGN_EPI) { if (wr == 0) PG8_BAR; }
    PG8_BAR;
    if constexpr (Epi::AFTER_DRAIN) { E.fused(acc, cur, wr, wc, fr, fq, lds, wid, lane); S.done(cur); }
#undef PG8_SA
#undef PG8_SB
#undef PG8_STAGE
#undef PG8_LDA
#undef PG8_LDB
#undef PG8_MMA
#undef PG8_WAIT_V
#undef PG8_WAIT_L
#undef PG8_BAR
#undef PG8_SCHED
}
}

namespace att {
typedef unsigned short bf16_t;
using bf16x8 = __attribute__((ext_vector_type(8))) short;
using s16x4  = __attribute__((ext_vector_type(4))) short;
using f32x16 = __attribute__((ext_vector_type(16))) float;
using u32x4  = __attribute__((ext_vector_type(4))) unsigned;
constexpr int NW = 8, QBLK = 32, KVBLK = 64, LD = 1024;
constexpr int SHM_V = KVBLK * 128 * 2, SHM_K = KVBLK * 64 * 2;
constexpr int OFF_V = 0, OFF_K = 2 * SHM_V, OFF_WS = OFF_K + 2 * SHM_K, OFF_UNIT = OFF_WS + NW * 64 * 4, LDS_BYTES = OFF_UNIT + 64;
constexpr float THR2 = 10.f;
#define KSWZ(row, colB) ((row) * 128 + ((colB) ^ ((((row) >> 1) & 7) << 4)))
#define SBAR() __builtin_amdgcn_sched_barrier(0)
__device__ __forceinline__ int crow(int r, int hi) { return (r & 3) + 8 * (r >> 2) + 4 * hi; }
__device__ __forceinline__ unsigned cvtpk(float lo, float hi) { unsigned r; asm volatile("v_cvt_pk_bf16_f32 %0, %1, %2" : "=v"(r) : "v"(lo), "v"(hi)); return r; }

__device__ __forceinline__ void partialSM(f32x16& p0, f32x16& p1, float& m_reg, float& alpha, float dq, float nc2) {
  const float dq1 = dq - 32.f;
#pragma unroll
  for (int r = 0; r < 16; ++r) p0[r] = fmaf(__builtin_fabsf(dq - (float)((r & 3) + 8 * (r >> 2))), nc2, p0[r]);
#pragma unroll
  for (int r = 0; r < 16; ++r) p1[r] = fmaf(__builtin_fabsf(dq1 - (float)((r & 3) + 8 * (r >> 2))), nc2, p1[r]);
  float pmax = p0[0];
#pragma unroll
  for (int r = 1; r < 16; ++r) pmax = fmaxf(pmax, p0[r]);
#pragma unroll
  for (int r = 0; r < 16; ++r) pmax = fmaxf(pmax, p1[r]);
  { auto rr = __builtin_amdgcn_permlane32_swap(__float_as_uint(pmax), __float_as_uint(pmax), false, false);
    pmax = fmaxf(__uint_as_float(rr[0]), __uint_as_float(rr[1])); }
  float mn;
  if (__builtin_expect(__all(pmax - m_reg <= THR2), 1)) { mn = m_reg; alpha = 1.f; }
  else { mn = fmaxf(m_reg, pmax); alpha = __builtin_amdgcn_exp2f(m_reg - mn); m_reg = mn; }
#pragma unroll
  for (int r = 0; r < 16; ++r) p0[r] -= mn;
#pragma unroll
  for (int r = 0; r < 16; ++r) p1[r] -= mn;
#pragma unroll
  for (int r = 0; r < 16; ++r) p0[r] = __builtin_amdgcn_exp2f(p0[r]);
}
__device__ __forceinline__ void finishSM(f32x16& p0, f32x16& p1, float alpha, float& l_reg, bf16x8& pa0, bf16x8& pa1, bf16x8& pa2, bf16x8& pa3) {
#pragma unroll
  for (int r = 0; r < 16; ++r) p1[r] = __builtin_amdgcn_exp2f(p1[r]);
  float ps = 0;
#pragma unroll
  for (int r = 0; r < 16; ++r) ps += p0[r];
#pragma unroll
  for (int r = 0; r < 16; ++r) ps += p1[r];
  { auto rr = __builtin_amdgcn_permlane32_swap(__float_as_uint(ps), __float_as_uint(ps), false, false);
    ps = __uint_as_float(rr[0]) + __uint_as_float(rr[1]); }
  l_reg = l_reg * alpha + ps;
#define PK4(P, BASE, OUT) do { unsigned a0 = cvtpk(P[BASE + 0], P[BASE + 1]), a1 = cvtpk(P[BASE + 2], P[BASE + 3]);   \
    unsigned b0 = cvtpk(P[BASE + 4], P[BASE + 5]), b1 = cvtpk(P[BASE + 6], P[BASE + 7]);                              \
    auto r0 = __builtin_amdgcn_permlane32_swap(a0, b0, false, false); auto r1 = __builtin_amdgcn_permlane32_swap(a1, b1, false, false); \
    u32x4 w = {r0[0], r1[0], r0[1], r1[1]}; OUT = *reinterpret_cast<bf16x8*>(&w); } while (0)
  PK4(p0, 0, pa0); PK4(p0, 8, pa1); PK4(p1, 0, pa2); PK4(p1, 8, pa3);
#undef PK4
}
__device__ __forceinline__ void qkt(f32x16& p0, f32x16& p1, const char* Ks, const bf16x8* qr, int r32, int hi) {
  p0 = f32x16{}; p1 = f32x16{};
#pragma unroll
  for (int d0 = 0; d0 < 4; ++d0) { const int cb = d0 * 32 + hi * 16;
    bf16x8 b0 = *reinterpret_cast<const bf16x8*>(Ks + KSWZ(r32, cb));
    bf16x8 b1 = *reinterpret_cast<const bf16x8*>(Ks + KSWZ(32 + r32, cb));
    p0 = __builtin_amdgcn_mfma_f32_32x32x16_bf16(b0, qr[d0], p0, 0, 0, 0);
    p1 = __builtin_amdgcn_mfma_f32_32x32x16_bf16(b1, qr[d0], p1, 0, 0, 0); }
}
__device__ __forceinline__ int v_st(int k, int c) { const int kk = (k & ~0xC) | ((k & 4) << 1) | ((k & 8) >> 1); return ((kk >> 3) * 4 + (c >> 5)) * 512 + ((kk & 7) * 32 + (c & 31)) * 2; }
__device__ __forceinline__ int v_rd_base(int lane) { return ((lane & 3) << 3) | (((lane >> 2) & 3) << 6) | (((lane >> 4) & 1) << 5) | (((lane >> 5) & 1) << 8); }
constexpr int v_rd_off(int d0, int ks, int half) { return d0 * 512 + ks * 4096 + half * 2048; }
template <int OFF> __device__ __forceinline__ s16x4 tr_read(int vb) {
  s16x4 r; asm volatile("ds_read_b64_tr_b16 %0, %1 offset:%2" : "=&v"(r) : "v"(vb), "i"(OFF) : "memory"); return r;
}
template <int D0> __device__ __forceinline__ void pv_one(f32x16& od, int vb, bf16x8 pa0, bf16x8 pa1, bf16x8 pa2, bf16x8 pa3) {
  const s16x4 l0 = tr_read<v_rd_off(D0, 0, 0)>(vb), h0 = tr_read<v_rd_off(D0, 0, 1)>(vb), l1 = tr_read<v_rd_off(D0, 1, 0)>(vb), h1 = tr_read<v_rd_off(D0, 1, 1)>(vb);
  const s16x4 l2 = tr_read<v_rd_off(D0, 2, 0)>(vb), h2 = tr_read<v_rd_off(D0, 2, 1)>(vb), l3 = tr_read<v_rd_off(D0, 3, 0)>(vb), h3 = tr_read<v_rd_off(D0, 3, 1)>(vb);
  asm volatile("s_waitcnt lgkmcnt(0)" ::: "memory"); SBAR();
#define PK(L, H) (bf16x8){L[0], L[1], L[2], L[3], H[0], H[1], H[2], H[3]}
  od = __builtin_amdgcn_mfma_f32_32x32x16_bf16(pa0, PK(l0, h0), od, 0, 0, 0);
  od = __builtin_amdgcn_mfma_f32_32x32x16_bf16(pa1, PK(l1, h1), od, 0, 0, 0);
  od = __builtin_amdgcn_mfma_f32_32x32x16_bf16(pa2, PK(l2, h2), od, 0, 0, 0);
  od = __builtin_amdgcn_mfma_f32_32x32x16_bf16(pa3, PK(l3, h3), od, 0, 0, 0);
#undef PK
}
__device__ __forceinline__ void pv_d0(f32x16* o, int vb, bf16x8 pa0, bf16x8 pa1, bf16x8 pa2, bf16x8 pa3) {
  pv_one<0>(o[0], vb, pa0, pa1, pa2, pa3); pv_one<1>(o[1], vb, pa0, pa1, pa2, pa3); pv_one<2>(o[2], vb, pa0, pa1, pa2, pa3); pv_one<3>(o[3], vb, pa0, pa1, pa2, pa3);
}

__device__ __forceinline__ void attn_pass(const bf16_t* __restrict__ Qw, const bf16_t* __restrict__ Kh, const bf16_t* __restrict__ Vh,
                                          int NT, float dqbase, float nc2, f32x16 (&o)[4], char* lds) {
  const int tid = mk_tid(), wid = tid >> 6, lane = tid & 63, r32 = lane & 31, hi = lane >> 5;
  char* V_lds = lds + OFF_V; char* K_lds = lds + OFF_K;
  float* ws = (float*)(lds + OFF_WS) + wid * 64; float* li_l = ws; float* al_l = ws + 32;
  float m_reg = -1e30f, l_reg = 0; bf16x8 qr[4];
#pragma unroll
  for (int d = 0; d < 4; ++d) o[d] = f32x16{};
#pragma unroll
  for (int d0 = 0; d0 < 4; ++d0) qr[d0] = *reinterpret_cast<const bf16x8*>(Qw + d0 * 16);
  dqbase -= (float)(4 * hi);
  const int sr = tid >> 4, sc = (tid & 15) * 8, vst0 = v_st(sr, sc), vst1 = v_st(32 + sr, sc);
  const int krow = tid >> 3, kcol = (tid & 7) * 8, kst = KSWZ(krow, kcol * 2);
  const int vb0 = (int)(uintptr_t)V_lds + v_rd_base(lane);
  struct { bf16x8 vs0, vs1, ks0; } sr_[2];
#define SLOAD(i, k0) do { sr_[i].vs0 = *reinterpret_cast<const bf16x8*>(&Vh[(long)((k0) + sr) * LD + sc]); sr_[i].vs1 = *reinterpret_cast<const bf16x8*>(&Vh[(long)((k0) + 32 + sr) * LD + sc]); \
    sr_[i].ks0 = *reinterpret_cast<const bf16x8*>(&Kh[(long)((k0) + krow) * LD + kcol]); } while (0)
#define SWRITE(b, i) do { *(bf16x8*)(V_lds + (b) * SHM_V + vst0) = sr_[i].vs0; *(bf16x8*)(V_lds + (b) * SHM_V + vst1) = sr_[i].vs1; \
    *(bf16x8*)(K_lds + (b) * SHM_K + kst) = sr_[i].ks0; } while (0)
#define SWAIT() asm volatile("s_waitcnt vmcnt(3)" ::: "memory")
#define RESC(a) do { if (__any((a) < 1.f)) { if (hi == 0) al_l[r32] = (a); asm volatile("s_waitcnt lgkmcnt(0)" ::: "memory"); \
    _Pragma("unroll") for (int d = 0; d < 4; ++d) _Pragma("unroll") for (int r = 0; r < 16; ++r) o[d][r] *= al_l[crow(r, hi)]; } } while (0)
  f32x16 pA0, pA1, pB0, pB1; float alA, alB; bf16x8 pa0, pa1, pa2, pa3;
  constexpr int SE = 0, SO = 1;
  __syncthreads();
  SLOAD(SE, 0); asm volatile("s_waitcnt vmcnt(0)" ::: "memory"); SWRITE(0, SE); __syncthreads();
  qkt(pA0, pA1, K_lds, qr, r32, hi); partialSM(pA0, pA1, m_reg, alA, dqbase, nc2);
  SLOAD(SO, KVBLK); if (2 < NT) SLOAD(SE, 2 * KVBLK);
  SWAIT(); SWRITE(1, SO); __syncthreads();
  for (int j = 1; j + 1 < NT; j += 2) {
    SBAR(); qkt(pB0, pB1, K_lds + SHM_K, qr, r32, hi);
    finishSM(pA0, pA1, alA, l_reg, pa0, pa1, pa2, pa3); SBAR();
    SLOAD(SO, (j + 2) * KVBLK); SBAR();
    pv_d0(o, vb0, pa0, pa1, pa2, pa3); partialSM(pB0, pB1, m_reg, alB, dqbase - (float)(j * KVBLK), nc2);
    __syncthreads(); SWAIT(); SWRITE(0, SE);
    RESC(alB); __syncthreads();
    SBAR(); qkt(pA0, pA1, K_lds, qr, r32, hi);
    finishSM(pB0, pB1, alB, l_reg, pa0, pa1, pa2, pa3); SBAR();
    if (j + 3 < NT) SLOAD(SE, (j + 3) * KVBLK); SBAR();
    pv_d0(o, vb0 + SHM_V, pa0, pa1, pa2, pa3); partialSM(pA0, pA1, m_reg, alA, dqbase - (float)((j + 1) * KVBLK), nc2);
    __syncthreads(); SWAIT(); SWRITE(1, SO);
    RESC(alA); __syncthreads();
  }
  SBAR(); qkt(pB0, pB1, K_lds + SHM_K, qr, r32, hi);
  finishSM(pA0, pA1, alA, l_reg, pa0, pa1, pa2, pa3); SBAR();
  pv_d0(o, vb0, pa0, pa1, pa2, pa3); partialSM(pB0, pB1, m_reg, alB, dqbase - (float)((NT - 1) * KVBLK), nc2);
  __syncthreads(); RESC(alB);
  finishSM(pB0, pB1, alB, l_reg, pa0, pa1, pa2, pa3); SBAR();
  pv_d0(o, vb0 + SHM_V, pa0, pa1, pa2, pa3);
  if (hi == 0) li_l[r32] = l_reg; asm volatile("s_waitcnt lgkmcnt(0)" ::: "memory");
#pragma unroll
  for (int r = 0; r < 16; ++r) { const float rli = __builtin_amdgcn_rcpf(li_l[crow(r, hi)]);
#pragma unroll
    for (int d0 = 0; d0 < 4; ++d0) o[d0][r] *= rli; }
#undef SLOAD
#undef SWRITE
#undef SWAIT
#undef RESC
}
}

typedef unsigned short bf16;
typedef unsigned v4u __attribute__((ext_vector_type(4)));
typedef unsigned v2u __attribute__((ext_vector_type(2)));
typedef float f32x4 __attribute__((ext_vector_type(4)));
#define LAS __attribute__((address_space(3)))
constexpr int NWAVES = 8, NTHREADS = 512;
constexpr int D = 1024, FF = 4096, MG = 16384, MTOT = 32768;
constexpr int DEPTH = 4;
constexpr float QSCALE = 0.125f * 1.4426950408889634f;
constexpr size_t MiB = 1u << 20;
constexpr size_t WS_CTL = 0, WS_ZERO_END = 64 * 1024;
constexpr size_t WS_WMI = 2 * MiB, WS_WMO = 10 * MiB, WS_WQKV = 14 * MiB, WS_WAO = 26 * MiB, WS_W1 = 30 * MiB, WS_W2 = 62 * MiB;
constexpr size_t WS_XB = 94 * MiB, WS_BIG = 126 * MiB, WS_ROWSQ = 254 * MiB, WS_END = WS_ROWSQ + 9 * (size_t)MG * 64;
static_assert(WS_ZERO_END <= WS_WMI, "ws map");
constexpr int CW_ATTCTR = 0;
constexpr int CW_NRM = 1024;

struct Args {
    const float* in[19]; float* out; unsigned char* ws; int ph_lo, ph_hi;
};

__device__ __forceinline__ unsigned f2bf(float f) { unsigned u = __builtin_bit_cast(unsigned, f); return (u + 0x7fffu + ((u >> 16) & 1u)) >> 16; }
__device__ __forceinline__ unsigned pk2(float lo, float hi) { return f2bf(lo) | (f2bf(hi) << 16); }
__device__ __forceinline__ float bflo(unsigned w) { return __uint_as_float(w << 16); }
__device__ __forceinline__ float bfhi(unsigned w) { return __uint_as_float(w & 0xffff0000u); }
__device__ __forceinline__ float wave_sum(float v) {
    v += xor_lt32<1>(v); v += xor_lt32<2>(v); v += xor_lt32<4>(v); v += xor_lt32<8>(v); v += xor_lt32<16>(v);
    return sum_x32(v);
}

__device__ __forceinline__ void transpose_item(const float* W, int ldw, int N, const float* gs, bf16* WT, int ldk, int koff, LAS float* scr, int item, int lane) {
    const int nblk = N / 32, kb = item / nblk, nb = item % nblk, k0 = 64 * kb, n0 = 32 * nb;
#pragma unroll 8
    for (int i = 0; i < 32; ++i) { const int kk = 2 * i + (lane >> 5); float v = W[(size_t)(k0 + kk) * ldw + n0 + (lane & 31)]; if (gs) v *= gs[k0 + kk]; scr[kk * 33 + (lane & 31)] = v; }
    asm volatile("s_waitcnt lgkmcnt(0)" ::: "memory");
    const int c = lane & 7;
#pragma unroll
    for (int j = 0; j < 4; ++j) { const int n = (lane >> 3) + 8 * j; const LAS float* s = scr + (8 * c) * 33 + n;
        v4u o; o.x = pk2(s[0 * 33], s[1 * 33]); o.y = pk2(s[2 * 33], s[3 * 33]); o.z = pk2(s[4 * 33], s[5 * 33]); o.w = pk2(s[6 * 33], s[7 * 33]);
        *(v4u*)(WT + (size_t)(n0 + n) * ldk + koff + k0 + 8 * c) = o; }
    asm volatile("s_waitcnt lgkmcnt(0)" ::: "memory");
}

__device__ __forceinline__ void phase_prologue(const Args& a, LAS unsigned char* lds) {
    const int tid = mk_tid(), lane = tid & 63, wave = tid >> 6;
    const int gt = blockIdx.x * NTHREADS + tid, NGT = gridDim.x * NTHREADS;
    const int gw = blockIdx.x * NWAVES + wave, NGW = gridDim.x * NWAVES;
    { v4u z = {0u, 0u, 0u, 0u}; v4u* p = (v4u*)(a.ws + WS_CTL); for (int i = gt; i < (int)(WS_ZERO_END / 16); i += NGT) p[i] = z; }
    LAS float* scr = (LAS float*)(lds + wave * 16384);
    const float* norm1_g = a.in[2]; const float* norm2_g = a.in[3];
    constexpr int I_MI = 16 * 64, I_MO = 8 * 32, I_QKV = 16 * 96, I_AO = 16 * 32, I_W1 = 16 * 128, I_W2 = 64 * 32;
    constexpr int T_MI = 2 * I_MI, T_MO = T_MI + 2 * I_MO, T_QKV = T_MO + 2 * I_QKV, T_AO = T_QKV + 2 * I_AO, T_W1 = T_AO + 4 * I_W1, T_W2 = T_W1 + 4 * I_W2;
    for (int it = gw; it < T_W2; it += NGW) {
        if (it < T_MI) { const int j = it / I_MI, r = it % I_MI;
            transpose_item(a.in[5] + (size_t)j * D * 2048, 2048, 2048, norm1_g + (2 * j) * D, (bf16*)(a.ws + WS_WMI) + (size_t)j * 2048 * D, D, 0, scr, r, lane); }
        else if (it < T_MO) { const int q = it - T_MI, j = q / I_MO, r = q % I_MO;
            transpose_item(a.in[9] + (size_t)j * D * D + (size_t)512 * D, D, D, nullptr, (bf16*)(a.ws + WS_WMO) + (size_t)j * D * D, D, 512, scr, r, lane); }
        else if (it < T_QKV) { const int q = it - T_MO, j = q / I_QKV, r = q % I_QKV;
            transpose_item(a.in[10] + (size_t)j * D * 3072, 3072, 3072, norm1_g + (2 * j + 1) * D, (bf16*)(a.ws + WS_WQKV) + (size_t)j * 3072 * D, D, 0, scr, r, lane); }
        else if (it < T_AO) { const int q = it - T_QKV, j = q / I_AO, r = q % I_AO;
            transpose_item(a.in[11] + (size_t)j * D * D, D, D, nullptr, (bf16*)(a.ws + WS_WAO) + (size_t)j * D * D, D, 0, scr, r, lane); }
        else if (it < T_W1) { const int q = it - T_AO, i = q / I_W1, r = q % I_W1;
            transpose_item(a.in[17] + (size_t)i * D * FF, FF, FF, norm2_g + i * D, (bf16*)(a.ws + WS_W1) + (size_t)i * FF * D, D, 0, scr, r, lane); }
        else { const int q = it - T_W1, i = q / I_W2, r = q % I_W2;
            transpose_item(a.in[18] + (size_t)i * FF * D, D, D, nullptr, (bf16*)(a.ws + WS_W2) + (size_t)i * D * FF, FF, 0, scr, r, lane); }
    }
    for (int it = gw; it < 2 * 4 * 16 * 16; it += NGW) {
        const int cb = it & 15, nb = (it >> 4) & 15, g = (it >> 8) & 3, j = it >> 10;
        const float* pw = a.in[6] + ((size_t)(j * 4 + g) * 128 + cb * 8) * 128;
        const float* ps = a.in[7] + j * 512 + g * 128;
        const float* mo = a.in[9] + (size_t)j * D * D + (size_t)(g * 128) * D + nb * 64 + lane;
        float acc[8];
#pragma unroll
        for (int c = 0; c < 8; ++c) acc[c] = 0.f;
        for (int d = 0; d < 128; ++d) {
            const float m = mo[(size_t)d * D] * ps[d];
#pragma unroll
            for (int c = 0; c < 8; ++c) acc[c] = fmaf(pw[c * 128 + d], m, acc[c]);
        }
        v4u o; o.x = pk2(acc[0], acc[1]); o.y = pk2(acc[2], acc[3]); o.z = pk2(acc[4], acc[5]); o.w = pk2(acc[6], acc[7]);
        *(v4u*)((bf16*)(a.ws + WS_WMO) + (size_t)j * D * D + (size_t)(nb * 64 + lane) * D + g * 128 + cb * 8) = o;
    }
}

__device__ __forceinline__ void phase_prep(const Args& a, int g) {
    const int tid = mk_tid(), lane = tid & 63, gw = blockIdx.x * NWAVES + (tid >> 6), NGW = gridDim.x * NWAVES;
    const float* xin = g ? a.in[1] : a.in[0]; float* xo = a.out + (size_t)g * MG * D; bf16* xb = (bf16*)(a.ws + WS_XB); float* rsq = (float*)(a.ws + WS_ROWSQ);
    for (int m = gw; m < MG; m += NGW) {
        const f32x4* xr = (const f32x4*)(xin + (size_t)m * D) + lane; f32x4* orow = (f32x4*)(xo + (size_t)m * D) + lane; v2u* brow = (v2u*)(xb + (size_t)m * D) + lane;
        float s = 0.f;
#pragma unroll
        for (int j = 0; j < 4; ++j) { const f32x4 v = xr[64 * j]; orow[64 * j] = v; s += (v[0] * v[0] + v[1] * v[1]) + (v[2] * v[2] + v[3] * v[3]);
            v2u w; w.x = pk2(v[0], v[1]); w.y = pk2(v[2], v[3]); brow[64 * j] = w; }
        s = wave_sum(s);
        if (lane < 16) rsq[(size_t)m * 16 + lane] = lane == 0 ? s : 0.f;
    }
}
__device__ __forceinline__ void phase_final(const Args& a, int g) {
    const int tid = mk_tid(), lane = tid & 63, gw = blockIdx.x * NWAVES + (tid >> 6), NGW = gridDim.x * NWAVES;
    float* xo = a.out + (size_t)g * MG * D; const float* rsq = (const float*)(a.ws + WS_ROWSQ) + (size_t)8 * MG * 16; const f32x4* fg = (const f32x4*)a.in[4] + lane;
    for (int m = gw; m < MG; m += NGW) {
        float rsum;
        { const f32x4* rp = (const f32x4*)(rsq + (size_t)m * 16); const f32x4 a0 = rp[0], a1 = rp[1], a2 = rp[2], a3 = rp[3];
          rsum = (((a0[0] + a0[1]) + (a0[2] + a0[3])) + ((a1[0] + a1[1]) + (a1[2] + a1[3]))) + (((a2[0] + a2[1]) + (a2[2] + a2[3])) + ((a3[0] + a3[1]) + (a3[2] + a3[3]))); }
        const float rs = __builtin_amdgcn_rsqf(rsum * (1.0f / 1024.0f) + 1e-6f);
        f32x4* orow = (f32x4*)(xo + (size_t)m * D) + lane;
#pragma unroll
        for (int j = 0; j < 4; ++j) { f32x4 v = orow[64 * j]; const f32x4 gg = fg[64 * j]; v = v * rs * gg; orow[64 * j] = v; }
    }
}

__device__ __forceinline__ void unpack8(const v4u w, float (&f)[8]) {
    f[0] = bflo(w.x); f[1] = bfhi(w.x); f[2] = bflo(w.y); f[3] = bfhi(w.y); f[4] = bflo(w.z); f[5] = bfhi(w.z); f[6] = bflo(w.w); f[7] = bfhi(w.w);
}
__device__ __forceinline__ void phase_stencil(const Args& a, int g, int j) {
    const int S = g ? 16384 : 8192;
    const bf16* P = (const bf16*)(a.ws + WS_BIG); bf16* A2 = (bf16*)(a.ws + WS_BIG + 64 * MiB);
    const int tid = mk_tid(), chunk = tid & 127, tb = tid >> 7;
    for (int tile = blockIdx.x; tile < MG / 64; tile += gridDim.x) {
        const int row0 = tile * 64 + tb * 16;
        const int b0 = row0 & ~(S - 1), t0 = row0 & (S - 1);
        if (chunk < 64) {
            const int c0 = chunk * 8, hw = 1 << (chunk >> 4);
            const bf16* U = P + (size_t)b0 * 2048 + c0;
            float sum[8];
#pragma unroll
            for (int e = 0; e < 8; ++e) sum[e] = 0.f;
            { const int lo = max(t0 - hw, 0), hi = min(t0 + hw, S);
              for (int t = lo; t < hi; ++t) { float f[8]; unpack8(*(const v4u*)(U + (size_t)t * 2048), f);
#pragma unroll
                  for (int e = 0; e < 8; ++e) sum[e] += f[e]; } }
            for (int i = 0; i < 16; ++i) {
                const int t = t0 + i; const int lo = max(t - hw, 0), hi = min(t + hw, S);
                const float rc = 1.0f / (float)(hi - lo);
                float f[8]; unpack8(*(const v4u*)(U + (size_t)t * 2048), f);
                v4u o; o.x = pk2(sum[0] * rc - f[0], sum[1] * rc - f[1]); o.y = pk2(sum[2] * rc - f[2], sum[3] * rc - f[3]);
                o.z = pk2(sum[4] * rc - f[4], sum[5] * rc - f[5]); o.w = pk2(sum[6] * rc - f[6], sum[7] * rc - f[7]);
                *(v4u*)(A2 + (size_t)(b0 + t) * 1024 + c0) = o;
                if (t + hw < S) { float n[8]; unpack8(*(const v4u*)(U + (size_t)(t + hw) * 2048), n);
#pragma unroll
                    for (int e = 0; e < 8; ++e) sum[e] += n[e]; }
                if (t - hw >= 0) { float n[8]; unpack8(*(const v4u*)(U + (size_t)(t - hw) * 2048), n);
#pragma unroll
                    for (int e = 0; e < 8; ++e) sum[e] -= n[e]; }
            }
        } else {
            const int c0 = (chunk - 64) * 8;
            const bf16* Hc = P + (size_t)b0 * 2048 + 512 + c0; const bf16* Gb = Hc + 512; const bf16* Gc = Hc + 1024;
            const float* cw = a.in[8] + (size_t)j * 3 * 512 + c0;
            float w0[8], w1[8], w2[8];
#pragma unroll
            for (int e = 0; e < 8; ++e) { w0[e] = cw[e]; w1[e] = cw[512 + e]; w2[e] = cw[1024 + e]; }
            float zp[8], zc[8];
            if (t0 > 0) { float hh[8], cc[8]; unpack8(*(const v4u*)(Hc + (size_t)(t0 - 1) * 2048), hh); unpack8(*(const v4u*)(Gc + (size_t)(t0 - 1) * 2048), cc);
#pragma unroll
                for (int e = 0; e < 8; ++e) zp[e] = hh[e] * cc[e]; }
            else {
#pragma unroll
                for (int e = 0; e < 8; ++e) zp[e] = 0.f; }
            { float hh[8], cc[8]; unpack8(*(const v4u*)(Hc + (size_t)t0 * 2048), hh); unpack8(*(const v4u*)(Gc + (size_t)t0 * 2048), cc);
#pragma unroll
              for (int e = 0; e < 8; ++e) zc[e] = hh[e] * cc[e]; }
            for (int i = 0; i < 16; ++i) {
                const int t = t0 + i; float zn[8];
                if (t + 1 < S) { float hh[8], cc[8]; unpack8(*(const v4u*)(Hc + (size_t)(t + 1) * 2048), hh); unpack8(*(const v4u*)(Gc + (size_t)(t + 1) * 2048), cc);
#pragma unroll
                    for (int e = 0; e < 8; ++e) zn[e] = hh[e] * cc[e]; }
                else {
#pragma unroll
                    for (int e = 0; e < 8; ++e) zn[e] = 0.f; }
                float gb[8], r[8]; unpack8(*(const v4u*)(Gb + (size_t)t * 2048), gb);
#pragma unroll
                for (int e = 0; e < 8; ++e) r[e] = gb[e] * (w0[e] * zp[e] + w1[e] * zc[e] + w2[e] * zn[e]);
                v4u o; o.x = pk2(r[0], r[1]); o.y = pk2(r[2], r[3]); o.z = pk2(r[4], r[5]); o.w = pk2(r[6], r[7]);
                *(v4u*)(A2 + (size_t)(b0 + t) * 1024 + 512 + c0) = o;
#pragma unroll
                for (int e = 0; e < 8; ++e) { zp[e] = zc[e]; zc[e] = zn[e]; }
            }
        }
    }
}

__device__ __forceinline__ void phase_attention(const Args& a, int g, int layer, char* lds) {
    using namespace att;
    const int S = g ? 16384 : 8192, logS = g ? 14 : 13; const int j = layer >> 1;
    const bf16* Qb = (const bf16*)(a.ws + WS_BIG); const bf16* Kb = Qb + (size_t)MG * 1024; const bf16* Vb = Kb + (size_t)MG * 1024; bf16* Ob = (bf16*)(a.ws + WS_BIG);
    float* scr = (float*)(a.ws + WS_BIG + 96 * MiB) + (size_t)blockIdx.x * 32768;
    unsigned* ctr = (unsigned*)(a.ws + WS_CTL) + CW_ATTCTR + 64 * (g * 2 + j);
    const unsigned* nrm = (const unsigned*)(a.ws + WS_CTL) + CW_NRM + 256 * (g * 2 + j);
    const int tid = mk_tid(), wid = tid >> 6, lane = tid & 63, r32 = lane & 31, hi = lane >> 5;
    volatile unsigned* s_unit = (volatile unsigned*)(lds + OFF_UNIT);
    const float lambda_init = (layer == 1) ? 0.35550906759096926f : 0.5560582041556405f;
    float lam;
    { const float* q1 = a.in[12] + j * 64; const float* k1 = a.in[13] + j * 64; const float* q2 = a.in[14] + j * 64; const float* k2 = a.in[15] + j * 64;
      float s1 = q1[lane] * k1[lane], s2 = q2[lane] * k2[lane]; s1 = wave_sum(s1); s2 = wave_sum(s2); lam = __expf(s1) - __expf(s2) + lambda_init; }
    const float* subg = a.in[16] + j * 128;
    for (;;) {
        __syncthreads();
        if (tid == 0) *s_unit = atomicAdd(ctr, 1u);
        __syncthreads();
        const int u = (int)*s_unit;
        if (u >= 512) break;
        const int h = 7 - (u >> 6), qbi = u & 63;
        const int b = (qbi * 256) >> logS, q0 = (qbi * 256) & (S - 1);
        const size_t rowbase = (size_t)b * S;
        const float slope2 = __builtin_amdgcn_exp2f(-(float)(h + 1)) * 1.4426950408889634f;
        const int qpos = q0 + wid * QBLK + r32;
        f32x16 o[4];
        f32x4* sp = (f32x4*)(scr + tid * 64);
#pragma unroll 1
        for (int pass = 0; pass < 2; ++pass) {
            const int map = 2 * h + pass;
            int klo = 0, khi = S;
#if MK_WINDOW
            { const unsigned* nq = nrm + ((0 * 2 + b) * 16 + map) * 2; const unsigned* nk = nrm + ((1 * 2 + b) * 16 + map) * 2;
              const float qn2 = __uint_as_float(__hip_atomic_load(nq, __ATOMIC_RELAXED, __HIP_MEMORY_SCOPE_AGENT)) + __uint_as_float(__hip_atomic_load(nq + 1, __ATOMIC_RELAXED, __HIP_MEMORY_SCOPE_AGENT));
              const float kn2 = __uint_as_float(__hip_atomic_load(nk, __ATOMIC_RELAXED, __HIP_MEMORY_SCOPE_AGENT)) + __uint_as_float(__hip_atomic_load(nk + 1, __ATOMIC_RELAXED, __HIP_MEMORY_SCOPE_AGENT));
              const float smax = sqrtf(qn2 * kn2) * 1.02f;
              const float wf = (2.f * smax + 30.f) / slope2;
              const int wi = (wf < (float)S) ? (int)wf + 1 : S;
              klo = max(q0 - wi, 0) & ~127; khi = min((q0 + 256 + wi + 127) & ~127, S); }
#endif
            const int NT = (khi - klo) >> 6;
            const bf16* Qw = Qb + (rowbase + q0 + wid * QBLK + r32) * 1024 + map * 64 + hi * 8;
            const bf16* Kh = Kb + (rowbase + klo) * 1024 + map * 64;
            const bf16* Vh = Vb + (rowbase + klo) * 1024 + h * 128;
            attn_pass(Qw, Kh, Vh, NT, (float)(qpos - klo), -slope2, o, lds);
            if (pass == 0) {
#pragma unroll
                for (int d0 = 0; d0 < 4; ++d0)
#pragma unroll
                    for (int q = 0; q < 4; ++q) { f32x4 t4 = {o[d0][4 * q], o[d0][4 * q + 1], o[d0][4 * q + 2], o[d0][4 * q + 3]}; sp[d0 * 4 + q] = t4; }
            }
        }
        float ssq[16];
#pragma unroll
        for (int r = 0; r < 16; ++r) ssq[r] = 0.f;
#pragma unroll
        for (int d0 = 0; d0 < 4; ++d0)
#pragma unroll
            for (int q = 0; q < 4; ++q) { const f32x4 t4 = sp[d0 * 4 + q];
#pragma unroll
                for (int e = 0; e < 4; ++e) { const int r = 4 * q + e; const float v = t4[e] - lam * o[d0][r]; o[d0][r] = v; ssq[r] = fmaf(v, v, ssq[r]); } }
#pragma unroll
        for (int r = 0; r < 16; ++r) {
            float s = ssq[r];
            s += xor_lt32<1>(s); s += xor_lt32<2>(s); s += xor_lt32<4>(s); s += xor_lt32<8>(s); s += xor_lt32<16>(s);
            ssq[r] = __builtin_amdgcn_rsqf(s * (1.0f / 128.0f) + 1e-5f) * (1.0f - lambda_init);
        }
        int hi_l = hi; asm volatile("" : "+v"(hi_l));
        bf16* Ow = Ob + (rowbase + q0 + wid * QBLK + 4 * hi_l) * 1024 + h * 128 + r32;
#pragma unroll
        for (int d0 = 0; d0 < 4; ++d0) { const float gg = subg[d0 * 32 + r32];
#pragma unroll
            for (int r = 0; r < 16; ++r) Ow[(size_t)crow(r, 0) * 1024 + d0 * 32] = (bf16)f2bf(o[d0][r] * ssq[r] * gg); }
    }
}

constexpr int LDS_BYTES = 147456;
constexpr int N_PHASES = 1 + 2 * (1 + 4 * 5 + 1);
#ifndef MK_MASK
#define MK_MASK 0xFFFF
#endif
#define EN(k) ((MK_MASK >> (k)) & 1)

__global__ void __launch_bounds__(NTHREADS, 2) fwd_megakernel(Args args) {
    extern __shared__ __attribute__((aligned(16))) unsigned char lds[];
    cg::grid_group grid = cg::this_grid();
    const int lo = args.ph_lo, hi = args.ph_hi;
    int ph = 0;
#define RUN() (ph >= lo && ph < hi)
#define SEAM() do { if (ph >= lo && ph + 1 < hi) grid.sync(); ++ph; } while (0)
    unsigned char* ws = args.ws;
    PG8_LAS unsigned char* glds = (PG8_LAS unsigned char*)lds;
    const int G = gridDim.x, c = blockIdx.x;

    if (EN(0) && RUN()) phase_prologue(args, (LAS unsigned char*)lds);
    SEAM();
#pragma unroll 1
    for (int g = 0; g < 2; ++g) {
        if (EN(1) && RUN()) phase_prep(args, g);
        SEAM();
        float* xg = args.out + (size_t)g * MG * D; bf16* XB = (bf16*)(ws + WS_XB);
        float* rsq_base = (float*)(ws + WS_ROWSQ);
#pragma unroll 1
        for (int i = 0; i < DEPTH; ++i) {
            const int j = i >> 1;
            float* rsq_n1 = rsq_base + (size_t)(2 * i) * MG * 16; float* rsq_n2 = rsq_base + (size_t)(2 * i + 1) * MG * 16; float* rsq_nx = rsq_base + (size_t)(2 * i + 2) * MG * 16;
            if ((i & 1) == 0) {
                if (EN(2) && RUN()) {
                    pg8::Gemm gm{XB, (const bf16*)(ws + WS_WMI) + (size_t)j * 2048 * D, MG, 2048, D}; pg8::StaticOrder S; S.init(MG, 2048, G, c);
                    pg8::EpiProj<0> E{(bf16*)(ws + WS_BIG), 2048, rsq_n1, 0, 1.f, nullptr, 0};
                    pg8::gemm_phase<pg8::EpiProj<0>, pg8::StaticOrder, true, true>(glds, gm, S, E);
                }
                SEAM();
                if (EN(3) && RUN()) phase_stencil(args, g, j);
                SEAM();
                if (EN(4) && RUN()) {
                    pg8::Gemm gm{(const bf16*)(ws + WS_BIG + 64 * MiB), (const bf16*)(ws + WS_WMO) + (size_t)j * D * D, MG, D, D}; pg8::StaticOrder S; S.init(MG, D, G, c);
                    pg8::EpiRes E{xg, XB, rsq_n2};
                    pg8::gemm_phase<pg8::EpiRes, pg8::StaticOrder, true, true>(glds, gm, S, E);
                }
                SEAM();
            } else {
                if (EN(5) && RUN()) {
                    pg8::Gemm gm{XB, (const bf16*)(ws + WS_WQKV) + (size_t)j * 3072 * D, MG, 3072, D}; pg8::StaticOrder S; S.init(MG, 3072, G, c);
                    pg8::EpiProj<1> E{(bf16*)(ws + WS_BIG), 1024, rsq_n1, (size_t)MG * 1024, QSCALE, (unsigned*)(ws + WS_CTL) + CW_NRM + 256 * (g * 2 + j), g ? 14 : 13};
                    pg8::gemm_phase<pg8::EpiProj<1>, pg8::StaticOrder, true, true>(glds, gm, S, E);
                }
                SEAM();
                if (EN(6) && RUN()) phase_attention(args, g, i, (char*)lds);
                SEAM();
                if (EN(7) && RUN()) {
                    pg8::Gemm gm{(const bf16*)(ws + WS_BIG), (const bf16*)(ws + WS_WAO) + (size_t)j * D * D, MG, D, D}; pg8::StaticOrder S; S.init(MG, D, G, c);
                    pg8::EpiRes E{xg, XB, rsq_n2};
                    pg8::gemm_phase<pg8::EpiRes, pg8::StaticOrder, true, true>(glds, gm, S, E);
                }
                SEAM();
            }
            if (EN(8) && RUN()) {
                pg8::Gemm gm{XB, (const bf16*)(ws + WS_W1) + (size_t)i * FF * D, MG, FF, D}; pg8::StaticOrder S; S.init(MG, FF, G, c);
                pg8::EpiProj<2> E{(bf16*)(ws + WS_BIG), FF, rsq_n2, 0, 1.f, nullptr, 0};
                pg8::gemm_phase<pg8::EpiProj<2>, pg8::StaticOrder, true, true>(glds, gm, S, E);
            }
            SEAM();
            if (EN(9) && RUN()) {
                pg8::Gemm gm{(const bf16*)(ws + WS_BIG), (const bf16*)(ws + WS_W2) + (size_t)i * D * FF, MG, D, FF}; pg8::StaticOrder S; S.init(MG, D, G, c);
                pg8::EpiRes E{xg, XB, rsq_nx};
                pg8::gemm_phase<pg8::EpiRes, pg8::StaticOrder, true, true>(glds, gm, S, E);
            }
            SEAM();
        }
        if (EN(10) && RUN()) phase_final(args, g);
        SEAM();
    }
#undef RUN
#undef SEAM
}

extern "C" void kernel_launch(void* const* d_in, const int* in_sizes, int n_in, void* d_out, int out_size, void* d_ws, size_t ws_size, hipStream_t stream) {
    static int grid = 0;
    if (grid == 0) {
        if (n_in != 19 || in_sizes[0] != MG * D || in_sizes[1] != MG * D || out_size != MTOT * D || ws_size < WS_END) {
            fprintf(stderr, "kernel_launch: unexpected shapes: n_in %d in0 %d in1 %d out %d ws %zu (need %zu); nothing launched\n", n_in, n_in > 0 ? in_sizes[0] : -1, n_in > 1 ? in_sizes[1] : -1, out_size, ws_size, (size_t)WS_END);
            grid = -1; return; }
        int dev = 0, cus = 0, per_cu = 0;
        hipGetDevice(&dev);
        hipDeviceGetAttribute(&cus, hipDeviceAttributeMultiprocessorCount, dev);
        if (hipFuncSetAttribute((const void*)fwd_megakernel, hipFuncAttributeMaxDynamicSharedMemorySize, LDS_BYTES) != hipSuccess) { fprintf(stderr, "kernel_launch: hipFuncSetAttribute failed\n"); grid = -1; return; }
        if (hipOccupancyMaxActiveBlocksPerMultiprocessor(&per_cu, (const void*)fwd_megakernel, NTHREADS, LDS_BYTES) != hipSuccess || per_cu < 1) { fprintf(stderr, "kernel_launch: occupancy query failed (%d)\n", per_cu); per_cu = 1; }
        (void)hipGetLastError();
        grid = cus * per_cu;
        if (grid > 256) grid = 256;
    }
    if (grid < 0) return;
    Args a{};
    for (int i = 0; i < 19; ++i) a.in[i] = (const float*)d_in[i];
    a.out = (float*)d_out; a.ws = (unsigned char*)d_ws;
#if MK_PER_PHASE
    for (int p = 0; p < N_PHASES; ++p) {
        a.ph_lo = p; a.ph_hi = p + 1;
        void* kargs[] = {&a};
        hipError_t e = hipLaunchCooperativeKernel((const void*)fwd_megakernel, dim3(grid), dim3(NTHREADS), kargs, LDS_BYTES, stream);
        if (e != hipSuccess) { fprintf(stderr, "kernel_launch: cooperative launch %d failed: %s\n", p, hipGetErrorString(e)); break; }
    }
#else
    a.ph_lo = 0; a.ph_hi = N_PHASES;
    void* kargs[] = {&a};
    hipError_t e = hipLaunchCooperativeKernel((const void*)fwd_megakernel, dim3(grid), dim3(NTHREADS), kargs, LDS_BYTES, stream);
    if (e != hipSuccess) fprintf(stderr, "kernel_launch: cooperative launch failed: %s (grid %d)\n", hipGetErrorString(e), grid);
#endif
}
```

```cpp
#include <hip/hip_runtime.h>
#include <hip/hip_cooperative_groups.h>
#include <cstdio>
#include <cstdint>
namespace cg = cooperative_groups;

#ifndef MK_WINDOW
#define MK_WINDOW 1
#endif
#ifndef MK_PROBE
#define MK_PROBE 0
#endif
#ifndef MK_PROBE_A
#define MK_PROBE_A (1 << 7)
#endif
#ifndef MK_PROBE_B
#define MK_PROBE_B ((1 << 3) | (1 << 5) | (1 << 6) | (1 << 8) | (1 << 9) | (1 << 10))
#endif
#ifndef MK_DUP
#define MK_DUP 1
#endif
#ifndef MK_DUP_ATT
#define MK_DUP_ATT 1
#endif
#ifndef MK_DUP_MISC
#define MK_DUP_MISC 0
#endif
#ifndef MK_DUP_RES
#define MK_DUP_RES 0
#endif
#ifndef MK_PER_PHASE
#define MK_PER_PHASE 0
#endif

__device__ __forceinline__ int mk_tid() { int t = threadIdx.x; asm volatile("" : "+v"(t)); return t; }

template <int M> __device__ __forceinline__ float xor_lt32(float v) { return __int_as_float(__builtin_amdgcn_ds_swizzle(__float_as_int(v), (M << 10) | 0x1f)); }
__device__ __forceinline__ float sum_x32(float v) { auto rr = __builtin_amdgcn_permlane32_swap(__float_as_uint(v), __float_as_uint(v), false, false); return __uint_as_float(rr[0]) + __uint_as_float(rr[1]); }

namespace pg8 {
#define PG8_LAS __attribute__((address_space(3)))
typedef unsigned short bf16_t;
typedef short bf16x8 __attribute__((ext_vector_type(8)));
typedef float f32x4 __attribute__((ext_vector_type(4)));
typedef unsigned u32x4 __attribute__((ext_vector_type(4)));
constexpr int BM = 256, BK = 64, HALF = 128, HTB = HALF * BK * 2  , STAGE_BYTES = 8 * HTB, NXCD = 8, WGM = 8;

__host__ __device__ __forceinline__ int lds_byte(int r, int c) { const int st = (r >> 4) * 2 + (c >> 5), rr = r & 15, cc = c & 31, ob = rr * 64 + cc * 2; return st * 1024 + (ob ^ (((ob >> 9) & 1) << 5)); }
__host__ __device__ __forceinline__ void stage_rc(int b, int& R, int& C) { const int st = b / 1024, sb = b % 1024, swz = sb ^ (((sb >> 9) & 1) << 5); R = (st >> 1) * 16 + swz / 64; C = (st & 1) * 32 + (swz % 64) / 2; }
__host__ __device__ __forceinline__ int perm32(int rho) { const int n = rho >> 4, i = rho & 15; return 8 * (i >> 2) + 4 * n + (i & 3); }

struct Unit { int pm, pn; };
struct Gemm { const bf16_t* A; const bf16_t* Bt; int M, N, K; };

struct StaticOrder {
    int nM, nN, nwg, G, c;
    __host__ __device__ void init(int M, int N, int G_, int c_) { nM = M / BM; nN = N / BM; nwg = nM * nN; G = G_; c = c_; }
    __host__ __device__ bool next(int i, Unit& u) const {
        const long L = (long)i * G + c; if (L >= nwg) return false;
        int wgid = (int)L; { const int q = nwg / NXCD, r = nwg % NXCD, xcd = wgid % NXCD, off = wgid / NXCD; wgid = (xcd < r ? xcd * (q + 1) : r * (q + 1) + (xcd - r) * q) + off; }
        const int nig = WGM * nN, gid = wgid / nig, fm = gid * WGM, gsz = (nM - fm) < WGM ? (nM - fm) : WGM;
        u.pm = fm + ((wgid % nig) % gsz); u.pn = (wgid % nig) / gsz; return true;
    }
    __device__ __forceinline__ void a_ready(const Unit&) const {}
    __device__ __forceinline__ void done(const Unit&) const {}
};

__device__ __forceinline__ unsigned cvt_pk_bf16(float lo, float hi) { unsigned r; asm volatile("v_cvt_pk_bf16_f32 %0, %1, %2" : "=v"(r) : "v"(lo), "v"(hi)); return r; }
typedef float f32x2 __attribute__((ext_vector_type(2)));
template <int MODE> struct EpiProj {
    static constexpr bool PERM = true, AFTER_DRAIN = false;
    bf16_t* O; int ldc; const float* rowsq; size_t split_stride; float scale0; unsigned* nrm; int logS;
    __device__ __forceinline__ void operator()(const f32x4 (&acc)[2][2][4][2], const Unit& u, int wr, int wc, int fr, int fq) const {
        const int row0 = u.pm * BM + wr * 64 + fr; int colt = u.pn * BM; bf16_t* base = O; float sc = 1.f; int t = 0;
        if (MODE == 1) { t = colt >> 10; base += (size_t)t * split_stride; colt &= 1023; if (t == 0) sc = scale0; }
        const int col0 = colt + wc * 32 + 8 * fq;
        float nmx[2] = {0.f, 0.f};
#pragma unroll
        for (int ai = 0; ai < 2; ++ai)
#pragma unroll
            for (int m = 0; m < 4; ++m) {
                const int row = row0 + ai * HALF + m * 16;
                float rsum;
                { const f32x4* rp = (const f32x4*)(rowsq + (size_t)row * 16); const f32x4 a0 = rp[0], a1 = rp[1], a2 = rp[2], a3 = rp[3];
                  rsum = (((a0[0] + a0[1]) + (a0[2] + a0[3])) + ((a1[0] + a1[1]) + (a1[2] + a1[3]))) + (((a2[0] + a2[1]) + (a2[2] + a2[3])) + ((a3[0] + a3[1]) + (a3[2] + a3[3]))); }
                const float rs = __builtin_amdgcn_rsqf(rsum * (1.0f / 1024.0f) + 1e-6f) * sc;
                bf16_t* rowp = base + (size_t)row * ldc + col0;
#pragma unroll
                for (int bj = 0; bj < 2; ++bj) {
                    f32x4 v0 = acc[ai][bj][m][0] * rs, v1 = acc[ai][bj][m][1] * rs;
                    if (MODE == 2) {
#pragma unroll
                        for (int e = 0; e < 4; ++e) { const float a = fmaxf(v0[e], 0.f), b = fmaxf(v1[e], 0.f); v0[e] = a * a; v1[e] = b * b; }
                    }
                    if (MODE == 1) {
                        float s = (v0[0] * v0[0] + v0[1] * v0[1]) + (v0[2] * v0[2] + v0[3] * v0[3]) + (v1[0] * v1[0] + v1[1] * v1[1]) + (v1[2] * v1[2] + v1[3] * v1[3]);
                        s += xor_lt32<16>(s); s = sum_x32(s);
                        nmx[bj] = fmaxf(nmx[bj], s);
                    }
                    u32x4 w; w.x = cvt_pk_bf16(v0[0], v0[1]); w.y = cvt_pk_bf16(v0[2], v0[3]); w.z = cvt_pk_bf16(v1[0], v1[1]); w.w = cvt_pk_bf16(v1[2], v1[3]);
                    *(u32x4*)(rowp + bj * HALF) = w;
                }
            }
        if (MODE == 1) {
            if (t < 2) {
                const int b = (u.pm * BM) >> logS;
#pragma unroll
                for (int bj = 0; bj < 2; ++bj) {
                    float v = nmx[bj];
                    v = fmaxf(v, xor_lt32<1>(v)); v = fmaxf(v, xor_lt32<2>(v)); v = fmaxf(v, xor_lt32<4>(v)); v = fmaxf(v, xor_lt32<8>(v));
                    const int map = (colt >> 6) + 2 * bj + (wc >> 1), half = wc & 1;
                    if (fr == 0 && fq == 0) atomicMax(nrm + (((t * 2 + b) * 16 + map) * 2 + half), __float_as_uint(v));
                }
            }
        }
    }
};
struct EpiRes {
    static constexpr bool PERM = false, AFTER_DRAIN = false;
    float* x; bf16_t* xb; float* rowsq; int dry;
    __device__ __forceinline__ void operator()(const f32x4 (&acc)[2][2][4][2], const Unit& u, int wr, int wc, int fr, int fq) const {
        typedef unsigned u32x2v __attribute__((ext_vector_type(2)));
        const int col0 = u.pn * BM + wc * 32 + 4 * fq;
#pragma unroll
        for (int ai = 0; ai < 2; ++ai)
#pragma unroll
            for (int m = 0; m < 4; ++m) {
                const int row = u.pm * BM + ai * HALF + wr * 64 + m * 16 + fr; const size_t off = (size_t)row * 1024 + col0;
                float ss = 0.f;
#pragma unroll
                for (int bj = 0; bj < 2; ++bj)
#pragma unroll
                    for (int n = 0; n < 2; ++n) {
                        const f32x4 xo = *(const f32x4*)(x + off + bj * HALF + n * 16);
                        const f32x4 xn = xo + acc[ai][bj][m][n];
                        *(f32x4*)(x + off + bj * HALF + n * 16) = dry ? xo : xn;
                        ss += (xn[0] * xn[0] + xn[1] * xn[1]) + (xn[2] * xn[2] + xn[3] * xn[3]);
                        u32x2v w; w.x = cvt_pk_bf16(xn[0], xn[1]); w.y = cvt_pk_bf16(xn[2], xn[3]);
                        *(u32x2v*)(xb + off + bj * HALF + n * 16) = w;
                    }
                ss += xor_lt32<16>(ss); ss = sum_x32(ss);
                if (fq == 0) rowsq[(size_t)row * 16 + u.pn * 4 + wc] = ss;
            }
    }
};

struct EpiNull {
    static constexpr bool PERM = false, AFTER_DRAIN = false;
    __device__ __forceinline__ void operator()(const f32x4 (&acc)[2][2][4][2], const Unit& u, int wr, int wc, int fr, int fq) const {
#pragma unroll
        for (int ai = 0; ai < 2; ++ai)
#pragma unroll
            for (int bj = 0; bj < 2; ++bj)
#pragma unroll
                for (int m = 0; m < 4; ++m)
#pragma unroll
                    for (int n = 0; n < 2; ++n) asm volatile("" :: "v"(acc[ai][bj][m][n]));
    }
};

template <class Epi, class Sched, bool ALIGN_EPI = false, bool SP2 = false>
__device__ __forceinline__ void gemm_phase(PG8_LAS unsigned char* lds, const Gemm g, const Sched& S, const Epi& E) {
    const int tid = mk_tid(), wid = __builtin_amdgcn_readfirstlane(tid >> 6), lane = tid & 63, wr = wid >> 2, wc = wid & 3, fr = lane & 15, fq = lane >> 4;
    const int K = g.K, nt = K / BK;
    unsigned voffA[2], voffB[2];
#pragma unroll
    for (int i = 0; i < 2; ++i) { int R, C; stage_rc(tid * 16 + i * 8192, R, C); const int Rb = Epi::PERM ? ((R & ~31) + perm32(R & 31)) : R;
        voffA[i] = (unsigned)(R * K + C) * 2u; voffB[i] = (unsigned)(Rb * K + C) * 2u; }
    const size_t kstep = (size_t)(BK * 2);
    const size_t hstep = (size_t)HALF * K * 2;
    const size_t tstep = 2 * hstep;
    const unsigned ldsw = (unsigned)wid * 1024u;
    const int aoff = lds_byte(wr * 64 + fr, fq * 8), boff = lds_byte(wc * 32 + fr, fq * 8);
#define PG8_SA(b, h) (((b) * 2 + (h)) * HTB)
#define PG8_SB(b, h) ((4 + (b) * 2 + (h)) * HTB)
#define PG8_STAGE(bufoff, gbase, voff) do { _Pragma("unroll") for (int _i = 0; _i < 2; ++_i) \
        __builtin_amdgcn_global_load_lds((const unsigned*)((const char*)(gbase) + (voff)[_i]), (PG8_LAS unsigned*)(lds + (bufoff) + ldsw + _i * 8192), 16, 0, 0); } while (0)
#define PG8_LDA(dst, b, h) do { _Pragma("unroll") for (int m = 0; m < 4; ++m) _Pragma("unroll") for (int k = 0; k < 2; ++k) dst[m][k] = *(const PG8_LAS bf16x8*)(lds + PG8_SA(b, h) + aoff + m * 2048 + k * 1024); } while (0)
#define PG8_LDB(dst, b, h) do { _Pragma("unroll") for (int n = 0; n < 2; ++n) _Pragma("unroll") for (int k = 0; k < 2; ++k) dst[n][k] = *(const PG8_LAS bf16x8*)(lds + PG8_SB(b, h) + boff + n * 2048 + k * 1024); } while (0)
#define PG8_MMA(ai, bj, At, Bt) do { __builtin_amdgcn_s_setprio(1); _Pragma("unroll") for (int m = 0; m < 4; ++m) _Pragma("unroll") for (int n = 0; n < 2; ++n) _Pragma("unroll") for (int k = 0; k < 2; ++k) \
        acc[ai][bj][m][n] = __builtin_amdgcn_mfma_f32_16x16x32_bf16(Bt[n][k], At[m][k], acc[ai][bj][m][n], 0, 0, 0); __builtin_amdgcn_s_setprio(0); } while (0)
#define PG8_WAIT_V(n) asm volatile("s_waitcnt vmcnt(" #n ")" ::: "memory")
#define PG8_WAIT_L(n) asm volatile("s_waitcnt lgkmcnt(" #n ")" ::: "memory")
#define PG8_BAR __builtin_amdgcn_s_barrier()
#define PG8_SCHED __builtin_amdgcn_sched_barrier(0)
    Unit cur, nxt; int ui = 0;
    if (!S.next(0, cur)) return;
    f32x4 acc[2][2][4][2];
#pragma unroll
    for (int a = 0; a < 2; ++a)
#pragma unroll
        for (int b = 0; b < 2; ++b)
#pragma unroll
            for (int m = 0; m < 4; ++m)
#pragma unroll
                for (int n = 0; n < 2; ++n) acc[a][b][m][n] = (f32x4){0.f, 0.f, 0.f, 0.f};
    bf16x8 At[4][2], B0[2][2], B1[2][2];
    const char* cA = (const char*)g.A + (size_t)cur.pm * tstep; const char* cB = (const char*)g.Bt + (size_t)cur.pn * tstep;
    S.a_ready(cur);
    if constexpr (SP2) {
        PG8_STAGE(PG8_SB(0, 0), cB, voffB); PG8_STAGE(PG8_SB(0, 1), cB + hstep, voffB); PG8_STAGE(PG8_SA(0, 0), cA, voffA); PG8_STAGE(PG8_SA(0, 1), cA + hstep, voffA);
        if (wr == 1) PG8_BAR;
        PG8_WAIT_V(2); PG8_BAR;
        PG8_STAGE(PG8_SB(1, 0), cB + kstep, voffB); PG8_STAGE(PG8_SA(1, 0), cA + kstep, voffA); PG8_STAGE(PG8_SB(1, 1), cB + hstep + kstep, voffB);
        PG8_WAIT_V(6); PG8_BAR;
    } else {
        PG8_STAGE(PG8_SB(0, 0), cB, voffB); PG8_STAGE(PG8_SA(0, 0), cA, voffA); PG8_STAGE(PG8_SB(0, 1), cB + hstep, voffB); PG8_STAGE(PG8_SA(0, 1), cA + hstep, voffA);
        if (wr == 1) PG8_BAR;
        PG8_WAIT_V(4); PG8_BAR;
        PG8_STAGE(PG8_SB(1, 0), cB + kstep, voffB); PG8_STAGE(PG8_SA(1, 0), cA + kstep, voffA); PG8_STAGE(PG8_SB(1, 1), cB + hstep + kstep, voffB);
        PG8_WAIT_V(6); PG8_BAR;
    }
    for (;;) {
        const bool has_next = S.next(ui + 1, nxt);
        const char* nA = has_next ? (const char*)g.A + (size_t)nxt.pm * tstep : cA; const char* nB = has_next ? (const char*)g.Bt + (size_t)nxt.pn * tstep : cB;
        for (int t = 0; t < nt; t += 2) {
            const bool last = (t == nt - 2);
            const char* a1 = cA + (size_t)(t + 1) * kstep;
            const char* a2 = last ? nA : cA + (size_t)(t + 2) * kstep; const char* b2 = last ? nB : cB + (size_t)(t + 2) * kstep;
            const char* a3 = a2 + kstep; const char* b3 = b2 + kstep;
            if (last && has_next) S.a_ready(nxt);
            if constexpr (SP2) {
            PG8_LDB(B0, 0, 0); PG8_LDB(B1, 0, 1); PG8_SCHED; PG8_LDA(At, 0, 0); PG8_STAGE(PG8_SA(1, 1), a1 + hstep, voffA);
            PG8_WAIT_V(8); PG8_WAIT_L(0); PG8_BAR; PG8_MMA(0, 0, At, B0); PG8_MMA(0, 1, At, B1); PG8_BAR; PG8_SCHED;
            PG8_LDA(At, 0, 1); PG8_STAGE(PG8_SB(0, 0), b2, voffB); PG8_STAGE(PG8_SB(0, 1), b2 + hstep, voffB); PG8_STAGE(PG8_SA(0, 0), a2, voffA);
            PG8_WAIT_V(8); PG8_WAIT_L(0); PG8_BAR; PG8_MMA(1, 0, At, B0); PG8_MMA(1, 1, At, B1); PG8_BAR; PG8_SCHED;
            PG8_LDB(B0, 1, 0); PG8_LDB(B1, 1, 1); PG8_SCHED; PG8_LDA(At, 1, 0); PG8_STAGE(PG8_SA(0, 1), a2 + hstep, voffA);
            PG8_WAIT_V(8); PG8_WAIT_L(0); PG8_BAR; PG8_MMA(0, 0, At, B0); PG8_MMA(0, 1, At, B1); PG8_BAR; PG8_SCHED;
            PG8_LDA(At, 1, 1); PG8_STAGE(PG8_SB(1, 0), b3, voffB); PG8_STAGE(PG8_SB(1, 1), b3 + hstep, voffB); PG8_STAGE(PG8_SA(1, 0), a3, voffA);
            PG8_WAIT_V(8); PG8_WAIT_L(0); PG8_BAR; PG8_MMA(1, 0, At, B0); PG8_MMA(1, 1, At, B1); PG8_BAR; PG8_SCHED;
            } else {
            PG8_LDB(B0, 0, 0); PG8_SCHED; PG8_LDA(At, 0, 0); PG8_STAGE(PG8_SA(1, 1), a1 + hstep, voffA);
            PG8_WAIT_L(8); PG8_BAR; PG8_WAIT_L(0); PG8_MMA(0, 0, At, B0); PG8_BAR; PG8_SCHED;
            PG8_LDB(B1, 0, 1); PG8_STAGE(PG8_SB(0, 0), b2, voffB);
            PG8_BAR; PG8_WAIT_L(0); PG8_MMA(0, 1, At, B1); PG8_BAR;
            PG8_LDA(At, 0, 1); PG8_STAGE(PG8_SA(0, 0), a2, voffA);
            PG8_BAR; PG8_WAIT_L(0); PG8_MMA(1, 0, At, B0); PG8_BAR; PG8_SCHED;
            PG8_STAGE(PG8_SB(0, 1), b2 + hstep, voffB);
            PG8_WAIT_V(6); PG8_BAR; PG8_MMA(1, 1, At, B1); PG8_BAR;
            PG8_LDB(B0, 1, 0); PG8_SCHED; PG8_LDA(At, 1, 0); PG8_STAGE(PG8_SA(0, 1), a2 + hstep, voffA);
            PG8_WAIT_L(8); PG8_BAR; PG8_WAIT_L(0); PG8_MMA(0, 0, At, B0); PG8_BAR; PG8_SCHED;
            PG8_LDB(B1, 1, 1); PG8_STAGE(PG8_SB(1, 0), b3, voffB);
            PG8_BAR; PG8_WAIT_L(0); PG8_MMA(0, 1, At, B1); PG8_BAR;
            PG8_LDA(At, 1, 1); PG8_STAGE(PG8_SA(1, 0), a3, voffA);
            PG8_BAR; PG8_WAIT_L(0); PG8_MMA(1, 0, At, B0); PG8_BAR; PG8_SCHED;
            PG8_STAGE(PG8_SB(1, 1), b3 + hstep, voffB);
            PG8_WAIT_V(6); PG8_BAR; PG8_MMA(1, 1, At, B1); PG8_BAR;
            }
        }
        if constexpr (ALIGN_EPI) { if (wr == 0) PG8_BAR; }
        if constexpr (!Epi::AFTER_DRAIN) { E(acc, cur, wr, wc, fr, fq); S.done(cur); }
        if (!has_next) break;
#pragma unroll
        for (int a = 0; a < 2; ++a)
#pragma unroll
            for (int b = 0; b < 2; ++b)
#pragma unroll
                for (int m = 0; m < 4; ++m)
#pragma unroll
                    for (int n = 0; n < 2; ++n) acc[a][b][m][n] = (f32x4){0.f, 0.f, 0.f, 0.f};
        cur = nxt; cA = nA; cB = nB; ++ui;
        if constexpr (ALIGN_EPI) { if (wr == 1) PG8_BAR; }
    }
    PG8_WAIT_V(0);
    if constexpr (!ALIGN_EPI) { if (wr == 0) PG8_BAR; }
    PG8_BAR;
    if constexpr (Epi::AFTER_DRAIN) { E.fused(acc, cur, wr, wc, fr, fq, lds, wid, lane); S.done(cur); }
#undef PG8_SA
#undef PG8_SB
#undef PG8_STAGE
#undef PG8_LDA
#undef PG8_LDB
#undef PG8_MMA
#undef PG8_WAIT_V
#undef PG8_WAIT_L
#undef PG8_BAR
#undef PG8_SCHED
}
}

namespace att {
typedef unsigned short bf16_t;
using bf16x8 = __attribute__((ext_vector_type(8))) short;
using s16x4  = __attribute__((ext_vector_type(4))) short;
using f32x16 = __attribute__((ext_vector_type(16))) float;
using u32x4  = __attribute__((ext_vector_type(4))) unsigned;
constexpr int NW = 8, QBLK = 32, KVBLK = 64, LD = 1024;
constexpr int SHM_V = KVBLK * 128 * 2, SHM_K = KVBLK * 64 * 2;
constexpr int OFF_V = 0, OFF_K = 2 * SHM_V, OFF_WS = OFF_K + 2 * SHM_K, OFF_UNIT = OFF_WS + NW * 64 * 4, LDS_BYTES = OFF_UNIT + 128;
constexpr int SDEPTH = 1;
constexpr float THR2 = 10.f;
#define KSWZ(row, colB) ((row) * 128 + ((colB) ^ ((((row) >> 1) & 7) << 4)))
#define SBAR() __builtin_amdgcn_sched_barrier(0)
#define SGB_MFMA_VALU(N, V) do { _Pragma("unroll") for (int _g = 0; _g < (N); ++_g) { __builtin_amdgcn_sched_group_barrier(0x008, 1, 0); __builtin_amdgcn_sched_group_barrier(0x400, (V), 0); } } while (0)
__device__ __forceinline__ int crow(int r, int hi) { return (r & 3) + 8 * (r >> 2) + 4 * hi; }
__device__ __forceinline__ unsigned cvtpk(float lo, float hi) { unsigned r; asm volatile("v_cvt_pk_bf16_f32 %0, %1, %2" : "=v"(r) : "v"(lo), "v"(hi)); return r; }

__device__ __forceinline__ void split3(float a, unsigned& h, unsigned& l, unsigned& ll) {
  h = cvtpk(a, 0.f) & 0xffffu; const float r1 = a - __uint_as_float(h << 16);
  l = cvtpk(r1, 0.f) & 0xffffu; const float r2 = r1 - __uint_as_float(l << 16);
  ll = cvtpk(r2, 0.f) & 0xffffu;
}
__device__ __forceinline__ void tile_ctl(int rel, float dq, float m_reg, float nc2, float smax, int hi, bf16x8& qx, int& mode, bool& skip) {
  mode = (rel <= -64) ? 1 : (rel >= 32) ? 2 : 0;
  const float dmin = (mode == 1) ? (float)(-rel - 63) : (float)(rel - 31);
  skip = (mode != 0) && (smax + nc2 * dmin <= THR2);
  const float A = (mode == 1 ? nc2 * dq : -nc2 * dq) - m_reg;
  unsigned ah, al, all_; split3(A, ah, al, all_);
  const unsigned sg = (mode == 1) ? 0x3F80u : 0xBF80u;
  u32x4 w = {ah | (al << 16), all_ | (sg << 16), sg | (sg << 16), 0u};
  if (hi != 0 || mode == 0) w = u32x4{0u, 0u, 0u, 0u};
  qx = *reinterpret_cast<bf16x8*>(&w);
}
__device__ __forceinline__ void partialSM(f32x16& p0, f32x16& p1, float& m_reg, float& alpha, int mode, bool skip, float dqh, float nc2) {
  if (mode == 0) {
    const float dq1 = dqh - 32.f;
#pragma unroll
    for (int r = 0; r < 16; ++r) p0[r] = fmaf(__builtin_fabsf(dqh - (float)((r & 3) + 8 * (r >> 2))), nc2, p0[r]) - m_reg;
#pragma unroll
    for (int r = 0; r < 16; ++r) p1[r] = fmaf(__builtin_fabsf(dq1 - (float)((r & 3) + 8 * (r >> 2))), nc2, p1[r]) - m_reg;
  }
  alpha = 1.f;
  if (!skip) {
    float pmax = p0[0];
#pragma unroll
    for (int r = 1; r < 16; ++r) pmax = fmaxf(pmax, p0[r]);
#pragma unroll
    for (int r = 0; r < 16; ++r) pmax = fmaxf(pmax, p1[r]);
    { auto rr = __builtin_amdgcn_permlane32_swap(__float_as_uint(pmax), __float_as_uint(pmax), false, false);
      pmax = fmaxf(__uint_as_float(rr[0]), __uint_as_float(rr[1])); }
    if (__builtin_expect(!__all(pmax <= THR2), 0)) {
      const float dl = fmaxf(pmax, 0.f); m_reg += dl; alpha = __builtin_amdgcn_exp2f(-dl);
#pragma unroll
      for (int r = 0; r < 16; ++r) p0[r] -= dl;
#pragma unroll
      for (int r = 0; r < 16; ++r) p1[r] -= dl;
    }
  }
}
__device__ __forceinline__ void expP0(f32x16& p0) {
#pragma unroll
  for (int r = 0; r < 16; ++r) p0[r] = __builtin_amdgcn_exp2f(p0[r]);
}
__device__ __forceinline__ void finishSM(f32x16& p0, f32x16& p1, float alpha, float& l_reg, bf16x8& pa0, bf16x8& pa1, bf16x8& pa2, bf16x8& pa3) {
#pragma unroll
  for (int r = 0; r < 16; ++r) p1[r] = __builtin_amdgcn_exp2f(p1[r]);
  float ps = 0;
#pragma unroll
  for (int r = 0; r < 16; ++r) ps += p0[r];
#pragma unroll
  for (int r = 0; r < 16; ++r) ps += p1[r];
  { auto rr = __builtin_amdgcn_permlane32_swap(__float_as_uint(ps), __float_as_uint(ps), false, false);
    ps = __uint_as_float(rr[0]) + __uint_as_float(rr[1]); }
  l_reg = l_reg * alpha + ps;
#define PK4(P, BASE, OUT) do { unsigned a0 = cvtpk(P[BASE + 0], P[BASE + 1]), a1 = cvtpk(P[BASE + 2], P[BASE + 3]);   \
    unsigned b0 = cvtpk(P[BASE + 4], P[BASE + 5]), b1 = cvtpk(P[BASE + 6], P[BASE + 7]);                              \
    auto r0 = __builtin_amdgcn_permlane32_swap(a0, b0, false, false); auto r1 = __builtin_amdgcn_permlane32_swap(a1, b1, false, false); \
    u32x4 w = {r0[0], r1[0], r0[1], r1[1]}; OUT = *reinterpret_cast<bf16x8*>(&w); } while (0)
  PK4(p0, 0, pa0); PK4(p0, 8, pa1); PK4(p1, 0, pa2); PK4(p1, 8, pa3);
#undef PK4
}
__device__ __forceinline__ void qkt(f32x16& p0, f32x16& p1, const char* Ks, const bf16x8* qr, int r32, int hi, bf16x8 kx0, bf16x8 kx1, bf16x8 qx) {
  p0 = __builtin_amdgcn_mfma_f32_32x32x16_bf16(kx0, qx, f32x16{}, 0, 0, 0); p1 = __builtin_amdgcn_mfma_f32_32x32x16_bf16(kx1, qx, f32x16{}, 0, 0, 0);
#pragma unroll
  for (int d0 = 0; d0 < 4; ++d0) { const int cb = d0 * 32 + hi * 16;
    bf16x8 b0 = *reinterpret_cast<const bf16x8*>(Ks + KSWZ(r32, cb));
    bf16x8 b1 = *reinterpret_cast<const bf16x8*>(Ks + KSWZ(32 + r32, cb));
    p0 = __builtin_amdgcn_mfma_f32_32x32x16_bf16(b0, qr[d0], p0, 0, 0, 0);
    p1 = __builtin_amdgcn_mfma_f32_32x32x16_bf16(b1, qr[d0], p1, 0, 0, 0); }
}
__device__ __forceinline__ int v_st(int k, int c) { const int kk = (k & ~0xC) | ((k & 4) << 1) | ((k & 8) >> 1); return ((kk >> 3) * 4 + (c >> 5)) * 512 + ((kk & 7) * 32 + (c & 31)) * 2; }
__device__ __forceinline__ int v_rd_base(int lane) { return ((lane & 3) << 3) | (((lane >> 2) & 3) << 6) | (((lane >> 4) & 1) << 5) | (((lane >> 5) & 1) << 8); }
constexpr int v_rd_off(int d0, int ks, int half) { return d0 * 512 + ks * 4096 + half * 2048; }
template <int OFF> __device__ __forceinline__ s16x4 tr_read(int vb) {
  s16x4 r; asm volatile("ds_read_b64_tr_b16 %0, %1 offset:%2" : "=&v"(r) : "v"(vb), "i"(OFF) : "memory"); return r;
}
#define PV_RD(D0, L, H) do { L[0] = tr_read<v_rd_off(D0, 0, 0)>(vb); H[0] = tr_read<v_rd_off(D0, 0, 1)>(vb); L[1] = tr_read<v_rd_off(D0, 1, 0)>(vb); H[1] = tr_read<v_rd_off(D0, 1, 1)>(vb); \
    L[2] = tr_read<v_rd_off(D0, 2, 0)>(vb); H[2] = tr_read<v_rd_off(D0, 2, 1)>(vb); L[3] = tr_read<v_rd_off(D0, 3, 0)>(vb); H[3] = tr_read<v_rd_off(D0, 3, 1)>(vb); } while (0)
#define PV_RD2(D0, KS, L, H) do { L[KS] = tr_read<v_rd_off(D0, KS, 0)>(vb); H[KS] = tr_read<v_rd_off(D0, KS, 1)>(vb); } while (0)
#define PV_WAIT(N, L, H) asm volatile("s_waitcnt lgkmcnt(" #N ")" : "+v"(L[0]), "+v"(H[0]), "+v"(L[1]), "+v"(H[1]), "+v"(L[2]), "+v"(H[2]), "+v"(L[3]), "+v"(H[3]))
#define PV_PK(L, H, KS) (bf16x8){L[KS][0], L[KS][1], L[KS][2], L[KS][3], H[KS][0], H[KS][1], H[KS][2], H[KS][3]}
#define PV_MF(D0, KS, PA, L, H, R) do { o[D0] = __builtin_amdgcn_mfma_f32_32x32x16_bf16(PA, PV_PK(L, H, KS), o[D0], 0, 0, 0); \
    if (EXPS) { px[R] = __builtin_amdgcn_exp2f(px[R]); asm volatile("" : "+v"(px)); } SBAR(); } while (0)
template <bool EXPS> __device__ __forceinline__ void pv_d0(f32x16* o, int vb, bf16x8 pa0, bf16x8 pa1, bf16x8 pa2, bf16x8 pa3, f32x16& px) {
  s16x4 la[4], ha[4], lb[4], hb[4];
  SBAR(); PV_RD(0, la, ha); SBAR();
  PV_RD2(1, 0, lb, hb); PV_WAIT(2, la, ha);  PV_MF(0, 0, pa0, la, ha, 0);
  PV_RD2(1, 1, lb, hb);                       PV_MF(0, 1, pa1, la, ha, 1);
  PV_RD2(1, 2, lb, hb);                       PV_MF(0, 2, pa2, la, ha, 2);
  PV_RD2(1, 3, lb, hb);                       PV_MF(0, 3, pa3, la, ha, 3);
  PV_RD2(2, 0, la, ha); PV_WAIT(2, lb, hb);  PV_MF(1, 0, pa0, lb, hb, 4);
  PV_RD2(2, 1, la, ha);                       PV_MF(1, 1, pa1, lb, hb, 5);
  PV_RD2(2, 2, la, ha);                       PV_MF(1, 2, pa2, lb, hb, 6);
  PV_RD2(2, 3, la, ha);                       PV_MF(1, 3, pa3, lb, hb, 7);
  PV_RD2(3, 0, lb, hb); PV_WAIT(2, la, ha);  PV_MF(2, 0, pa0, la, ha, 8);
  PV_RD2(3, 1, lb, hb);                       PV_MF(2, 1, pa1, la, ha, 9);
  PV_RD2(3, 2, lb, hb);                       PV_MF(2, 2, pa2, la, ha, 10);
  PV_RD2(3, 3, lb, hb);                       PV_MF(2, 3, pa3, la, ha, 11);
                        PV_WAIT(0, lb, hb);  PV_MF(3, 0, pa0, lb, hb, 12);
                                              PV_MF(3, 1, pa1, lb, hb, 13);
                                              PV_MF(3, 2, pa2, lb, hb, 14);
                                              PV_MF(3, 3, pa3, lb, hb, 15);
}

__device__ __forceinline__ void attn_pass(const bf16_t* __restrict__ Qw, const bf16_t* __restrict__ Kh, const bf16_t* __restrict__ Vh,
                                          int NT, float dqbase, int rel0, float nc2, float smax, f32x16 (&o)[4], char* lds) {
  const int tid = mk_tid(), wid = tid >> 6, lane = tid & 63, r32 = lane & 31, hi = lane >> 5;
  char* V_lds = lds + OFF_V; char* K_lds = lds + OFF_K;
  float* ws = (float*)(lds + OFF_WS) + wid * 64; float* li_l = ws; float* al_l = ws + 32;
  float m_reg = 0.f, l_reg = 0; bf16x8 qr[4];
#pragma unroll
  for (int d = 0; d < 4; ++d) o[d] = f32x16{};
#pragma unroll
  for (int d0 = 0; d0 < 4; ++d0) qr[d0] = *reinterpret_cast<const bf16x8*>(Qw + d0 * 16);
  const float dqh0 = dqbase - (float)(4 * hi);
  bf16x8 kx0, kx1;
  { unsigned bh, bl, bll; u32x4 w;
    split3(-nc2 * (float)r32, bh, bl, bll); w = u32x4{0x3F803F80u, 0x3F80u | (bh << 16), bl | (bll << 16), 0u}; if (hi) w = u32x4{0u, 0u, 0u, 0u}; kx0 = *reinterpret_cast<bf16x8*>(&w);
    split3(-nc2 * (float)(32 + r32), bh, bl, bll); w = u32x4{0x3F803F80u, 0x3F80u | (bh << 16), bl | (bll << 16), 0u}; if (hi) w = u32x4{0u, 0u, 0u, 0u}; kx1 = *reinterpret_cast<bf16x8*>(&w); }
  bf16x8 qx; int mdA, mdB; bool skA, skB;
#define CTL(j, MD, SK) tile_ctl(rel0 + (j) * KVBLK, dqbase - (float)((j) * KVBLK), m_reg, nc2, smax, hi, qx, MD, SK)
  const int sr = tid >> 4, sc = (tid & 15) * 8, vst0 = v_st(sr, sc), vst1 = v_st(32 + sr, sc);
  const int krow = tid >> 3, kcol = (tid & 7) * 8, kst = KSWZ(krow, kcol * 2);
  const int vb0 = (int)(uintptr_t)V_lds + v_rd_base(lane);
  struct { bf16x8 vs0, vs1, ks0; } sr_[SDEPTH];
#define SLOAD(i, k0) do { sr_[i].vs0 = *reinterpret_cast<const bf16x8*>(&Vh[(long)((k0) + sr) * LD + sc]); sr_[i].vs1 = *reinterpret_cast<const bf16x8*>(&Vh[(long)((k0) + 32 + sr) * LD + sc]); \
    sr_[i].ks0 = *reinterpret_cast<const bf16x8*>(&Kh[(long)((k0) + krow) * LD + kcol]); } while (0)
#define SWRITE(b, i) do { *(bf16x8*)(V_lds + (b) * SHM_V + vst0) = sr_[i].vs0; *(bf16x8*)(V_lds + (b) * SHM_V + vst1) = sr_[i].vs1; \
    *(bf16x8*)(K_lds + (b) * SHM_K + kst) = sr_[i].ks0; } while (0)
#define SWAIT() do { if constexpr (SDEPTH == 2) asm volatile("s_waitcnt vmcnt(3)" ::: "memory"); else asm volatile("s_waitcnt vmcnt(0)" ::: "memory"); } while (0)
#define RESC(a) do { if (__any((a) < 1.f)) { if (hi == 0) al_l[r32] = (a); asm volatile("s_waitcnt lgkmcnt(0)" ::: "memory"); \
    _Pragma("unroll") for (int d = 0; d < 4; ++d) _Pragma("unroll") for (int r = 0; r < 16; ++r) o[d][r] *= al_l[crow(r, hi)]; } } while (0)
  f32x16 pA0, pA1, pB0, pB1; float alA, alB; bf16x8 pa0, pa1, pa2, pa3;
  constexpr int SE = 0, SO = SDEPTH - 1;
  __syncthreads();
  SLOAD(SE, 0); asm volatile("s_waitcnt vmcnt(0)" ::: "memory"); SWRITE(0, SE); __syncthreads();
  CTL(0, mdA, skA); qkt(pA0, pA1, K_lds, qr, r32, hi, kx0, kx1, qx); partialSM(pA0, pA1, m_reg, alA, mdA, skA, dqh0, nc2); expP0(pA0);
  SLOAD(SO, KVBLK); if constexpr (SDEPTH == 2) { if (2 < NT) SLOAD(SE, 2 * KVBLK); }
  SWAIT(); SWRITE(1, SO); __syncthreads();
  for (int j = 1; j + 1 < NT; j += 2) {
    SBAR(); CTL(j, mdB, skB); qkt(pB0, pB1, K_lds + SHM_K, qr, r32, hi, kx0, kx1, qx);
    finishSM(pA0, pA1, alA, l_reg, pa0, pa1, pa2, pa3); SBAR();
    SLOAD(SO, (j + SDEPTH) * KVBLK); SBAR();
    partialSM(pB0, pB1, m_reg, alB, mdB, skB, dqh0 - (float)(j * KVBLK), nc2); SBAR();
    pv_d0<true>(o, vb0, pa0, pa1, pa2, pa3, pB0);
    __syncthreads(); SWAIT(); SWRITE(0, SE);
    RESC(alB); __syncthreads();
    SBAR(); CTL(j + 1, mdA, skA); qkt(pA0, pA1, K_lds, qr, r32, hi, kx0, kx1, qx);
    finishSM(pB0, pB1, alB, l_reg, pa0, pa1, pa2, pa3); SBAR();
    if (SDEPTH == 1 || j + 3 < NT) SLOAD(SE, (j + 1 + SDEPTH) * KVBLK); SBAR();
    partialSM(pA0, pA1, m_reg, alA, mdA, skA, dqh0 - (float)((j + 1) * KVBLK), nc2); SBAR();
    pv_d0<true>(o, vb0 + SHM_V, pa0, pa1, pa2, pa3, pA0);
    __syncthreads(); SWAIT(); SWRITE(1, SO);
    RESC(alA); __syncthreads();
  }
  SBAR(); CTL(NT - 1, mdB, skB); qkt(pB0, pB1, K_lds + SHM_K, qr, r32, hi, kx0, kx1, qx);
  finishSM(pA0, pA1, alA, l_reg, pa0, pa1, pa2, pa3); SBAR();
  partialSM(pB0, pB1, m_reg, alB, mdB, skB, dqh0 - (float)((NT - 1) * KVBLK), nc2); SBAR();
  pv_d0<true>(o, vb0, pa0, pa1, pa2, pa3, pB0);
  __syncthreads(); RESC(alB);
  finishSM(pB0, pB1, alB, l_reg, pa0, pa1, pa2, pa3); SBAR();
  pv_d0<false>(o, vb0 + SHM_V, pa0, pa1, pa2, pa3, pB0);
  if (hi == 0) li_l[r32] = l_reg; asm volatile("s_waitcnt lgkmcnt(0)" ::: "memory");
#pragma unroll
  for (int r = 0; r < 16; ++r) { const float rli = __builtin_amdgcn_rcpf(li_l[crow(r, hi)]);
#pragma unroll
    for (int d0 = 0; d0 < 4; ++d0) o[d0][r] *= rli; }
#undef CTL
#undef SLOAD
#undef SWRITE
#undef SWAIT
#undef RESC
}
}

typedef unsigned short bf16;
typedef unsigned v4u __attribute__((ext_vector_type(4)));
typedef unsigned v2u __attribute__((ext_vector_type(2)));
typedef float f32x4 __attribute__((ext_vector_type(4)));
#define LAS __attribute__((address_space(3)))
constexpr int NWAVES = 8, NTHREADS = 512;
constexpr int D = 1024, FF = 4096, MG = 16384, MTOT = 32768;
constexpr int DEPTH = 4;
constexpr float QSCALE = 0.125f * 1.4426950408889634f;
constexpr size_t MiB = 1u << 20;
constexpr size_t WS_CTL = 0, WS_ZERO_END = 64 * 1024;
constexpr size_t WS_WMI = 2 * MiB, WS_WMO = 10 * MiB, WS_WQKV = 14 * MiB, WS_WAO = 26 * MiB, WS_W1 = 30 * MiB, WS_W2 = 62 * MiB;
constexpr size_t WS_XB = 94 * MiB, WS_BIG = 126 * MiB, WS_ROWSQ = 254 * MiB, WS_END = WS_ROWSQ + 9 * (size_t)MG * 64;
static_assert(WS_ZERO_END <= WS_WMI, "ws map");
constexpr int CW_ATTCTR = 0;
constexpr int CW_ARR = 8192;
constexpr int CW_BAR = 4096;
constexpr int CW_NRM = 1024;

struct Args {
    const float* in[19]; float* out; unsigned char* ws; int ph_lo, ph_hi;
};

__device__ __forceinline__ unsigned f2bf(float f) { unsigned u = __builtin_bit_cast(unsigned, f); return (u + 0x7fffu + ((u >> 16) & 1u)) >> 16; }
__device__ __forceinline__ unsigned pk2(float lo, float hi) { return f2bf(lo) | (f2bf(hi) << 16); }
__device__ __forceinline__ float bflo(unsigned w) { return __uint_as_float(w << 16); }
__device__ __forceinline__ float bfhi(unsigned w) { return __uint_as_float(w & 0xffff0000u); }
__device__ __forceinline__ float wave_sum(float v) {
    v += xor_lt32<1>(v); v += xor_lt32<2>(v); v += xor_lt32<4>(v); v += xor_lt32<8>(v); v += xor_lt32<16>(v);
    return sum_x32(v);
}

__device__ __forceinline__ void transpose_item(const float* W, int ldw, int N, const float* gs, bf16* WT, int ldk, int koff, LAS float* scr, int item, int lane) {
    const int nblk = N / 32, kb = item / nblk, nb = item % nblk, k0 = 64 * kb, n0 = 32 * nb;
#pragma unroll
    for (int i = 0; i < 8; ++i) { const int kk = 8 * i + (lane >> 3), c4 = (lane & 7) * 4;
        f32x4 v = *(const f32x4*)(W + (size_t)(k0 + kk) * ldw + n0 + c4); if (gs) v = v * gs[k0 + kk];
        scr[kk * 33 + c4] = v[0]; scr[kk * 33 + c4 + 1] = v[1]; scr[kk * 33 + c4 + 2] = v[2]; scr[kk * 33 + c4 + 3] = v[3]; }
    asm volatile("s_waitcnt lgkmcnt(0)" ::: "memory");
    const int c = lane & 7;
#pragma unroll
    for (int j = 0; j < 4; ++j) { const int n = (lane >> 3) + 8 * j; const LAS float* s = scr + (8 * c) * 33 + n;
        v4u o; o.x = pk2(s[0 * 33], s[1 * 33]); o.y = pk2(s[2 * 33], s[3 * 33]); o.z = pk2(s[4 * 33], s[5 * 33]); o.w = pk2(s[6 * 33], s[7 * 33]);
        *(v4u*)(WT + (size_t)(n0 + n) * ldk + koff + k0 + 8 * c) = o; }
    asm volatile("s_waitcnt lgkmcnt(0)" ::: "memory");
}

__device__ __forceinline__ void phase_prologue(const Args& a, LAS unsigned char* lds) {
    const int tid = mk_tid(), lane = tid & 63, wave = tid >> 6;
    const int gt = blockIdx.x * NTHREADS + tid, NGT = gridDim.x * NTHREADS;
    const int gw = blockIdx.x * NWAVES + wave, NGW = gridDim.x * NWAVES;
    { v4u z = {0u, 0u, 0u, 0u}; v4u* p = (v4u*)(a.ws + WS_CTL); for (int i = gt; i < (int)(WS_ZERO_END / 16); i += NGT) p[i] = z; }
    LAS float* scr = (LAS float*)(lds + wave * 16384);
    const float* norm1_g = a.in[2]; const float* norm2_g = a.in[3];
    constexpr int I_MI = 16 * 64, I_MO = 8 * 32, I_QKV = 16 * 96, I_AO = 16 * 32, I_W1 = 16 * 128, I_W2 = 64 * 32;
    constexpr int T_MI = 2 * I_MI, T_MO = T_MI + 2 * I_MO, T_QKV = T_MO + 2 * I_QKV, T_AO = T_QKV + 2 * I_AO, T_W1 = T_AO + 4 * I_W1, T_W2 = T_W1 + 4 * I_W2;
    for (int it = gw; it < T_W2; it += NGW) {
        if (it < T_MI) { const int j = it / I_MI, r = it % I_MI;
            transpose_item(a.in[5] + (size_t)j * D * 2048, 2048, 2048, norm1_g + (2 * j) * D, (bf16*)(a.ws + WS_WMI) + (size_t)j * 2048 * D, D, 0, scr, r, lane); }
        else if (it < T_MO) { const int q = it - T_MI, j = q / I_MO, r = q % I_MO;
            transpose_item(a.in[9] + (size_t)j * D * D + (size_t)512 * D, D, D, nullptr, (bf16*)(a.ws + WS_WMO) + (size_t)j * D * D, D, 512, scr, r, lane); }
        else if (it < T_QKV) { const int q = it - T_MO, j = q / I_QKV, r = q % I_QKV;
            transpose_item(a.in[10] + (size_t)j * D * 3072, 3072, 3072, norm1_g + (2 * j + 1) * D, (bf16*)(a.ws + WS_WQKV) + (size_t)j * 3072 * D, D, 0, scr, r, lane); }
        else if (it < T_AO) { const int q = it - T_QKV, j = q / I_AO, r = q % I_AO;
            transpose_item(a.in[11] + (size_t)j * D * D, D, D, nullptr, (bf16*)(a.ws + WS_WAO) + (size_t)j * D * D, D, 0, scr, r, lane); }
        else if (it < T_W1) { const int q = it - T_AO, i = q / I_W1, r = q % I_W1;
            transpose_item(a.in[17] + (size_t)i * D * FF, FF, FF, norm2_g + i * D, (bf16*)(a.ws + WS_W1) + (size_t)i * FF * D, D, 0, scr, r, lane); }
        else { const int q = it - T_W1, i = q / I_W2, r = q % I_W2;
            transpose_item(a.in[18] + (size_t)i * FF * D, D, D, nullptr, (bf16*)(a.ws + WS_W2) + (size_t)i * D * FF, FF, 0, scr, r, lane); }
    }
    for (int it = gw; it < 2 * 4 * 16 * 16; it += NGW) {
        const int cb = it & 15, nb = (it >> 4) & 15, g = (it >> 8) & 3, j = it >> 10;
        const float* pw = a.in[6] + ((size_t)(j * 4 + g) * 128 + cb * 8) * 128;
        const float* ps = a.in[7] + j * 512 + g * 128;
        const float* mo = a.in[9] + (size_t)j * D * D + (size_t)(g * 128) * D + nb * 64 + lane;
        float acc[8];
#pragma unroll
        for (int c = 0; c < 8; ++c) acc[c] = 0.f;
#pragma unroll 8
        for (int d = 0; d < 128; ++d) {
            const float m = mo[(size_t)d * D] * ps[d];
#pragma unroll
            for (int c = 0; c < 8; ++c) acc[c] = fmaf(pw[c * 128 + d], m, acc[c]);
        }
        v4u o; o.x = pk2(acc[0], acc[1]); o.y = pk2(acc[2], acc[3]); o.z = pk2(acc[4], acc[5]); o.w = pk2(acc[6], acc[7]);
        *(v4u*)((bf16*)(a.ws + WS_WMO) + (size_t)j * D * D + (size_t)(nb * 64 + lane) * D + g * 128 + cb * 8) = o;
    }
}

__device__ __forceinline__ void phase_prep(const Args& a, int g) {
    const int tid = mk_tid(), lane = tid & 63, gw = blockIdx.x * NWAVES + (tid >> 6), NGW = gridDim.x * NWAVES;
    const float* xin = g ? a.in[1] : a.in[0]; float* xo = a.out + (size_t)g * MG * D; bf16* xb = (bf16*)(a.ws + WS_XB); float* rsq = (float*)(a.ws + WS_ROWSQ);
    for (int m = gw; m < MG; m += NGW) {
        const f32x4* xr = (const f32x4*)(xin + (size_t)m * D) + lane; f32x4* orow = (f32x4*)(xo + (size_t)m * D) + lane; v2u* brow = (v2u*)(xb + (size_t)m * D) + lane;
        float s = 0.f;
#pragma unroll
        for (int j = 0; j < 4; ++j) { const f32x4 v = xr[64 * j]; orow[64 * j] = v; s += (v[0] * v[0] + v[1] * v[1]) + (v[2] * v[2] + v[3] * v[3]);
            v2u w; w.x = pk2(v[0], v[1]); w.y = pk2(v[2], v[3]); brow[64 * j] = w; }
        s = wave_sum(s);
        if (lane < 16) rsq[(size_t)m * 16 + lane] = lane == 0 ? s : 0.f;
    }
}
__device__ __forceinline__ void phase_final(const Args& a, int g) {
    const int tid = mk_tid(), lane = tid & 63, gw = blockIdx.x * NWAVES + (tid >> 6), NGW = gridDim.x * NWAVES;
    float* xo = a.out + (size_t)g * MG * D; const float* rsq = (const float*)(a.ws + WS_ROWSQ) + (size_t)8 * MG * 16; const f32x4* fg = (const f32x4*)a.in[4] + lane;
    for (int m = gw; m < MG; m += NGW) {
        float rsum;
        { const f32x4* rp = (const f32x4*)(rsq + (size_t)m * 16); const f32x4 a0 = rp[0], a1 = rp[1], a2 = rp[2], a3 = rp[3];
          rsum = (((a0[0] + a0[1]) + (a0[2] + a0[3])) + ((a1[0] + a1[1]) + (a1[2] + a1[3]))) + (((a2[0] + a2[1]) + (a2[2] + a2[3])) + ((a3[0] + a3[1]) + (a3[2] + a3[3]))); }
        const float rs = __builtin_amdgcn_rsqf(rsum * (1.0f / 1024.0f) + 1e-6f);
        f32x4* orow = (f32x4*)(xo + (size_t)m * D) + lane;
#pragma unroll
        for (int j = 0; j < 4; ++j) { f32x4 v = orow[64 * j]; const f32x4 gg = fg[64 * j]; v = v * rs * gg; orow[64 * j] = v; }
    }
}

__device__ __forceinline__ void unpack8(const v4u w, float (&f)[8]) {
    f[0] = bflo(w.x); f[1] = bfhi(w.x); f[2] = bflo(w.y); f[3] = bfhi(w.y); f[4] = bflo(w.z); f[5] = bfhi(w.z); f[6] = bflo(w.w); f[7] = bfhi(w.w);
}
__device__ __forceinline__ void phase_stencil(const Args& a, int g, int j) {
    const int S = g ? 16384 : 8192;
    const bf16* P = (const bf16*)(a.ws + WS_BIG); bf16* A2 = (bf16*)(a.ws + WS_BIG + 64 * MiB);
    const int tid = mk_tid(), chunk = tid & 127, tb = tid >> 7;
    for (int tile = blockIdx.x; tile < MG / 64; tile += gridDim.x) {
        const int row0 = tile * 64 + tb * 16;
        const int b0 = row0 & ~(S - 1), t0 = row0 & (S - 1);
        if (chunk < 64) {
            const int c0 = chunk * 8, hw = 1 << (chunk >> 4);
            const bf16* U = P + (size_t)b0 * 2048 + c0;
            float sum[8];
#pragma unroll
            for (int e = 0; e < 8; ++e) sum[e] = 0.f;
            { const int lo = max(t0 - hw, 0), hi = min(t0 + hw, S);
              for (int t = lo; t < hi; ++t) { float f[8]; unpack8(*(const v4u*)(U + (size_t)t * 2048), f);
#pragma unroll
                  for (int e = 0; e < 8; ++e) sum[e] += f[e]; } }
            for (int i = 0; i < 16; ++i) {
                const int t = t0 + i; const int lo = max(t - hw, 0), hi = min(t + hw, S);
                const float rc = 1.0f / (float)(hi - lo);
                float f[8]; unpack8(*(const v4u*)(U + (size_t)t * 2048), f);
                v4u o; o.x = pk2(sum[0] * rc - f[0], sum[1] * rc - f[1]); o.y = pk2(sum[2] * rc - f[2], sum[3] * rc - f[3]);
                o.z = pk2(sum[4] * rc - f[4], sum[5] * rc - f[5]); o.w = pk2(sum[6] * rc - f[6], sum[7] * rc - f[7]);
                *(v4u*)(A2 + (size_t)(b0 + t) * 1024 + c0) = o;
                if (t + hw < S) { float n[8]; unpack8(*(const v4u*)(U + (size_t)(t + hw) * 2048), n);
#pragma unroll
                    for (int e = 0; e < 8; ++e) sum[e] += n[e]; }
                if (t - hw >= 0) { float n[8]; unpack8(*(const v4u*)(U + (size_t)(t - hw) * 2048), n);
#pragma unroll
                    for (int e = 0; e < 8; ++e) sum[e] -= n[e]; }
            }
        } else {
            const int c0 = (chunk - 64) * 8;
            const bf16* Hc = P + (size_t)b0 * 2048 + 512 + c0; const bf16* Gb = Hc + 512; const bf16* Gc = Hc + 1024;
            const float* cw = a.in[8] + (size_t)j * 3 * 512 + c0;
            float w0[8], w1[8], w2[8];
#pragma unroll
            for (int e = 0; e < 8; ++e) { w0[e] = cw[e]; w1[e] = cw[512 + e]; w2[e] = cw[1024 + e]; }
            float zp[8], zc[8];
            if (t0 > 0) { float hh[8], cc[8]; unpack8(*(const v4u*)(Hc + (size_t)(t0 - 1) * 2048), hh); unpack8(*(const v4u*)(Gc + (size_t)(t0 - 1) * 2048), cc);
#pragma unroll
                for (int e = 0; e < 8; ++e) zp[e] = hh[e] * cc[e]; }
            else {
#pragma unroll
                for (int e = 0; e < 8; ++e) zp[e] = 0.f; }
            { float hh[8], cc[8]; unpack8(*(const v4u*)(Hc + (size_t)t0 * 2048), hh); unpack8(*(const v4u*)(Gc + (size_t)t0 * 2048), cc);
#pragma unroll
              for (int e = 0; e < 8; ++e) zc[e] = hh[e] * cc[e]; }
            for (int i = 0; i < 16; ++i) {
                const int t = t0 + i; float zn[8];
                if (t + 1 < S) { float hh[8], cc[8]; unpack8(*(const v4u*)(Hc + (size_t)(t + 1) * 2048), hh); unpack8(*(const v4u*)(Gc + (size_t)(t + 1) * 2048), cc);
#pragma unroll
                    for (int e = 0; e < 8; ++e) zn[e] = hh[e] * cc[e]; }
                else {
#pragma unroll
                    for (int e = 0; e < 8; ++e) zn[e] = 0.f; }
                float gb[8], r[8]; unpack8(*(const v4u*)(Gb + (size_t)t * 2048), gb);
#pragma unroll
                for (int e = 0; e < 8; ++e) r[e] = gb[e] * (w0[e] * zp[e] + w1[e] * zc[e] + w2[e] * zn[e]);
                v4u o; o.x = pk2(r[0], r[1]); o.y = pk2(r[2], r[3]); o.z = pk2(r[4], r[5]); o.w = pk2(r[6], r[7]);
                *(v4u*)(A2 + (size_t)(b0 + t) * 1024 + 512 + c0) = o;
#pragma unroll
                for (int e = 0; e < 8; ++e) { zp[e] = zc[e]; zc[e] = zn[e]; }
            }
        }
    }
}

__device__ __forceinline__ void phase_attention(const Args& a, int g, int layer, char* lds) {
    using namespace att;
    const int S = g ? 16384 : 8192, logS = g ? 14 : 13; const int j = layer >> 1;
    const bf16* Qb = (const bf16*)(a.ws + WS_BIG); const bf16* Kb = Qb + (size_t)MG * 1024; const bf16* Vb = Kb + (size_t)MG * 1024; bf16* Ob = (bf16*)(a.ws + WS_BIG);
    unsigned* ctr = (unsigned*)(a.ws + WS_CTL) + CW_ATTCTR + 64 * (g * 2 + j);
    unsigned* arr = (unsigned*)(a.ws + WS_CTL) + CW_ARR + 1024 * (g * 2 + j);
    const unsigned* nrm = (const unsigned*)(a.ws + WS_CTL) + CW_NRM + 256 * (g * 2 + j);
    volatile unsigned* s_unit = (volatile unsigned*)(lds + OFF_UNIT);
    const float lambda_init = (layer == 1) ? 0.35550906759096926f : 0.5560582041556405f;
    float lam;
    { const float* q1 = a.in[12] + j * 64; const float* k1 = a.in[13] + j * 64; const float* q2 = a.in[14] + j * 64; const float* k2 = a.in[15] + j * 64;
      const int lane = mk_tid() & 63; float s1 = q1[lane] * k1[lane], s2 = q2[lane] * k2[lane]; s1 = wave_sum(s1); s2 = wave_sum(s2); lam = __expf(s1) - __expf(s2) + lambda_init; }
    const float* subg = a.in[16] + j * 128;
    for (;;) {
        const int tid = mk_tid(), wid = tid >> 6, lane = tid & 63, r32 = lane & 31, hi = lane >> 5;
        __syncthreads();
        if (tid == 0) s_unit[0] = atomicAdd(ctr, 1u);
        __syncthreads();
        const int tk = (int)s_unit[0];
        if (tk >= 1024 * MK_DUP_ATT) break;
        const int u = tk / MK_DUP_ATT; const bool dup = (tk % MK_DUP_ATT) != 0;
        const int h = 7 - (u >> 7), qbi = (u >> 1) & 63, pass = u & 1, uid = u >> 1;
        const int b = (qbi * 256) >> logS, q0 = (qbi * 256) & (S - 1);
        const size_t rowbase = (size_t)b * S;
        const float slope2 = __builtin_amdgcn_exp2f(-(float)(h + 1)) * 1.4426950408889634f;
        const int qpos = q0 + wid * QBLK + r32;
        f32x16 o[4];
        {
            const int map = 2 * h + pass;
            int klo = 0, khi = S; float smax;
            { const unsigned* nq = nrm + ((0 * 2 + b) * 16 + map) * 2; const unsigned* nk = nrm + ((1 * 2 + b) * 16 + map) * 2;
              const float qn2 = __uint_as_float(__hip_atomic_load(nq, __ATOMIC_RELAXED, __HIP_MEMORY_SCOPE_AGENT)) + __uint_as_float(__hip_atomic_load(nq + 1, __ATOMIC_RELAXED, __HIP_MEMORY_SCOPE_AGENT));
              const float kn2 = __uint_as_float(__hip_atomic_load(nk, __ATOMIC_RELAXED, __HIP_MEMORY_SCOPE_AGENT)) + __uint_as_float(__hip_atomic_load(nk + 1, __ATOMIC_RELAXED, __HIP_MEMORY_SCOPE_AGENT));
              smax = sqrtf(qn2 * kn2) * 1.02f;
#if MK_WINDOW
              float sown;
              { const bf16* qp = Qb + (rowbase + q0 + wid * QBLK + r32) * 1024 + map * 64 + hi * 32; const bf16* kp = Kb + (rowbase + q0 + wid * QBLK + r32) * 1024 + map * 64 + hi * 32;
                float acc = 0.f, qq = 0.f;
#pragma unroll
                for (int c = 0; c < 4; ++c) { const v4u qa = *(const v4u*)(qp + c * 8), ka = *(const v4u*)(kp + c * 8);
                    acc += bflo(qa.x) * bflo(ka.x) + bfhi(qa.x) * bfhi(ka.x) + bflo(qa.y) * bflo(ka.y) + bfhi(qa.y) * bfhi(ka.y)
                         + bflo(qa.z) * bflo(ka.z) + bfhi(qa.z) * bfhi(ka.z) + bflo(qa.w) * bflo(ka.w) + bfhi(qa.w) * bfhi(ka.w);
                    qq += bflo(qa.x) * bflo(qa.x) + bfhi(qa.x) * bfhi(qa.x) + bflo(qa.y) * bflo(qa.y) + bfhi(qa.y) * bfhi(qa.y)
                        + bflo(qa.z) * bflo(qa.z) + bfhi(qa.z) * bfhi(qa.z) + bflo(qa.w) * bflo(qa.w) + bfhi(qa.w) * bfhi(qa.w); }
                acc = sum_x32(acc); qq = sum_x32(qq);
                acc = fminf(acc, xor_lt32<1>(acc)); acc = fminf(acc, xor_lt32<2>(acc)); acc = fminf(acc, xor_lt32<4>(acc)); acc = fminf(acc, xor_lt32<8>(acc)); acc = fminf(acc, xor_lt32<16>(acc));
                qq = fmaxf(qq, xor_lt32<1>(qq)); qq = fmaxf(qq, xor_lt32<2>(qq)); qq = fmaxf(qq, xor_lt32<4>(qq)); qq = fmaxf(qq, xor_lt32<8>(qq)); qq = fmaxf(qq, xor_lt32<16>(qq));
                float* wmin = (float*)(lds + OFF_UNIT) + 8;
                if (lane == 0) { wmin[wid] = acc; wmin[8 + wid] = qq; }
                __syncthreads();
                sown = fminf(fminf(fminf(wmin[0], wmin[1]), fminf(wmin[2], wmin[3])), fminf(fminf(wmin[4], wmin[5]), fminf(wmin[6], wmin[7])));
                sown = fminf(sown, 0.f) - 0.25f;
                const float qu2 = fmaxf(fmaxf(fmaxf(wmin[8], wmin[9]), fmaxf(wmin[10], wmin[11])), fmaxf(fmaxf(wmin[12], wmin[13]), fmaxf(wmin[14], wmin[15])));
                smax = fminf(smax, sqrtf(qu2 * kn2) * 1.02f);
              }
              const float wf = (smax - sown + 24.f) / slope2;
              const int wi = (wf < (float)S) ? (int)wf + 1 : S;
              klo = max(q0 - wi, 0) & ~127; khi = min((q0 + 256 + wi + 127) & ~127, S);
#endif
            }
            const int NT = (khi - klo) >> 6;
            const bf16* Qw = Qb + (rowbase + q0 + wid * QBLK + r32) * 1024 + map * 64 + hi * 8;
            const bf16* Kh = Kb + (rowbase + klo) * 1024 + map * 64;
            const bf16* Vh = Vb + (rowbase + klo) * 1024 + h * 128;
            attn_pass(Qw, Kh, Vh, NT, (float)(qpos - klo), klo - (q0 + __builtin_amdgcn_readfirstlane(wid) * QBLK), -slope2, smax, o, lds);
        }
        if (dup) continue;
        const int t2 = mk_tid(); const int r32b = t2 & 31, hib = (t2 >> 5) & 1, widb = t2 >> 6;
        if (t2 == 0) s_unit[1] = atomicAdd(arr + 2 * uid, 1u);
        __syncthreads();
        const unsigned first = s_unit[1];
        f32x4* sp = (f32x4*)(uid < 256 ? (float*)(a.ws + WS_XB) + (size_t)uid * 32768 : (float*)(a.ws + WS_BIG + 96 * MiB) + (size_t)(uid - 256) * 32768) + t2;
        if (first == 0u) {
#pragma unroll
            for (int d0 = 0; d0 < 4; ++d0)
#pragma unroll
                for (int q = 0; q < 4; ++q) {
                    const f32x4 w = {o[d0][4 * q], o[d0][4 * q + 1], o[d0][4 * q + 2], o[d0][4 * q + 3]};
                    asm volatile("global_store_dwordx4 %0, %1, off sc1" :: "v"(sp + (d0 * 4 + q) * 512), "v"(w) : "memory");
                }
            asm volatile("s_waitcnt vmcnt(0)" ::: "memory");
            __syncthreads();
            if (t2 == 0) __hip_atomic_store(arr + 2 * uid + 1, 1u, __ATOMIC_RELEASE, __HIP_MEMORY_SCOPE_AGENT);
            continue;
        }
        if (t2 == 0) { unsigned spn = 0; while (__hip_atomic_load(arr + 2 * uid + 1, __ATOMIC_RELAXED, __HIP_MEMORY_SCOPE_AGENT) == 0u) { __builtin_amdgcn_s_sleep(2); if (++spn > (1u << 24)) break; } }
        __syncthreads();
        __builtin_amdgcn_fence(__ATOMIC_ACQUIRE, "agent");
        float ssq[16];
#pragma unroll
        for (int r = 0; r < 16; ++r) ssq[r] = 0.f;
        f32x4 w[16];
#pragma unroll
        for (int i = 0; i < 16; ++i) asm volatile("global_load_dwordx4 %0, %1, off sc1" : "=v"(w[i]) : "v"(sp + i * 512) : "memory");
        asm volatile("s_waitcnt vmcnt(0)" : "+v"(w[0]), "+v"(w[1]), "+v"(w[2]), "+v"(w[3]), "+v"(w[4]), "+v"(w[5]), "+v"(w[6]), "+v"(w[7]),
                                             "+v"(w[8]), "+v"(w[9]), "+v"(w[10]), "+v"(w[11]), "+v"(w[12]), "+v"(w[13]), "+v"(w[14]), "+v"(w[15]) :: "memory");
#pragma unroll
        for (int d0 = 0; d0 < 4; ++d0)
#pragma unroll
            for (int q = 0; q < 4; ++q) {
#pragma unroll
                for (int e = 0; e < 4; ++e) { const int r = 4 * q + e; const float t = w[d0 * 4 + q][e]; const float v = pass ? (t - lam * o[d0][r]) : (o[d0][r] - lam * t);
                    o[d0][r] = v; ssq[r] = fmaf(v, v, ssq[r]); } }
#pragma unroll
        for (int r = 0; r < 16; ++r) {
            float s = ssq[r];
            s += xor_lt32<1>(s); s += xor_lt32<2>(s); s += xor_lt32<4>(s); s += xor_lt32<8>(s); s += xor_lt32<16>(s);
            ssq[r] = __builtin_amdgcn_rsqf(s * (1.0f / 128.0f) + 1e-5f) * (1.0f - lambda_init);
        }
        bf16* Ow = Ob + (rowbase + q0 + widb * QBLK + 4 * hib) * 1024 + h * 128 + r32b;
#pragma unroll
        for (int d0 = 0; d0 < 4; ++d0) { const float gg = subg[d0 * 32 + r32b];
#pragma unroll
            for (int r = 0; r < 16; ++r) Ow[(size_t)crow(r, 0) * 1024 + d0 * 32] = (bf16)f2bf(o[d0][r] * ssq[r] * gg); }
    }
}


#define XB_TMO      128
#define XB_XCNT(j)  (256  + 64 * (j))
#define XB_XSUB(j)  (1280 + 64 * (j))
#define XB_XGEN(j)  (2304 + 64 * (j))
#define XB_TOP      3328
#define XB_TOPGEN   3392
#define XCD_BAR_WORDS 3456
#define XB_SPIN_CAP (1u << 22)
__device__ __forceinline__ unsigned xb_ld(unsigned* p)              { return __hip_atomic_load(p, __ATOMIC_RELAXED, __HIP_MEMORY_SCOPE_AGENT); }
__device__ __forceinline__ unsigned xb_add(unsigned* p, unsigned v) { return __hip_atomic_fetch_add(p, v, __ATOMIC_RELAXED, __HIP_MEMORY_SCOPE_AGENT); }
__device__ __forceinline__ unsigned xb_xcc_id() { return (unsigned)__builtin_amdgcn_s_getreg((3 << 11) | 20) & 0xFu; }
#define XB_SPIN(cond, bar) do { unsigned _sp = 0; while (cond) { __builtin_amdgcn_s_sleep(1); \
    if ((++_sp & 255u) == 0u) { if (xb_ld(&(bar)[XB_TMO])) break; if (_sp > XB_SPIN_CAP) { atomicAdd(&(bar)[XB_TMO], 1u); break; } } } } while (0)
struct XcdBarrier { unsigned* bar; unsigned x; volatile LAS unsigned* st; };
__device__ __forceinline__ XcdBarrier xcd_barrier_post(unsigned* bar, volatile LAS unsigned* st) {
    XcdBarrier b; b.bar = bar; b.x = xb_xcc_id(); b.st = st;
    if (mk_tid() == 0) (void)xb_add(&bar[XB_XCNT(b.x)], 1u);
    return b;
}
__device__ __forceinline__ void xcd_barrier_complete(unsigned* bar, unsigned x, unsigned& nloc, unsigned& nx) {
    const unsigned G = gridDim.x * gridDim.y * gridDim.z;
    unsigned sum, cnt, mine, sp = 0u;
    for (;;) {
        sum = 0u; cnt = 0u; mine = 0u;
#pragma unroll
        for (unsigned j = 0; j < 16; ++j) { const unsigned c = xb_ld(&bar[XB_XCNT(j)]); sum += c; cnt += (c > 0u) ? 1u : 0u; mine = (j == x) ? c : mine; }
        if (sum == G) break;
        __builtin_amdgcn_s_sleep(1);
        if ((++sp & 255u) == 0u) { if (xb_ld(&bar[XB_TMO])) break; if (sp > XB_SPIN_CAP) { atomicAdd(&bar[XB_TMO], 1u); break; } }
    }
    nloc = mine > 0u ? mine : 1u; nx = cnt > 0u ? cnt : 1u;
}
__device__ __forceinline__ void xcd_barrier(const XcdBarrier& b) {
    asm volatile("s_waitcnt vmcnt(0)" ::: "memory");
    __syncthreads();
    if (mk_tid() == 0) {
        unsigned* bar = b.bar;
        __builtin_amdgcn_s_waitcnt(0);
        unsigned nloc = b.st[0], nx = b.st[1];
        if (nloc == 0u) { xcd_barrier_complete(bar, b.x, nloc, nx); b.st[0] = nloc; b.st[1] = nx; }
        const unsigned old = xb_add(&bar[XB_XSUB(b.x)], 1u);
        const unsigned gen = old / nloc;
        if (old + 1u == (gen + 1u) * nloc) {
            __builtin_amdgcn_fence(__ATOMIC_RELEASE, "agent");
            asm volatile("s_waitcnt vmcnt(0)" ::: "memory");
            const unsigned og = xb_add(&bar[XB_TOP], 1u);
            const unsigned tg = og / nx;
            if (og + 1u == (tg + 1u) * nx) xb_add(&bar[XB_TOPGEN], 1u);
            else XB_SPIN(xb_ld(&bar[XB_TOPGEN]) == tg, bar);
            __builtin_amdgcn_fence(__ATOMIC_ACQUIRE, "agent");
            xb_add(&bar[XB_XGEN(b.x)], 1u);
            asm volatile("s_waitcnt vmcnt(0)" ::: "memory");
        } else {
            XB_SPIN(xb_ld(&bar[XB_XGEN(b.x)]) == gen, bar);
            __builtin_amdgcn_fence(__ATOMIC_ACQUIRE, "agent");
            asm volatile("s_waitcnt vmcnt(0)" ::: "memory");
        }
    }
    __syncthreads();
}

constexpr int LDS_BYTES = 147456;
constexpr int N_PHASES = 1 + 2 * (1 + 4 * 5 + 1);
#ifndef MK_MASK
#define MK_MASK 0xFFFF
#endif
#define EN(k) ((MK_MASK >> (k)) & 1)

__global__ void __launch_bounds__(NTHREADS, 2) fwd_megakernel(Args args) {
    extern __shared__ __attribute__((aligned(16))) unsigned char lds[];
    cg::grid_group grid = cg::this_grid();
    const int lo = args.ph_lo, hi = args.ph_hi;
    int ph = 0;
#define RUN() (ph >= lo && ph < hi)
#if MK_PROBE
    unsigned long long t_last = __builtin_amdgcn_s_memrealtime(), t_a = 0, t_b = 0;
#define SEAMK(k) do { if (ph >= lo && ph + 1 < hi) grid.sync(); ++ph; { const unsigned long long t_now = __builtin_amdgcn_s_memrealtime(); \
        if ((MK_PROBE_A >> (k)) & 1) t_a += t_now - t_last; if ((MK_PROBE_B >> (k)) & 1) t_b += t_now - t_last; t_last = t_now; } } while (0)
#else
#define SEAMK(k) do { if (ph >= lo && ph + 1 < hi) { if (ph == 0) { grid.sync(); xbar = xcd_barrier_post((unsigned*)(ws + WS_CTL) + CW_BAR, xst); } else xcd_barrier(xbar); } ++ph; } while (0)
#endif
#define SEAM() SEAMK(0)
    unsigned char* ws = args.ws;
    volatile LAS unsigned* xst = (volatile LAS unsigned*)((LAS unsigned char*)lds + 131072 + 256);
    if (mk_tid() == 0) { xst[0] = 0u; xst[1] = 0u; }
    __syncthreads();
    XcdBarrier xbar; xbar.bar = (unsigned*)(ws + WS_CTL) + CW_BAR; xbar.x = 0; xbar.st = xst;
    PG8_LAS unsigned char* glds = (PG8_LAS unsigned char*)lds;
    const int G = gridDim.x, c = blockIdx.x;

    if (EN(0) && RUN()) { _Pragma("unroll 1") for (int rep = 0; rep < 1 + (MK_DUP_MISC & 1); ++rep) { phase_prologue(args, (LAS unsigned char*)lds); __syncthreads(); } }
    SEAMK(1);
#pragma unroll 1
    for (int g = 0; g < 2; ++g) {
        if (EN(1) && RUN()) { _Pragma("unroll 1") for (int rep = 0; rep < 1 + ((MK_DUP_MISC >> 1) & 1); ++rep) phase_prep(args, g); }
        SEAMK(2);
        float* xg = args.out + (size_t)g * MG * D; bf16* XB = (bf16*)(ws + WS_XB);
        float* rsq_base = (float*)(ws + WS_ROWSQ);
#pragma unroll 1
        for (int i = 0; i < DEPTH; ++i) {
            const int j = i >> 1;
            float* rsq_n1 = rsq_base + (size_t)(2 * i) * MG * 16; float* rsq_n2 = rsq_base + (size_t)(2 * i + 1) * MG * 16; float* rsq_nx = rsq_base + (size_t)(2 * i + 2) * MG * 16;
            if ((i & 1) == 0) {
                if (EN(2) && RUN()) {
                    pg8::Gemm gm{XB, (const bf16*)(ws + WS_WMI) + (size_t)j * 2048 * D, MG, 2048, D}; pg8::StaticOrder S; S.init(MG, 2048, G, c);
                    pg8::EpiProj<0> E{(bf16*)(ws + WS_BIG), 2048, rsq_n1, 0, 1.f, nullptr, 0};
                    _Pragma("unroll 1") for (int rep = 0; rep < MK_DUP; ++rep) pg8::gemm_phase<pg8::EpiProj<0>, pg8::StaticOrder, true, true>(glds, gm, S, E);
                }
                SEAMK(3);
                if (EN(3) && RUN()) { _Pragma("unroll 1") for (int rep = 0; rep < 1 + ((MK_DUP_MISC >> 2) & 1); ++rep) phase_stencil(args, g, j); }
                SEAMK(4);
                if (EN(4) && RUN()) {
                    pg8::Gemm gm{(const bf16*)(ws + WS_BIG + 64 * MiB), (const bf16*)(ws + WS_WMO) + (size_t)j * D * D, MG, D, D}; pg8::StaticOrder S; S.init(MG, D, G, c);
                    pg8::EpiRes E{xg, XB, rsq_n2, 0};
                    if (MK_DUP_RES == 1) { pg8::EpiNull E0; pg8::gemm_phase<pg8::EpiNull, pg8::StaticOrder, true, true>(glds, gm, S, E0); }
                    if (MK_DUP_RES == 2) { pg8::EpiRes E0 = E; E0.dry = 1; pg8::gemm_phase<pg8::EpiRes, pg8::StaticOrder, true, true>(glds, gm, S, E0); }
                    pg8::gemm_phase<pg8::EpiRes, pg8::StaticOrder, true, true>(glds, gm, S, E);
                }
                SEAMK(5);
            } else {
                if (EN(5) && RUN()) {
                    pg8::Gemm gm{XB, (const bf16*)(ws + WS_WQKV) + (size_t)j * 3072 * D, MG, 3072, D}; pg8::StaticOrder S; S.init(MG, 3072, G, c);
                    pg8::EpiProj<1> E{(bf16*)(ws + WS_BIG), 1024, rsq_n1, (size_t)MG * 1024, QSCALE, (unsigned*)(ws + WS_CTL) + CW_NRM + 256 * (g * 2 + j), g ? 14 : 13};
                    _Pragma("unroll 1") for (int rep = 0; rep < MK_DUP; ++rep) pg8::gemm_phase<pg8::EpiProj<1>, pg8::StaticOrder, true, true>(glds, gm, S, E);
                }
                SEAMK(6);
                if (EN(6) && RUN()) phase_attention(args, g, i, (char*)lds);
                SEAMK(7);
                if (EN(7) && RUN()) {
                    pg8::Gemm gm{(const bf16*)(ws + WS_BIG), (const bf16*)(ws + WS_WAO) + (size_t)j * D * D, MG, D, D}; pg8::StaticOrder S; S.init(MG, D, G, c);
                    pg8::EpiRes E{xg, XB, rsq_n2, 0};
                    if (MK_DUP_RES == 1) { pg8::EpiNull E0; pg8::gemm_phase<pg8::EpiNull, pg8::StaticOrder, true, true>(glds, gm, S, E0); }
                    if (MK_DUP_RES == 2) { pg8::EpiRes E0 = E; E0.dry = 1; pg8::gemm_phase<pg8::EpiRes, pg8::StaticOrder, true, true>(glds, gm, S, E0); }
                    pg8::gemm_phase<pg8::EpiRes, pg8::StaticOrder, true, true>(glds, gm, S, E);
                }
                SEAMK(8);
            }
            if (EN(8) && RUN()) {
                pg8::Gemm gm{XB, (const bf16*)(ws + WS_W1) + (size_t)i * FF * D, MG, FF, D}; pg8::StaticOrder S; S.init(MG, FF, G, c);
                pg8::EpiProj<2> E{(bf16*)(ws + WS_BIG), FF, rsq_n2, 0, 1.f, nullptr, 0};
                _Pragma("unroll 1") for (int rep = 0; rep < MK_DUP; ++rep) pg8::gemm_phase<pg8::EpiProj<2>, pg8::StaticOrder, true, true>(glds, gm, S, E);
            }
            SEAMK(9);
            if (EN(9) && RUN()) {
                pg8::Gemm gm{(const bf16*)(ws + WS_BIG), (const bf16*)(ws + WS_W2) + (size_t)i * D * FF, MG, D, FF}; pg8::StaticOrder S; S.init(MG, D, G, c);
                pg8::EpiRes E{xg, XB, rsq_nx, 0};
                if (MK_DUP_RES == 1) { pg8::EpiNull E0; pg8::gemm_phase<pg8::EpiNull, pg8::StaticOrder, true, true>(glds, gm, S, E0); }
                    if (MK_DUP_RES == 2) { pg8::EpiRes E0 = E; E0.dry = 1; pg8::gemm_phase<pg8::EpiRes, pg8::StaticOrder, true, true>(glds, gm, S, E0); }
                    pg8::gemm_phase<pg8::EpiRes, pg8::StaticOrder, true, true>(glds, gm, S, E);
            }
            SEAMK(10);
        }
        if (EN(10) && RUN()) phase_final(args, g);
        SEAMK(11);
    }
#if MK_PROBE
    if (blockIdx.x == 0 && (mk_tid() >> 6) == 0) {
        const float da = (float)t_a * 1e-5f / 1.5f, db = (float)t_b * 1e-5f;
        for (int g = 0; g < 2; ++g) { float* r0 = args.out + (size_t)g * MG * D; const int lane = mk_tid() & 63;
            for (int q = 0; q < 16; ++q) r0[q * 64 + lane] += da;
            if (lane == 0) r0[(size_t)2048 * D] += db; }
    }
#endif
#undef RUN
#undef SEAM
}

extern "C" void kernel_launch(void* const* d_in, const int* in_sizes, int n_in, void* d_out, int out_size, void* d_ws, size_t ws_size, hipStream_t stream) {
    static int grid = 0;
    if (grid == 0) {
        if (n_in != 19 || in_sizes[0] != MG * D || in_sizes[1] != MG * D || out_size != MTOT * D || ws_size < WS_END) {
            fprintf(stderr, "kernel_launch: unexpected shapes: n_in %d in0 %d in1 %d out %d ws %zu (need %zu); nothing launched\n", n_in, n_in > 0 ? in_sizes[0] : -1, n_in > 1 ? in_sizes[1] : -1, out_size, ws_size, (size_t)WS_END);
            grid = -1; return; }
        int dev = 0, cus = 0, per_cu = 0;
        hipGetDevice(&dev);
        hipDeviceGetAttribute(&cus, hipDeviceAttributeMultiprocessorCount, dev);
        if (hipFuncSetAttribute((const void*)fwd_megakernel, hipFuncAttributeMaxDynamicSharedMemorySize, LDS_BYTES) != hipSuccess) { fprintf(stderr, "kernel_launch: hipFuncSetAttribute failed\n"); grid = -1; return; }
        if (hipOccupancyMaxActiveBlocksPerMultiprocessor(&per_cu, (const void*)fwd_megakernel, NTHREADS, LDS_BYTES) != hipSuccess || per_cu < 1) { fprintf(stderr, "kernel_launch: occupancy query failed (%d)\n", per_cu); per_cu = 1; }
        (void)hipGetLastError();
        grid = cus * per_cu;
        if (grid > 256) grid = 256;
    }
    if (grid < 0) return;
    Args a{};
    for (int i = 0; i < 19; ++i) a.in[i] = (const float*)d_in[i];
    a.out = (float*)d_out; a.ws = (unsigned char*)d_ws;
#if MK_PER_PHASE
    for (int p = 0; p < N_PHASES; ++p) {
        a.ph_lo = p; a.ph_hi = p + 1;
        void* kargs[] = {&a};
        hipError_t e = hipLaunchCooperativeKernel((const void*)fwd_megakernel, dim3(grid), dim3(NTHREADS), kargs, LDS_BYTES, stream);
        if (e != hipSuccess) { fprintf(stderr, "kernel_launch: cooperative launch %d failed: %s\n", p, hipGetErrorString(e)); break; }
    }
#else
    a.ph_lo = 0; a.ph_hi = N_PHASES;
    void* kargs[] = {&a};
    hipError_t e = hipLaunchCooperativeKernel((const void*)fwd_megakernel, dim3(grid), dim3(NTHREADS), kargs, LDS_BYTES, stream);
    if (e != hipSuccess) fprintf(stderr, "kernel_launch: cooperative launch failed: %s (grid %d)\n", hipGetErrorString(e), grid);
#endif
}
```

```cpp
#include <hip/hip_runtime.h>
#include <hip/hip_cooperative_groups.h>
#include <cstdio>
#include <cstdint>
namespace cg = cooperative_groups;

#ifndef MK_WINDOW
#define MK_WINDOW 1
#endif
#ifndef MK_PROBE
#define MK_PROBE 0
#endif
#ifndef MK_PROBE_A
#define MK_PROBE_A (1 << 7)
#endif
#ifndef MK_PROBE_B
#define MK_PROBE_B ((1 << 3) | (1 << 5) | (1 << 6) | (1 << 8) | (1 << 9) | (1 << 10))
#endif
#ifndef MK_DUP
#define MK_DUP 1
#endif
#ifndef MK_DUP_ATT
#define MK_DUP_ATT 1
#endif
#ifndef MK_DUP_MISC
#define MK_DUP_MISC 0
#endif
#ifndef MK_DUP_RES
#define MK_DUP_RES 0
#endif
#ifndef MK_PER_PHASE
#define MK_PER_PHASE 0
#endif

__device__ __forceinline__ int mk_tid() { int t = threadIdx.x; asm volatile("" : "+v"(t)); return t; }

template <int M> __device__ __forceinline__ float xor_lt32(float v) { return __int_as_float(__builtin_amdgcn_ds_swizzle(__float_as_int(v), (M << 10) | 0x1f)); }
__device__ __forceinline__ float sum_x32(float v) { auto rr = __builtin_amdgcn_permlane32_swap(__float_as_uint(v), __float_as_uint(v), false, false); return __uint_as_float(rr[0]) + __uint_as_float(rr[1]); }

namespace pg8 {
#define PG8_LAS __attribute__((address_space(3)))
typedef unsigned short bf16_t;
typedef short bf16x8 __attribute__((ext_vector_type(8)));
typedef float f32x4 __attribute__((ext_vector_type(4)));
typedef unsigned u32x4 __attribute__((ext_vector_type(4)));
constexpr int BM = 256, BK = 64, HALF = 128, HTB = HALF * BK * 2  , STAGE_BYTES = 8 * HTB, NXCD = 8, WGM = 8;

__host__ __device__ __forceinline__ int lds_byte(int r, int c) { const int st = (r >> 4) * 2 + (c >> 5), rr = r & 15, cc = c & 31, ob = rr * 64 + cc * 2; return st * 1024 + (ob ^ (((ob >> 9) & 1) << 5)); }
__host__ __device__ __forceinline__ void stage_rc(int b, int& R, int& C) { const int st = b / 1024, sb = b % 1024, swz = sb ^ (((sb >> 9) & 1) << 5); R = (st >> 1) * 16 + swz / 64; C = (st & 1) * 32 + (swz % 64) / 2; }
__host__ __device__ __forceinline__ int perm32(int rho) { const int n = rho >> 4, i = rho & 15; return 8 * (i >> 2) + 4 * n + (i & 3); }

struct Unit { int pm, pn; };
struct Gemm { const bf16_t* A; const bf16_t* Bt; int M, N, K; };

struct StaticOrder {
    int nM, nN, nwg, G, c;
    __host__ __device__ void init(int M, int N, int G_, int c_) { nM = M / BM; nN = N / BM; nwg = nM * nN; G = G_; c = c_; }
    __host__ __device__ bool next(int i, Unit& u) const {
        const long L = (long)i * G + c; if (L >= nwg) return false;
        int wgid = (int)L; { const int q = nwg / NXCD, r = nwg % NXCD, xcd = wgid % NXCD, off = wgid / NXCD; wgid = (xcd < r ? xcd * (q + 1) : r * (q + 1) + (xcd - r) * q) + off; }
        const int nig = WGM * nN, gid = wgid / nig, fm = gid * WGM, gsz = (nM - fm) < WGM ? (nM - fm) : WGM;
        u.pm = fm + ((wgid % nig) % gsz); u.pn = (wgid % nig) / gsz; return true;
    }
    __device__ __forceinline__ void a_ready(const Unit&) const {}
    __device__ __forceinline__ void done(const Unit&) const {}
};

__device__ __forceinline__ unsigned cvt_pk_bf16(float lo, float hi) { unsigned r; asm volatile("v_cvt_pk_bf16_f32 %0, %1, %2" : "=v"(r) : "v"(lo), "v"(hi)); return r; }
typedef float f32x2 __attribute__((ext_vector_type(2)));
template <int MODE> struct EpiProj {
    static constexpr bool PERM = true, AFTER_DRAIN = false;
    bf16_t* O; int ldc; const float* rowsq; size_t split_stride; float scale0; unsigned* nrm; int logS;
    __device__ __forceinline__ void operator()(const f32x4 (&acc)[2][2][4][2], const Unit& u, int wr, int wc, int fr, int fq) const {
        const int row0 = u.pm * BM + wr * 64 + fr; int colt = u.pn * BM; bf16_t* base = O; float sc = 1.f; int t = 0;
        if (MODE == 1) { t = colt >> 10; base += (size_t)t * split_stride; colt &= 1023; if (t == 0) sc = scale0; }
        const int col0 = colt + wc * 32 + 8 * fq;
        float nmx[2] = {0.f, 0.f};
#pragma unroll
        for (int ai = 0; ai < 2; ++ai)
#pragma unroll
            for (int m = 0; m < 4; ++m) {
                const int row = row0 + ai * HALF + m * 16;
                float rsum;
                { const f32x4* rp = (const f32x4*)(rowsq + (size_t)row * 16); const f32x4 a0 = rp[0], a1 = rp[1], a2 = rp[2], a3 = rp[3];
                  rsum = (((a0[0] + a0[1]) + (a0[2] + a0[3])) + ((a1[0] + a1[1]) + (a1[2] + a1[3]))) + (((a2[0] + a2[1]) + (a2[2] + a2[3])) + ((a3[0] + a3[1]) + (a3[2] + a3[3]))); }
                const float rs = __builtin_amdgcn_rsqf(rsum * (1.0f / 1024.0f) + 1e-6f) * sc;
                bf16_t* rowp = base + (size_t)row * ldc + col0;
#pragma unroll
                for (int bj = 0; bj < 2; ++bj) {
                    f32x4 v0 = acc[ai][bj][m][0] * rs, v1 = acc[ai][bj][m][1] * rs;
                    if (MODE == 2) {
#pragma unroll
                        for (int e = 0; e < 4; ++e) { const float a = fmaxf(v0[e], 0.f), b = fmaxf(v1[e], 0.f); v0[e] = a * a; v1[e] = b * b; }
                    }
                    if (MODE == 1) {
                        float s = (v0[0] * v0[0] + v0[1] * v0[1]) + (v0[2] * v0[2] + v0[3] * v0[3]) + (v1[0] * v1[0] + v1[1] * v1[1]) + (v1[2] * v1[2] + v1[3] * v1[3]);
                        s += xor_lt32<16>(s); s = sum_x32(s);
                        nmx[bj] = fmaxf(nmx[bj], s);
                    }
                    u32x4 w; w.x = cvt_pk_bf16(v0[0], v0[1]); w.y = cvt_pk_bf16(v0[2], v0[3]); w.z = cvt_pk_bf16(v1[0], v1[1]); w.w = cvt_pk_bf16(v1[2], v1[3]);
                    *(u32x4*)(rowp + bj * HALF) = w;
                }
            }
        if (MODE == 1) {
            if (t < 2) {
                const int b = (u.pm * BM) >> logS;
#pragma unroll
                for (int bj = 0; bj < 2; ++bj) {
                    float v = nmx[bj];
                    v = fmaxf(v, xor_lt32<1>(v)); v = fmaxf(v, xor_lt32<2>(v)); v = fmaxf(v, xor_lt32<4>(v)); v = fmaxf(v, xor_lt32<8>(v));
                    const int map = (colt >> 6) + 2 * bj + (wc >> 1), half = wc & 1;
                    if (fr == 0 && fq == 0) atomicMax(nrm + (((t * 2 + b) * 16 + map) * 2 + half), __float_as_uint(v));
                }
            }
        }
    }
};
struct EpiRes {
    static constexpr bool PERM = false, AFTER_DRAIN = false;
    float* x; bf16_t* xb; float* rowsq; int dry;
    __device__ __forceinline__ void operator()(const f32x4 (&acc)[2][2][4][2], const Unit& u, int wr, int wc, int fr, int fq) const {
        typedef unsigned u32x2v __attribute__((ext_vector_type(2)));
        const int col0 = u.pn * BM + wc * 32 + 4 * fq;
#pragma unroll
        for (int ai = 0; ai < 2; ++ai)
#pragma unroll
            for (int m = 0; m < 4; ++m) {
                const int row = u.pm * BM + ai * HALF + wr * 64 + m * 16 + fr; const size_t off = (size_t)row * 1024 + col0;
                float ss = 0.f;
#pragma unroll
                for (int bj = 0; bj < 2; ++bj)
#pragma unroll
                    for (int n = 0; n < 2; ++n) {
                        const f32x4 xo = *(const f32x4*)(x + off + bj * HALF + n * 16);
                        const f32x4 xn = xo + acc[ai][bj][m][n];
                        *(f32x4*)(x + off + bj * HALF + n * 16) = dry ? xo : xn;
                        ss += (xn[0] * xn[0] + xn[1] * xn[1]) + (xn[2] * xn[2] + xn[3] * xn[3]);
                        u32x2v w; w.x = cvt_pk_bf16(xn[0], xn[1]); w.y = cvt_pk_bf16(xn[2], xn[3]);
                        *(u32x2v*)(xb + off + bj * HALF + n * 16) = w;
                    }
                ss += xor_lt32<16>(ss); ss = sum_x32(ss);
                if (fq == 0) rowsq[(size_t)row * 16 + u.pn * 4 + wc] = ss;
            }
    }
};

struct EpiNull {
    static constexpr bool PERM = false, AFTER_DRAIN = false;
    __device__ __forceinline__ void operator()(const f32x4 (&acc)[2][2][4][2], const Unit& u, int wr, int wc, int fr, int fq) const {
#pragma unroll
        for (int ai = 0; ai < 2; ++ai)
#pragma unroll
            for (int bj = 0; bj < 2; ++bj)
#pragma unroll
                for (int m = 0; m < 4; ++m)
#pragma unroll
                    for (int n = 0; n < 2; ++n) asm volatile("" :: "v"(acc[ai][bj][m][n]));
    }
};

template <class Epi, class Sched, bool ALIGN_EPI = false, bool SP2 = false>
__device__ __forceinline__ void gemm_phase(PG8_LAS unsigned char* lds, const Gemm g, const Sched& S, const Epi& E) {
    const int tid = mk_tid(), wid = __builtin_amdgcn_readfirstlane(tid >> 6), lane = tid & 63, wr = wid >> 2, wc = wid & 3, fr = lane & 15, fq = lane >> 4;
    const int K = g.K, nt = K / BK;
    unsigned voffA[2], voffB[2];
#pragma unroll
    for (int i = 0; i < 2; ++i) { int R, C; stage_rc(tid * 16 + i * 8192, R, C); const int Rb = Epi::PERM ? ((R & ~31) + perm32(R & 31)) : R;
        voffA[i] = (unsigned)(R * K + C) * 2u; voffB[i] = (unsigned)(Rb * K + C) * 2u; }
    const size_t kstep = (size_t)(BK * 2);
    const size_t hstep = (size_t)HALF * K * 2;
    const size_t tstep = 2 * hstep;
    const unsigned ldsw = (unsigned)wid * 1024u;
    const int aoff = lds_byte(wr * 64 + fr, fq * 8), boff = lds_byte(wc * 32 + fr, fq * 8);
#define PG8_SA(b, h) (((b) * 2 + (h)) * HTB)
#define PG8_SB(b, h) ((4 + (b) * 2 + (h)) * HTB)
#define PG8_STAGE(bufoff, gbase, voff) do { _Pragma("unroll") for (int _i = 0; _i < 2; ++_i) \
        __builtin_amdgcn_global_load_lds((const unsigned*)((const char*)(gbase) + (voff)[_i]), (PG8_LAS unsigned*)(lds + (bufoff) + ldsw + _i * 8192), 16, 0, 0); } while (0)
#define PG8_LDA(dst, b, h) do { _Pragma("unroll") for (int m = 0; m < 4; ++m) _Pragma("unroll") for (int k = 0; k < 2; ++k) dst[m][k] = *(const PG8_LAS bf16x8*)(lds + PG8_SA(b, h) + aoff + m * 2048 + k * 1024); } while (0)
#define PG8_LDB(dst, b, h) do { _Pragma("unroll") for (int n = 0; n < 2; ++n) _Pragma("unroll") for (int k = 0; k < 2; ++k) dst[n][k] = *(const PG8_LAS bf16x8*)(lds + PG8_SB(b, h) + boff + n * 2048 + k * 1024); } while (0)
#define PG8_MMA(ai, bj, At, Bt) do { __builtin_amdgcn_s_setprio(1); _Pragma("unroll") for (int m = 0; m < 4; ++m) _Pragma("unroll") for (int n = 0; n < 2; ++n) _Pragma("unroll") for (int k = 0; k < 2; ++k) \
        acc[ai][bj][m][n] = __builtin_amdgcn_mfma_f32_16x16x32_bf16(Bt[n][k], At[m][k], acc[ai][bj][m][n], 0, 0, 0); __builtin_amdgcn_s_setprio(0); } while (0)
#define PG8_WAIT_V(n) asm volatile("s_waitcnt vmcnt(" #n ")" ::: "memory")
#define PG8_WAIT_L(n) asm volatile("s_waitcnt lgkmcnt(" #n ")" ::: "memory")
#define PG8_BAR __builtin_amdgcn_s_barrier()
#define PG8_SCHED __builtin_amdgcn_sched_barrier(0)
    Unit cur, nxt; int ui = 0;
    if (!S.next(0, cur)) return;
    f32x4 acc[2][2][4][2];
#pragma unroll
    for (int a = 0; a < 2; ++a)
#pragma unroll
        for (int b = 0; b < 2; ++b)
#pragma unroll
            for (int m = 0; m < 4; ++m)
#pragma unroll
                for (int n = 0; n < 2; ++n) acc[a][b][m][n] = (f32x4){0.f, 0.f, 0.f, 0.f};
    bf16x8 At[4][2], B0[2][2], B1[2][2];
    const char* cA = (const char*)g.A + (size_t)cur.pm * tstep; const char* cB = (const char*)g.Bt + (size_t)cur.pn * tstep;
    S.a_ready(cur);
    if constexpr (SP2) {
        PG8_STAGE(PG8_SB(0, 0), cB, voffB); PG8_STAGE(PG8_SB(0, 1), cB + hstep, voffB); PG8_STAGE(PG8_SA(0, 0), cA, voffA); PG8_STAGE(PG8_SA(0, 1), cA + hstep, voffA);
        if (wr == 1) PG8_BAR;
        PG8_WAIT_V(2); PG8_BAR;
        PG8_STAGE(PG8_SB(1, 0), cB + kstep, voffB); PG8_STAGE(PG8_SA(1, 0), cA + kstep, voffA); PG8_STAGE(PG8_SB(1, 1), cB + hstep + kstep, voffB);
        PG8_WAIT_V(6); PG8_BAR;
    } else {
        PG8_STAGE(PG8_SB(0, 0), cB, voffB); PG8_STAGE(PG8_SA(0, 0), cA, voffA); PG8_STAGE(PG8_SB(0, 1), cB + hstep, voffB); PG8_STAGE(PG8_SA(0, 1), cA + hstep, voffA);
        if (wr == 1) PG8_BAR;
        PG8_WAIT_V(4); PG8_BAR;
        PG8_STAGE(PG8_SB(1, 0), cB + kstep, voffB); PG8_STAGE(PG8_SA(1, 0), cA + kstep, voffA); PG8_STAGE(PG8_SB(1, 1), cB + hstep + kstep, voffB);
        PG8_WAIT_V(6); PG8_BAR;
    }
    for (;;) {
        const bool has_next = S.next(ui + 1, nxt);
        const char* nA = has_next ? (const char*)g.A + (size_t)nxt.pm * tstep : cA; const char* nB = has_next ? (const char*)g.Bt + (size_t)nxt.pn * tstep : cB;
        for (int t = 0; t < nt; t += 2) {
            const bool last = (t == nt - 2);
            const char* a1 = cA + (size_t)(t + 1) * kstep;
            const char* a2 = last ? nA : cA + (size_t)(t + 2) * kstep; const char* b2 = last ? nB : cB + (size_t)(t + 2) * kstep;
            const char* a3 = a2 + kstep; const char* b3 = b2 + kstep;
            if (last && has_next) S.a_ready(nxt);
            if constexpr (SP2) {
            PG8_LDB(B0, 0, 0); PG8_LDB(B1, 0, 1); PG8_SCHED; PG8_LDA(At, 0, 0); PG8_STAGE(PG8_SA(1, 1), a1 + hstep, voffA);
            PG8_WAIT_V(8); PG8_WAIT_L(0); PG8_BAR; PG8_MMA(0, 0, At, B0); PG8_MMA(0, 1, At, B1); PG8_BAR; PG8_SCHED;
            PG8_LDA(At, 0, 1); PG8_STAGE(PG8_SB(0, 0), b2, voffB); PG8_STAGE(PG8_SB(0, 1), b2 + hstep, voffB); PG8_STAGE(PG8_SA(0, 0), a2, voffA);
            PG8_WAIT_V(8); PG8_WAIT_L(0); PG8_BAR; PG8_MMA(1, 0, At, B0); PG8_MMA(1, 1, At, B1); PG8_BAR; PG8_SCHED;
            PG8_LDB(B0, 1, 0); PG8_LDB(B1, 1, 1); PG8_SCHED; PG8_LDA(At, 1, 0); PG8_STAGE(PG8_SA(0, 1), a2 + hstep, voffA);
            PG8_WAIT_V(8); PG8_WAIT_L(0); PG8_BAR; PG8_MMA(0, 0, At, B0); PG8_MMA(0, 1, At, B1); PG8_BAR; PG8_SCHED;
            PG8_LDA(At, 1, 1); PG8_STAGE(PG8_SB(1, 0), b3, voffB); PG8_STAGE(PG8_SB(1, 1), b3 + hstep, voffB); PG8_STAGE(PG8_SA(1, 0), a3, voffA);
            PG8_WAIT_V(8); PG8_WAIT_L(0); PG8_BAR; PG8_MMA(1, 0, At, B0); PG8_MMA(1, 1, At, B1); PG8_BAR; PG8_SCHED;
            } else {
            PG8_LDB(B0, 0, 0); PG8_SCHED; PG8_LDA(At, 0, 0); PG8_STAGE(PG8_SA(1, 1), a1 + hstep, voffA);
            PG8_WAIT_L(8); PG8_BAR; PG8_WAIT_L(0); PG8_MMA(0, 0, At, B0); PG8_BAR; PG8_SCHED;
            PG8_LDB(B1, 0, 1); PG8_STAGE(PG8_SB(0, 0), b2, voffB);
            PG8_BAR; PG8_WAIT_L(0); PG8_MMA(0, 1, At, B1); PG8_BAR;
            PG8_LDA(At, 0, 1); PG8_STAGE(PG8_SA(0, 0), a2, voffA);
            PG8_BAR; PG8_WAIT_L(0); PG8_MMA(1, 0, At, B0); PG8_BAR; PG8_SCHED;
            PG8_STAGE(PG8_SB(0, 1), b2 + hstep, voffB);
            PG8_WAIT_V(6); PG8_BAR; PG8_MMA(1, 1, At, B1); PG8_BAR;
            PG8_LDB(B0, 1, 0); PG8_SCHED; PG8_LDA(At, 1, 0); PG8_STAGE(PG8_SA(0, 1), a2 + hstep, voffA);
            PG8_WAIT_L(8); PG8_BAR; PG8_WAIT_L(0); PG8_MMA(0, 0, At, B0); PG8_BAR; PG8_SCHED;
            PG8_LDB(B1, 1, 1); PG8_STAGE(PG8_SB(1, 0), b3, voffB);
            PG8_BAR; PG8_WAIT_L(0); PG8_MMA(0, 1, At, B1); PG8_BAR;
            PG8_LDA(At, 1, 1); PG8_STAGE(PG8_SA(1, 0), a3, voffA);
            PG8_BAR; PG8_WAIT_L(0); PG8_MMA(1, 0, At, B0); PG8_BAR; PG8_SCHED;
            PG8_STAGE(PG8_SB(1, 1), b3 + hstep, voffB);
            PG8_WAIT_V(6); PG8_BAR; PG8_MMA(1, 1, At, B1); PG8_BAR;
            }
        }
        if constexpr (ALIGN_EPI) { if (wr == 0) PG8_BAR; }
        if constexpr (!Epi::AFTER_DRAIN) { E(acc, cur, wr, wc, fr, fq); S.done(cur); }
        if (!has_next) break;
#pragma unroll
        for (int a = 0; a < 2; ++a)
#pragma unroll
            for (int b = 0; b < 2; ++b)
#pragma unroll
                for (int m = 0; m < 4; ++m)
#pragma unroll
                    for (int n = 0; n < 2; ++n) acc[a][b][m][n] = (f32x4){0.f, 0.f, 0.f, 0.f};
        cur = nxt; cA = nA; cB = nB; ++ui;
        if constexpr (ALIGN_EPI) { if (wr == 1) PG8_BAR; }
    }
    PG8_WAIT_V(0);
    if constexpr (!ALIGN_EPI) { if (wr == 0) PG8_BAR; }
    PG8_BAR;
    if constexpr (Epi::AFTER_DRAIN) { E.fused(acc, cur, wr, wc, fr, fq, lds, wid, lane); S.done(cur); }
#undef PG8_SA
#undef PG8_SB
#undef PG8_STAGE
#undef PG8_LDA
#undef PG8_LDB
#undef PG8_MMA
#undef PG8_WAIT_V
#undef PG8_WAIT_L
#undef PG8_BAR
#undef PG8_SCHED
}
}

namespace att {
typedef unsigned short bf16_t;
using bf16x8 = __attribute__((ext_vector_type(8))) short;
using s16x4  = __attribute__((ext_vector_type(4))) short;
using f32x16 = __attribute__((ext_vector_type(16))) float;
using u32x4  = __attribute__((ext_vector_type(4))) unsigned;
constexpr int NW = 8, QBLK = 32, KVBLK = 64, LD = 1024;
constexpr int SHM_V = KVBLK * 128 * 2, SHM_K = KVBLK * 64 * 2;
constexpr int OFF_V = 0, OFF_K = 2 * SHM_V, OFF_WS = OFF_K + 2 * SHM_K, OFF_UNIT = OFF_WS + NW * 64 * 4, LDS_BYTES = OFF_UNIT + 128;
constexpr int SDEPTH = 1;
constexpr float THR2 = 16.f;
#define KSWZ(row, colB) ((row) * 128 + ((colB) ^ ((((row) >> 1) & 7) << 4)))
#define SBAR() __builtin_amdgcn_sched_barrier(0)
#define SGB_MFMA_VALU(N, V) do { _Pragma("unroll") for (int _g = 0; _g < (N); ++_g) { __builtin_amdgcn_sched_group_barrier(0x008, 1, 0); __builtin_amdgcn_sched_group_barrier(0x400, (V), 0); } } while (0)
__device__ __forceinline__ int crow(int r, int hi) { return (r & 3) + 8 * (r >> 2) + 4 * hi; }
__device__ __forceinline__ unsigned cvtpk(float lo, float hi) { unsigned r; asm volatile("v_cvt_pk_bf16_f32 %0, %1, %2" : "=v"(r) : "v"(lo), "v"(hi)); return r; }

__device__ __forceinline__ void split3(float a, unsigned& h, unsigned& l, unsigned& ll) {
  h = cvtpk(a, 0.f) & 0xffffu; const float r1 = a - __uint_as_float(h << 16);
  l = cvtpk(r1, 0.f) & 0xffffu; const float r2 = r1 - __uint_as_float(l << 16);
  ll = cvtpk(r2, 0.f) & 0xffffu;
}
__device__ __forceinline__ void tile_ctl(int rel, float dq, float m_reg, float nc2, float smax, int hi, bf16x8& qx, int& mode, bool& skip) {
  mode = (rel <= -64) ? 1 : (rel >= 32) ? 2 : 0;
  const float dmin = (mode == 1) ? (float)(-rel - 63) : (float)(rel - 31);
  skip = (mode != 0) && (smax + nc2 * dmin <= THR2);
  const float A = (mode == 1 ? nc2 * dq : -nc2 * dq) - m_reg;
  unsigned ah, al, all_; split3(A, ah, al, all_);
  const unsigned sg = (mode == 1) ? 0x3F80u : 0xBF80u;
  u32x4 w = {ah | (al << 16), all_ | (sg << 16), sg | (sg << 16), 0u};
  if (hi != 0 || mode == 0) w = u32x4{0u, 0u, 0u, 0u};
  qx = *reinterpret_cast<bf16x8*>(&w);
}
__device__ __forceinline__ void partialSM(f32x16& p0, f32x16& p1, float& m_reg, float& alpha, int mode, bool skip, float dqh, float nc2) {
  if (mode == 0) {
    const float dq1 = dqh - 32.f;
#pragma unroll
    for (int r = 0; r < 16; ++r) p0[r] = fmaf(__builtin_fabsf(dqh - (float)((r & 3) + 8 * (r >> 2))), nc2, p0[r]) - m_reg;
#pragma unroll
    for (int r = 0; r < 16; ++r) p1[r] = fmaf(__builtin_fabsf(dq1 - (float)((r & 3) + 8 * (r >> 2))), nc2, p1[r]) - m_reg;
  }
  alpha = 1.f;
  if (!skip) {
    float pmax = p0[0];
#pragma unroll
    for (int r = 1; r < 16; ++r) pmax = fmaxf(pmax, p0[r]);
#pragma unroll
    for (int r = 0; r < 16; ++r) pmax = fmaxf(pmax, p1[r]);
    { auto rr = __builtin_amdgcn_permlane32_swap(__float_as_uint(pmax), __float_as_uint(pmax), false, false);
      pmax = fmaxf(__uint_as_float(rr[0]), __uint_as_float(rr[1])); }
    if (__builtin_expect(!__all(pmax <= THR2), 0)) {
      const float dl = fmaxf(pmax, 0.f); m_reg += dl; alpha = __builtin_amdgcn_exp2f(-dl);
#pragma unroll
      for (int r = 0; r < 16; ++r) p0[r] -= dl;
#pragma unroll
      for (int r = 0; r < 16; ++r) p1[r] -= dl;
    }
  }
}
__device__ __forceinline__ void expP0(f32x16& p0) {
#pragma unroll
  for (int r = 0; r < 16; ++r) p0[r] = __builtin_amdgcn_exp2f(p0[r]);
}
__device__ __forceinline__ void finishSM(f32x16& p0, f32x16& p1, float alpha, float& l_reg, bf16x8& pa0, bf16x8& pa1, bf16x8& pa2, bf16x8& pa3) {
#pragma unroll
  for (int r = 0; r < 16; ++r) p1[r] = __builtin_amdgcn_exp2f(p1[r]);
  float ps = 0;
#pragma unroll
  for (int r = 0; r < 16; ++r) ps += p0[r];
#pragma unroll
  for (int r = 0; r < 16; ++r) ps += p1[r];
  { auto rr = __builtin_amdgcn_permlane32_swap(__float_as_uint(ps), __float_as_uint(ps), false, false);
    ps = __uint_as_float(rr[0]) + __uint_as_float(rr[1]); }
  l_reg = l_reg * alpha + ps;
#define PK4(P, BASE, OUT) do { unsigned a0 = cvtpk(P[BASE + 0], P[BASE + 1]), a1 = cvtpk(P[BASE + 2], P[BASE + 3]);   \
    unsigned b0 = cvtpk(P[BASE + 4], P[BASE + 5]), b1 = cvtpk(P[BASE + 6], P[BASE + 7]);                              \
    auto r0 = __builtin_amdgcn_permlane32_swap(a0, b0, false, false); auto r1 = __builtin_amdgcn_permlane32_swap(a1, b1, false, false); \
    u32x4 w = {r0[0], r1[0], r0[1], r1[1]}; OUT = *reinterpret_cast<bf16x8*>(&w); } while (0)
  PK4(p0, 0, pa0); PK4(p0, 8, pa1); PK4(p1, 0, pa2); PK4(p1, 8, pa3);
#undef PK4
}
__device__ __forceinline__ void qkt(f32x16& p0, f32x16& p1, const char* Ks, const bf16x8* qr, int r32, int hi, bf16x8 kx0, bf16x8 kx1, bf16x8 qx) {
  p0 = __builtin_amdgcn_mfma_f32_32x32x16_bf16(kx0, qx, f32x16{}, 0, 0, 0); p1 = __builtin_amdgcn_mfma_f32_32x32x16_bf16(kx1, qx, f32x16{}, 0, 0, 0);
#pragma unroll
  for (int d0 = 0; d0 < 4; ++d0) { const int cb = d0 * 32 + hi * 16;
    bf16x8 b0 = *reinterpret_cast<const bf16x8*>(Ks + KSWZ(r32, cb));
    bf16x8 b1 = *reinterpret_cast<const bf16x8*>(Ks + KSWZ(32 + r32, cb));
    p0 = __builtin_amdgcn_mfma_f32_32x32x16_bf16(b0, qr[d0], p0, 0, 0, 0);
    p1 = __builtin_amdgcn_mfma_f32_32x32x16_bf16(b1, qr[d0], p1, 0, 0, 0); }
}
__device__ __forceinline__ int v_st(int k, int c) { const int kk = (k & ~0xC) | ((k & 4) << 1) | ((k & 8) >> 1); return ((kk >> 3) * 4 + (c >> 5)) * 512 + ((kk & 7) * 32 + (c & 31)) * 2; }
__device__ __forceinline__ int v_rd_base(int lane) { return ((lane & 3) << 3) | (((lane >> 2) & 3) << 6) | (((lane >> 4) & 1) << 5) | (((lane >> 5) & 1) << 8); }
constexpr int v_rd_off(int d0, int ks, int half) { return d0 * 512 + ks * 4096 + half * 2048; }
template <int OFF> __device__ __forceinline__ s16x4 tr_read(int vb) {
  s16x4 r; asm volatile("ds_read_b64_tr_b16 %0, %1 offset:%2" : "=&v"(r) : "v"(vb), "i"(OFF) : "memory"); return r;
}
#define PV_RD(D0, L, H) do { L[0] = tr_read<v_rd_off(D0, 0, 0)>(vb); H[0] = tr_read<v_rd_off(D0, 0, 1)>(vb); L[1] = tr_read<v_rd_off(D0, 1, 0)>(vb); H[1] = tr_read<v_rd_off(D0, 1, 1)>(vb); \
    L[2] = tr_read<v_rd_off(D0, 2, 0)>(vb); H[2] = tr_read<v_rd_off(D0, 2, 1)>(vb); L[3] = tr_read<v_rd_off(D0, 3, 0)>(vb); H[3] = tr_read<v_rd_off(D0, 3, 1)>(vb); } while (0)
#define PV_RD2(D0, KS, L, H) do { L[KS] = tr_read<v_rd_off(D0, KS, 0)>(vb); H[KS] = tr_read<v_rd_off(D0, KS, 1)>(vb); } while (0)
#define PV_WAIT(N, L, H) asm volatile("s_waitcnt lgkmcnt(" #N ")" : "+v"(L[0]), "+v"(H[0]), "+v"(L[1]), "+v"(H[1]), "+v"(L[2]), "+v"(H[2]), "+v"(L[3]), "+v"(H[3]))
#define PV_PK(L, H, KS) (bf16x8){L[KS][0], L[KS][1], L[KS][2], L[KS][3], H[KS][0], H[KS][1], H[KS][2], H[KS][3]}
#define PV_MF(D0, KS, PA, L, H, R) do { o[D0] = __builtin_amdgcn_mfma_f32_32x32x16_bf16(PA, PV_PK(L, H, KS), o[D0], 0, 0, 0); \
    if (EXPS) { px[R] = __builtin_amdgcn_exp2f(px[R]); asm volatile("" : "+v"(px)); } SBAR(); } while (0)
template <bool EXPS> __device__ __forceinline__ void pv_d0(f32x16* o, int vb, bf16x8 pa0, bf16x8 pa1, bf16x8 pa2, bf16x8 pa3, f32x16& px) {
  s16x4 la[4], ha[4], lb[4], hb[4];
  SBAR(); PV_RD(0, la, ha); SBAR();
  PV_RD2(1, 0, lb, hb); PV_WAIT(2, la, ha);  PV_MF(0, 0, pa0, la, ha, 0);
  PV_RD2(1, 1, lb, hb);                       PV_MF(0, 1, pa1, la, ha, 1);
  PV_RD2(1, 2, lb, hb);                       PV_MF(0, 2, pa2, la, ha, 2);
  PV_RD2(1, 3, lb, hb);                       PV_MF(0, 3, pa3, la, ha, 3);
  PV_RD2(2, 0, la, ha); PV_WAIT(2, lb, hb);  PV_MF(1, 0, pa0, lb, hb, 4);
  PV_RD2(2, 1, la, ha);                       PV_MF(1, 1, pa1, lb, hb, 5);
  PV_RD2(2, 2, la, ha);                       PV_MF(1, 2, pa2, lb, hb, 6);
  PV_RD2(2, 3, la, ha);                       PV_MF(1, 3, pa3, lb, hb, 7);
  PV_RD2(3, 0, lb, hb); PV_WAIT(2, la, ha);  PV_MF(2, 0, pa0, la, ha, 8);
  PV_RD2(3, 1, lb, hb);                       PV_MF(2, 1, pa1, la, ha, 9);
  PV_RD2(3, 2, lb, hb);                       PV_MF(2, 2, pa2, la, ha, 10);
  PV_RD2(3, 3, lb, hb);                       PV_MF(2, 3, pa3, la, ha, 11);
                        PV_WAIT(0, lb, hb);  PV_MF(3, 0, pa0, lb, hb, 12);
                                              PV_MF(3, 1, pa1, lb, hb, 13);
                                              PV_MF(3, 2, pa2, lb, hb, 14);
                                              PV_MF(3, 3, pa3, lb, hb, 15);
}

__device__ __forceinline__ void attn_pass(const bf16_t* __restrict__ Qw, const bf16_t* __restrict__ Kh, const bf16_t* __restrict__ Vh,
                                          int NT, float dqbase, int rel0, float nc2, float smax, f32x16 (&o)[4], char* lds) {
  const int tid = mk_tid(), wid = tid >> 6, lane = tid & 63, r32 = lane & 31, hi = lane >> 5;
  char* V_lds = lds + OFF_V; char* K_lds = lds + OFF_K;
  float* ws = (float*)(lds + OFF_WS) + wid * 64; float* li_l = ws; float* al_l = ws + 32;
  float m_reg = 0.f, l_reg = 0; bf16x8 qr[4];
#pragma unroll
  for (int d = 0; d < 4; ++d) o[d] = f32x16{};
#pragma unroll
  for (int d0 = 0; d0 < 4; ++d0) qr[d0] = *reinterpret_cast<const bf16x8*>(Qw + d0 * 16);
  const float dqh0 = dqbase - (float)(4 * hi);
  bf16x8 kx0, kx1;
  { unsigned bh, bl, bll; u32x4 w;
    split3(-nc2 * (float)r32, bh, bl, bll); w = u32x4{0x3F803F80u, 0x3F80u | (bh << 16), bl | (bll << 16), 0u}; if (hi) w = u32x4{0u, 0u, 0u, 0u}; kx0 = *reinterpret_cast<bf16x8*>(&w);
    split3(-nc2 * (float)(32 + r32), bh, bl, bll); w = u32x4{0x3F803F80u, 0x3F80u | (bh << 16), bl | (bll << 16), 0u}; if (hi) w = u32x4{0u, 0u, 0u, 0u}; kx1 = *reinterpret_cast<bf16x8*>(&w); }
  bf16x8 qx; int mdA, mdB; bool skA, skB;
#define CTL(j, MD, SK) tile_ctl(rel0 + (j) * KVBLK, dqbase - (float)((j) * KVBLK), m_reg, nc2, smax, hi, qx, MD, SK)
  const int sr = tid >> 4, sc = (tid & 15) * 8, vst0 = v_st(sr, sc), vst1 = v_st(32 + sr, sc);
  const int krow = tid >> 3, kcol = (tid & 7) * 8, kst = KSWZ(krow, kcol * 2);
  const int vb0 = (int)(uintptr_t)V_lds + v_rd_base(lane);
  struct { bf16x8 vs0, vs1, ks0; } sr_[SDEPTH];
#define SLOAD(i, k0) do { sr_[i].vs0 = *reinterpret_cast<const bf16x8*>(&Vh[(long)((k0) + sr) * LD + sc]); sr_[i].vs1 = *reinterpret_cast<const bf16x8*>(&Vh[(long)((k0) + 32 + sr) * LD + sc]); \
    sr_[i].ks0 = *reinterpret_cast<const bf16x8*>(&Kh[(long)((k0) + krow) * LD + kcol]); } while (0)
#define SWRITE(b, i) do { *(bf16x8*)(V_lds + (b) * SHM_V + vst0) = sr_[i].vs0; *(bf16x8*)(V_lds + (b) * SHM_V + vst1) = sr_[i].vs1; \
    *(bf16x8*)(K_lds + (b) * SHM_K + kst) = sr_[i].ks0; } while (0)
#define SWAIT() do { if constexpr (SDEPTH == 2) asm volatile("s_waitcnt vmcnt(3)" ::: "memory"); else asm volatile("s_waitcnt vmcnt(0)" ::: "memory"); } while (0)
#define RESC(a) do { if (__any((a) < 1.f)) { if (hi == 0) al_l[r32] = (a); asm volatile("s_waitcnt lgkmcnt(0)" ::: "memory"); \
    _Pragma("unroll") for (int d = 0; d < 4; ++d) _Pragma("unroll") for (int r = 0; r < 16; ++r) o[d][r] *= al_l[crow(r, hi)]; } } while (0)
  f32x16 pA0, pA1, pB0, pB1; float alA, alB; bf16x8 pa0, pa1, pa2, pa3;
  constexpr int SE = 0, SO = SDEPTH - 1;
  __syncthreads();
  SLOAD(SE, 0); asm volatile("s_waitcnt vmcnt(0)" ::: "memory"); SWRITE(0, SE); __syncthreads();
  CTL(0, mdA, skA); qkt(pA0, pA1, K_lds, qr, r32, hi, kx0, kx1, qx); partialSM(pA0, pA1, m_reg, alA, mdA, skA, dqh0, nc2); expP0(pA0);
  SLOAD(SO, KVBLK); if constexpr (SDEPTH == 2) { if (2 < NT) SLOAD(SE, 2 * KVBLK); }
  SWAIT(); SWRITE(1, SO); __syncthreads();
  for (int j = 1; j + 1 < NT; j += 2) {
    SBAR(); CTL(j, mdB, skB); qkt(pB0, pB1, K_lds + SHM_K, qr, r32, hi, kx0, kx1, qx);
    finishSM(pA0, pA1, alA, l_reg, pa0, pa1, pa2, pa3); SBAR();
    SLOAD(SO, (j + SDEPTH) * KVBLK); SBAR();
    partialSM(pB0, pB1, m_reg, alB, mdB, skB, dqh0 - (float)(j * KVBLK), nc2); SBAR();
    pv_d0<true>(o, vb0, pa0, pa1, pa2, pa3, pB0);
    __syncthreads(); SWAIT(); SWRITE(0, SE);
    RESC(alB); __syncthreads();
    SBAR(); CTL(j + 1, mdA, skA); qkt(pA0, pA1, K_lds, qr, r32, hi, kx0, kx1, qx);
    finishSM(pB0, pB1, alB, l_reg, pa0, pa1, pa2, pa3); SBAR();
    if (SDEPTH == 1 || j + 3 < NT) SLOAD(SE, (j + 1 + SDEPTH) * KVBLK); SBAR();
    partialSM(pA0, pA1, m_reg, alA, mdA, skA, dqh0 - (float)((j + 1) * KVBLK), nc2); SBAR();
    pv_d0<true>(o, vb0 + SHM_V, pa0, pa1, pa2, pa3, pA0);
    __syncthreads(); SWAIT(); SWRITE(1, SO);
    RESC(alA); __syncthreads();
  }
  SBAR(); CTL(NT - 1, mdB, skB); qkt(pB0, pB1, K_lds + SHM_K, qr, r32, hi, kx0, kx1, qx);
  finishSM(pA0, pA1, alA, l_reg, pa0, pa1, pa2, pa3); SBAR();
  partialSM(pB0, pB1, m_reg, alB, mdB, skB, dqh0 - (float)((NT - 1) * KVBLK), nc2); SBAR();
  pv_d0<true>(o, vb0, pa0, pa1, pa2, pa3, pB0);
  __syncthreads(); RESC(alB);
  finishSM(pB0, pB1, alB, l_reg, pa0, pa1, pa2, pa3); SBAR();
  pv_d0<false>(o, vb0 + SHM_V, pa0, pa1, pa2, pa3, pB0);
  if (hi == 0) li_l[r32] = l_reg; asm volatile("s_waitcnt lgkmcnt(0)" ::: "memory");
#pragma unroll
  for (int r = 0; r < 16; ++r) { const float rli = __builtin_amdgcn_rcpf(li_l[crow(r, hi)]);
#pragma unroll
    for (int d0 = 0; d0 < 4; ++d0) o[d0][r] *= rli; }
#undef CTL
#undef SLOAD
#undef SWRITE
#undef SWAIT
#undef RESC
}
}

typedef unsigned short bf16;
typedef unsigned v4u __attribute__((ext_vector_type(4)));
typedef unsigned v2u __attribute__((ext_vector_type(2)));
typedef float f32x4 __attribute__((ext_vector_type(4)));
#define LAS __attribute__((address_space(3)))
constexpr int NWAVES = 8, NTHREADS = 512;
constexpr int D = 1024, FF = 4096, MG = 16384, MTOT = 32768;
constexpr int DEPTH = 4;
constexpr float QSCALE = 0.125f * 1.4426950408889634f;
constexpr size_t MiB = 1u << 20;
constexpr size_t WS_CTL = 0, WS_ZERO_END = 64 * 1024;
constexpr size_t WS_WMI = 2 * MiB, WS_WMO = 10 * MiB, WS_WQKV = 14 * MiB, WS_WAO = 26 * MiB, WS_W1 = 30 * MiB, WS_W2 = 62 * MiB;
constexpr size_t WS_XB = 94 * MiB, WS_BIG = 126 * MiB, WS_ROWSQ = 254 * MiB, WS_END = WS_ROWSQ + 9 * (size_t)MG * 64;
static_assert(WS_ZERO_END <= WS_WMI, "ws map");
constexpr int CW_ATTCTR = 0;
constexpr int CW_ARR = 8192;
constexpr int CW_BAR = 4096;
constexpr int CW_NRM = 1024;

struct Args {
    const float* in[19]; float* out; unsigned char* ws; int ph_lo, ph_hi;
};

__device__ __forceinline__ unsigned f2bf(float f) { unsigned u = __builtin_bit_cast(unsigned, f); return (u + 0x7fffu + ((u >> 16) & 1u)) >> 16; }
__device__ __forceinline__ unsigned pk2(float lo, float hi) { return f2bf(lo) | (f2bf(hi) << 16); }
__device__ __forceinline__ float bflo(unsigned w) { return __uint_as_float(w << 16); }
__device__ __forceinline__ float bfhi(unsigned w) { return __uint_as_float(w & 0xffff0000u); }
__device__ __forceinline__ float wave_sum(float v) {
    v += xor_lt32<1>(v); v += xor_lt32<2>(v); v += xor_lt32<4>(v); v += xor_lt32<8>(v); v += xor_lt32<16>(v);
    return sum_x32(v);
}

__device__ __forceinline__ void transpose_item(const float* W, int ldw, int N, const float* gs, bf16* WT, int ldk, int koff, LAS float* scr, int item, int lane) {
    const int nblk = N / 32, kb = item / nblk, nb = item % nblk, k0 = 64 * kb, n0 = 32 * nb;
#pragma unroll
    for (int i = 0; i < 8; ++i) { const int kk = 8 * i + (lane >> 3), c4 = (lane & 7) * 4;
        f32x4 v = *(const f32x4*)(W + (size_t)(k0 + kk) * ldw + n0 + c4); if (gs) v = v * gs[k0 + kk];
        scr[kk * 33 + c4] = v[0]; scr[kk * 33 + c4 + 1] = v[1]; scr[kk * 33 + c4 + 2] = v[2]; scr[kk * 33 + c4 + 3] = v[3]; }
    asm volatile("s_waitcnt lgkmcnt(0)" ::: "memory");
    const int c = lane & 7;
#pragma unroll
    for (int j = 0; j < 4; ++j) { const int n = (lane >> 3) + 8 * j; const LAS float* s = scr + (8 * c) * 33 + n;
        v4u o; o.x = pk2(s[0 * 33], s[1 * 33]); o.y = pk2(s[2 * 33], s[3 * 33]); o.z = pk2(s[4 * 33], s[5 * 33]); o.w = pk2(s[6 * 33], s[7 * 33]);
        *(v4u*)(WT + (size_t)(n0 + n) * ldk + koff + k0 + 8 * c) = o; }
    asm volatile("s_waitcnt lgkmcnt(0)" ::: "memory");
}

__device__ __forceinline__ void phase_prologue(const Args& a, LAS unsigned char* lds) {
    const int tid = mk_tid(), lane = tid & 63, wave = tid >> 6;
    const int gt = blockIdx.x * NTHREADS + tid, NGT = gridDim.x * NTHREADS;
    const int gw = blockIdx.x * NWAVES + wave, NGW = gridDim.x * NWAVES;
    { v4u z = {0u, 0u, 0u, 0u}; v4u* p = (v4u*)(a.ws + WS_CTL); for (int i = gt; i < (int)(WS_ZERO_END / 16); i += NGT) p[i] = z; }
    LAS float* scr = (LAS float*)(lds + wave * 16384);
    const float* norm1_g = a.in[2]; const float* norm2_g = a.in[3];
    constexpr int I_MI = 16 * 64, I_MO = 8 * 32, I_QKV = 16 * 96, I_AO = 16 * 32, I_W1 = 16 * 128, I_W2 = 64 * 32;
    constexpr int T_MI = 2 * I_MI, T_MO = T_MI + 2 * I_MO, T_QKV = T_MO + 2 * I_QKV, T_AO = T_QKV + 2 * I_AO, T_W1 = T_AO + 4 * I_W1, T_W2 = T_W1 + 4 * I_W2;
    for (int it = gw; it < T_W2; it += NGW) {
        if (it < T_MI) { const int j = it / I_MI, r = it % I_MI;
            transpose_item(a.in[5] + (size_t)j * D * 2048, 2048, 2048, norm1_g + (2 * j) * D, (bf16*)(a.ws + WS_WMI) + (size_t)j * 2048 * D, D, 0, scr, r, lane); }
        else if (it < T_MO) { const int q = it - T_MI, j = q / I_MO, r = q % I_MO;
            transpose_item(a.in[9] + (size_t)j * D * D + (size_t)512 * D, D, D, nullptr, (bf16*)(a.ws + WS_WMO) + (size_t)j * D * D, D, 512, scr, r, lane); }
        else if (it < T_QKV) { const int q = it - T_MO, j = q / I_QKV, r = q % I_QKV;
            transpose_item(a.in[10] + (size_t)j * D * 3072, 3072, 3072, norm1_g + (2 * j + 1) * D, (bf16*)(a.ws + WS_WQKV) + (size_t)j * 3072 * D, D, 0, scr, r, lane); }
        else if (it < T_AO) { const int q = it - T_QKV, j = q / I_AO, r = q % I_AO;
            transpose_item(a.in[11] + (size_t)j * D * D, D, D, nullptr, (bf16*)(a.ws + WS_WAO) + (size_t)j * D * D, D, 0, scr, r, lane); }
        else if (it < T_W1) { const int q = it - T_AO, i = q / I_W1, r = q % I_W1;
            transpose_item(a.in[17] + (size_t)i * D * FF, FF, FF, norm2_g + i * D, (bf16*)(a.ws + WS_W1) + (size_t)i * FF * D, D, 0, scr, r, lane); }
        else { const int q = it - T_W1, i = q / I_W2, r = q % I_W2;
            transpose_item(a.in[18] + (size_t)i * FF * D, D, D, nullptr, (bf16*)(a.ws + WS_W2) + (size_t)i * D * FF, FF, 0, scr, r, lane); }
    }
    for (int it = gw; it < 2 * 4 * 16 * 16; it += NGW) {
        const int cb = it & 15, nb = (it >> 4) & 15, g = (it >> 8) & 3, j = it >> 10;
        const float* pw = a.in[6] + ((size_t)(j * 4 + g) * 128 + cb * 8) * 128;
        const float* ps = a.in[7] + j * 512 + g * 128;
        const float* mo = a.in[9] + (size_t)j * D * D + (size_t)(g * 128) * D + nb * 64 + lane;
        float acc[8];
#pragma unroll
        for (int c = 0; c < 8; ++c) acc[c] = 0.f;
#pragma unroll 8
        for (int d = 0; d < 128; ++d) {
            const float m = mo[(size_t)d * D] * ps[d];
#pragma unroll
            for (int c = 0; c < 8; ++c) acc[c] = fmaf(pw[c * 128 + d], m, acc[c]);
        }
        v4u o; o.x = pk2(acc[0], acc[1]); o.y = pk2(acc[2], acc[3]); o.z = pk2(acc[4], acc[5]); o.w = pk2(acc[6], acc[7]);
        *(v4u*)((bf16*)(a.ws + WS_WMO) + (size_t)j * D * D + (size_t)(nb * 64 + lane) * D + g * 128 + cb * 8) = o;
    }
}

__device__ __forceinline__ void phase_prep(const Args& a, int g) {
    const int tid = mk_tid(), lane = tid & 63, gw = blockIdx.x * NWAVES + (tid >> 6), NGW = gridDim.x * NWAVES;
    const float* xin = g ? a.in[1] : a.in[0]; float* xo = a.out + (size_t)g * MG * D; bf16* xb = (bf16*)(a.ws + WS_XB); float* rsq = (float*)(a.ws + WS_ROWSQ);
    for (int m = gw; m < MG; m += NGW) {
        const f32x4* xr = (const f32x4*)(xin + (size_t)m * D) + lane; f32x4* orow = (f32x4*)(xo + (size_t)m * D) + lane; v2u* brow = (v2u*)(xb + (size_t)m * D) + lane;
        float s = 0.f;
#pragma unroll
        for (int j = 0; j < 4; ++j) { const f32x4 v = xr[64 * j]; orow[64 * j] = v; s += (v[0] * v[0] + v[1] * v[1]) + (v[2] * v[2] + v[3] * v[3]);
            v2u w; w.x = pk2(v[0], v[1]); w.y = pk2(v[2], v[3]); brow[64 * j] = w; }
        s = wave_sum(s);
        if (lane < 16) rsq[(size_t)m * 16 + lane] = lane == 0 ? s : 0.f;
    }
}
__device__ __forceinline__ void phase_final(const Args& a, int g) {
    const int tid = mk_tid(), lane = tid & 63, gw = blockIdx.x * NWAVES + (tid >> 6), NGW = gridDim.x * NWAVES;
    float* xo = a.out + (size_t)g * MG * D; const float* rsq = (const float*)(a.ws + WS_ROWSQ) + (size_t)8 * MG * 16; const f32x4* fg = (const f32x4*)a.in[4] + lane;
    for (int m = gw; m < MG; m += NGW) {
        float rsum;
        { const f32x4* rp = (const f32x4*)(rsq + (size_t)m * 16); const f32x4 a0 = rp[0], a1 = rp[1], a2 = rp[2], a3 = rp[3];
          rsum = (((a0[0] + a0[1]) + (a0[2] + a0[3])) + ((a1[0] + a1[1]) + (a1[2] + a1[3]))) + (((a2[0] + a2[1]) + (a2[2] + a2[3])) + ((a3[0] + a3[1]) + (a3[2] + a3[3]))); }
        const float rs = __builtin_amdgcn_rsqf(rsum * (1.0f / 1024.0f) + 1e-6f);
        f32x4* orow = (f32x4*)(xo + (size_t)m * D) + lane;
#pragma unroll
        for (int j = 0; j < 4; ++j) { f32x4 v = orow[64 * j]; const f32x4 gg = fg[64 * j]; v = v * rs * gg; orow[64 * j] = v; }
    }
}

__device__ __forceinline__ void unpack8(const v4u w, float (&f)[8]) {
    f[0] = bflo(w.x); f[1] = bfhi(w.x); f[2] = bflo(w.y); f[3] = bfhi(w.y); f[4] = bflo(w.z); f[5] = bfhi(w.z); f[6] = bflo(w.w); f[7] = bfhi(w.w);
}
__device__ __forceinline__ void phase_stencil(const Args& a, int g, int j) {
    const int S = g ? 16384 : 8192;
    const bf16* P = (const bf16*)(a.ws + WS_BIG); bf16* A2 = (bf16*)(a.ws + WS_BIG + 64 * MiB);
    const int tid = mk_tid(), chunk = tid & 127, tb = tid >> 7;
    for (int tile = blockIdx.x; tile < MG / 64; tile += gridDim.x) {
        const int row0 = tile * 64 + tb * 16;
        const int b0 = row0 & ~(S - 1), t0 = row0 & (S - 1);
        if (chunk < 64) {
            const int c0 = chunk * 8, hw = 1 << (chunk >> 4);
            const bf16* U = P + (size_t)b0 * 2048 + c0;
            float sum[8];
#pragma unroll
            for (int e = 0; e < 8; ++e) sum[e] = 0.f;
            { const int lo = max(t0 - hw, 0), hi = min(t0 + hw, S);
              for (int t = lo; t < hi; ++t) { float f[8]; unpack8(*(const v4u*)(U + (size_t)t * 2048), f);
#pragma unroll
                  for (int e = 0; e < 8; ++e) sum[e] += f[e]; } }
            for (int i = 0; i < 16; ++i) {
                const int t = t0 + i; const int lo = max(t - hw, 0), hi = min(t + hw, S);
                const float rc = 1.0f / (float)(hi - lo);
                float f[8]; unpack8(*(const v4u*)(U + (size_t)t * 2048), f);
                v4u o; o.x = pk2(sum[0] * rc - f[0], sum[1] * rc - f[1]); o.y = pk2(sum[2] * rc - f[2], sum[3] * rc - f[3]);
                o.z = pk2(sum[4] * rc - f[4], sum[5] * rc - f[5]); o.w = pk2(sum[6] * rc - f[6], sum[7] * rc - f[7]);
                *(v4u*)(A2 + (size_t)(b0 + t) * 1024 + c0) = o;
                if (t + hw < S) { float n[8]; unpack8(*(const v4u*)(U + (size_t)(t + hw) * 2048), n);
#pragma unroll
                    for (int e = 0; e < 8; ++e) sum[e] += n[e]; }
                if (t - hw >= 0) { float n[8]; unpack8(*(const v4u*)(U + (size_t)(t - hw) * 2048), n);
#pragma unroll
                    for (int e = 0; e < 8; ++e) sum[e] -= n[e]; }
            }
        } else {
            const int c0 = (chunk - 64) * 8;
            const bf16* Hc = P + (size_t)b0 * 2048 + 512 + c0; const bf16* Gb = Hc + 512; const bf16* Gc = Hc + 1024;
            const float* cw = a.in[8] + (size_t)j * 3 * 512 + c0;
            float w0[8], w1[8], w2[8];
#pragma unroll
            for (int e = 0; e < 8; ++e) { w0[e] = cw[e]; w1[e] = cw[512 + e]; w2[e] = cw[1024 + e]; }
            float zp[8], zc[8];
            if (t0 > 0) { float hh[8], cc[8]; unpack8(*(const v4u*)(Hc + (size_t)(t0 - 1) * 2048), hh); unpack8(*(const v4u*)(Gc + (size_t)(t0 - 1) * 2048), cc);
#pragma unroll
                for (int e = 0; e < 8; ++e) zp[e] = hh[e] * cc[e]; }
            else {
#pragma unroll
                for (int e = 0; e < 8; ++e) zp[e] = 0.f; }
            { float hh[8], cc[8]; unpack8(*(const v4u*)(Hc + (size_t)t0 * 2048), hh); unpack8(*(const v4u*)(Gc + (size_t)t0 * 2048), cc);
#pragma unroll
              for (int e = 0; e < 8; ++e) zc[e] = hh[e] * cc[e]; }
            for (int i = 0; i < 16; ++i) {
                const int t = t0 + i; float zn[8];
                if (t + 1 < S) { float hh[8], cc[8]; unpack8(*(const v4u*)(Hc + (size_t)(t + 1) * 2048), hh); unpack8(*(const v4u*)(Gc + (size_t)(t + 1) * 2048), cc);
#pragma unroll
                    for (int e = 0; e < 8; ++e) zn[e] = hh[e] * cc[e]; }
                else {
#pragma unroll
                    for (int e = 0; e < 8; ++e) zn[e] = 0.f; }
                float gb[8], r[8]; unpack8(*(const v4u*)(Gb + (size_t)t * 2048), gb);
#pragma unroll
                for (int e = 0; e < 8; ++e) r[e] = gb[e] * (w0[e] * zp[e] + w1[e] * zc[e] + w2[e] * zn[e]);
                v4u o; o.x = pk2(r[0], r[1]); o.y = pk2(r[2], r[3]); o.z = pk2(r[4], r[5]); o.w = pk2(r[6], r[7]);
                *(v4u*)(A2 + (size_t)(b0 + t) * 1024 + 512 + c0) = o;
#pragma unroll
                for (int e = 0; e < 8; ++e) { zp[e] = zc[e]; zc[e] = zn[e]; }
            }
        }
    }
}

__device__ __forceinline__ void phase_attention(const Args& a, int g, int layer, char* lds) {
    using namespace att;
    const int S = g ? 16384 : 8192, logS = g ? 14 : 13; const int j = layer >> 1;
    const bf16* Qb = (const bf16*)(a.ws + WS_BIG); const bf16* Kb = Qb + (size_t)MG * 1024; const bf16* Vb = Kb + (size_t)MG * 1024; bf16* Ob = (bf16*)(a.ws + WS_BIG);
    unsigned* ctr = (unsigned*)(a.ws + WS_CTL) + CW_ATTCTR + 64 * (g * 2 + j);
    unsigned* arr = (unsigned*)(a.ws + WS_CTL) + CW_ARR + 1024 * (g * 2 + j);
    const unsigned* nrm = (const unsigned*)(a.ws + WS_CTL) + CW_NRM + 256 * (g * 2 + j);
    volatile unsigned* s_unit = (volatile unsigned*)(lds + OFF_UNIT);
    const float lambda_init = (layer == 1) ? 0.35550906759096926f : 0.5560582041556405f;
    float lam;
    { const float* q1 = a.in[12] + j * 64; const float* k1 = a.in[13] + j * 64; const float* q2 = a.in[14] + j * 64; const float* k2 = a.in[15] + j * 64;
      const int lane = mk_tid() & 63; float s1 = q1[lane] * k1[lane], s2 = q2[lane] * k2[lane]; s1 = wave_sum(s1); s2 = wave_sum(s2); lam = __expf(s1) - __expf(s2) + lambda_init; }
    const float* subg = a.in[16] + j * 128;
    for (;;) {
        const int tid = mk_tid(), wid = tid >> 6, lane = tid & 63, r32 = lane & 31, hi = lane >> 5;
        __syncthreads();
        if (tid == 0) s_unit[0] = atomicAdd(ctr, 1u);
        __syncthreads();
        const int tk = (int)s_unit[0];
        if (tk >= 1024 * MK_DUP_ATT) break;
        const int u = tk / MK_DUP_ATT; const bool dup = (tk % MK_DUP_ATT) != 0;
        const int h = 7 - (u >> 7), qbi = (u >> 1) & 63, pass = u & 1, uid = u >> 1;
        const int b = (qbi * 256) >> logS, q0 = (qbi * 256) & (S - 1);
        const size_t rowbase = (size_t)b * S;
        const float slope2 = __builtin_amdgcn_exp2f(-(float)(h + 1)) * 1.4426950408889634f;
        const int qpos = q0 + wid * QBLK + r32;
        f32x16 o[4];
        {
            const int map = 2 * h + pass;
            int klo = 0, khi = S; float smax;
            { const unsigned* nq = nrm + ((0 * 2 + b) * 16 + map) * 2; const unsigned* nk = nrm + ((1 * 2 + b) * 16 + map) * 2;
              const float qn2 = __uint_as_float(__hip_atomic_load(nq, __ATOMIC_RELAXED, __HIP_MEMORY_SCOPE_AGENT)) + __uint_as_float(__hip_atomic_load(nq + 1, __ATOMIC_RELAXED, __HIP_MEMORY_SCOPE_AGENT));
              const float kn2 = __uint_as_float(__hip_atomic_load(nk, __ATOMIC_RELAXED, __HIP_MEMORY_SCOPE_AGENT)) + __uint_as_float(__hip_atomic_load(nk + 1, __ATOMIC_RELAXED, __HIP_MEMORY_SCOPE_AGENT));
              smax = sqrtf(qn2 * kn2) * 1.02f;
#if MK_WINDOW
              float sown;
              { const bf16* qp = Qb + (rowbase + q0 + wid * QBLK + r32) * 1024 + map * 64 + hi * 32; const bf16* kp = Kb + (rowbase + q0 + wid * QBLK + r32) * 1024 + map * 64 + hi * 32;
                float acc = 0.f, qq = 0.f;
#pragma unroll
                for (int c = 0; c < 4; ++c) { const v4u qa = *(const v4u*)(qp + c * 8), ka = *(const v4u*)(kp + c * 8);
                    acc += bflo(qa.x) * bflo(ka.x) + bfhi(qa.x) * bfhi(ka.x) + bflo(qa.y) * bflo(ka.y) + bfhi(qa.y) * bfhi(ka.y)
                         + bflo(qa.z) * bflo(ka.z) + bfhi(qa.z) * bfhi(ka.z) + bflo(qa.w) * bflo(ka.w) + bfhi(qa.w) * bfhi(ka.w);
                    qq += bflo(qa.x) * bflo(qa.x) + bfhi(qa.x) * bfhi(qa.x) + bflo(qa.y) * bflo(qa.y) + bfhi(qa.y) * bfhi(qa.y)
                        + bflo(qa.z) * bflo(qa.z) + bfhi(qa.z) * bfhi(qa.z) + bflo(qa.w) * bflo(qa.w) + bfhi(qa.w) * bfhi(qa.w); }
                acc = sum_x32(acc); qq = sum_x32(qq);
                acc = fminf(acc, xor_lt32<1>(acc)); acc = fminf(acc, xor_lt32<2>(acc)); acc = fminf(acc, xor_lt32<4>(acc)); acc = fminf(acc, xor_lt32<8>(acc)); acc = fminf(acc, xor_lt32<16>(acc));
                qq = fmaxf(qq, xor_lt32<1>(qq)); qq = fmaxf(qq, xor_lt32<2>(qq)); qq = fmaxf(qq, xor_lt32<4>(qq)); qq = fmaxf(qq, xor_lt32<8>(qq)); qq = fmaxf(qq, xor_lt32<16>(qq));
                float* wmin = (float*)(lds + OFF_UNIT) + 8;
                if (lane == 0) { wmin[wid] = acc; wmin[8 + wid] = qq; }
                __syncthreads();
                sown = fminf(fminf(fminf(wmin[0], wmin[1]), fminf(wmin[2], wmin[3])), fminf(fminf(wmin[4], wmin[5]), fminf(wmin[6], wmin[7])));
                sown = fminf(sown, 0.f) - 0.25f;
                const float qu2 = fmaxf(fmaxf(fmaxf(wmin[8], wmin[9]), fmaxf(wmin[10], wmin[11])), fmaxf(fmaxf(wmin[12], wmin[13]), fmaxf(wmin[14], wmin[15])));
                smax = fminf(smax, sqrtf(qu2 * kn2) * 1.02f);
              }
              const float wf = (smax - sown + 24.f) / slope2;
              const int wi = (wf < (float)S) ? (int)wf + 1 : S;
              klo = max(q0 - wi, 0) & ~127; khi = min((q0 + 256 + wi + 127) & ~127, S);
#endif
            }
            const int NT = (khi - klo) >> 6;
            const bf16* Qw = Qb + (rowbase + q0 + wid * QBLK + r32) * 1024 + map * 64 + hi * 8;
            const bf16* Kh = Kb + (rowbase + klo) * 1024 + map * 64;
            const bf16* Vh = Vb + (rowbase + klo) * 1024 + h * 128;
            attn_pass(Qw, Kh, Vh, NT, (float)(qpos - klo), klo - (q0 + __builtin_amdgcn_readfirstlane(wid) * QBLK), -slope2, smax, o, lds);
        }
        if (dup) continue;
        const int t2 = mk_tid(); const int r32b = t2 & 31, hib = (t2 >> 5) & 1, widb = t2 >> 6;
        if (t2 == 0) s_unit[1] = atomicAdd(arr + 2 * uid, 1u);
        __syncthreads();
        const unsigned first = s_unit[1];
        f32x4* sp = (f32x4*)(uid < 256 ? (float*)(a.ws + WS_XB) + (size_t)uid * 32768 : (float*)(a.ws + WS_BIG + 96 * MiB) + (size_t)(uid - 256) * 32768) + t2;
        if (first == 0u) {
#pragma unroll
            for (int d0 = 0; d0 < 4; ++d0)
#pragma unroll
                for (int q = 0; q < 4; ++q) {
                    const f32x4 w = {o[d0][4 * q], o[d0][4 * q + 1], o[d0][4 * q + 2], o[d0][4 * q + 3]};
                    asm volatile("global_store_dwordx4 %0, %1, off sc1" :: "v"(sp + (d0 * 4 + q) * 512), "v"(w) : "memory");
                }
            asm volatile("s_waitcnt vmcnt(0)" ::: "memory");
            __syncthreads();
            if (t2 == 0) __hip_atomic_store(arr + 2 * uid + 1, 1u, __ATOMIC_RELEASE, __HIP_MEMORY_SCOPE_AGENT);
            continue;
        }
        if (t2 == 0) { unsigned spn = 0; while (__hip_atomic_load(arr + 2 * uid + 1, __ATOMIC_RELAXED, __HIP_MEMORY_SCOPE_AGENT) == 0u) { __builtin_amdgcn_s_sleep(2); if (++spn > (1u << 24)) break; } }
        __syncthreads();
        __builtin_amdgcn_fence(__ATOMIC_ACQUIRE, "agent");
        float ssq[16];
#pragma unroll
        for (int r = 0; r < 16; ++r) ssq[r] = 0.f;
        f32x4 w[16];
#pragma unroll
        for (int i = 0; i < 16; ++i) asm volatile("global_load_dwordx4 %0, %1, off sc1" : "=v"(w[i]) : "v"(sp + i * 512) : "memory");
        asm volatile("s_waitcnt vmcnt(0)" : "+v"(w[0]), "+v"(w[1]), "+v"(w[2]), "+v"(w[3]), "+v"(w[4]), "+v"(w[5]), "+v"(w[6]), "+v"(w[7]),
                                             "+v"(w[8]), "+v"(w[9]), "+v"(w[10]), "+v"(w[11]), "+v"(w[12]), "+v"(w[13]), "+v"(w[14]), "+v"(w[15]) :: "memory");
#pragma unroll
        for (int d0 = 0; d0 < 4; ++d0)
#pragma unroll
            for (int q = 0; q < 4; ++q) {
#pragma unroll
                for (int e = 0; e < 4; ++e) { const int r = 4 * q + e; const float t = w[d0 * 4 + q][e]; const float v = pass ? (t - lam * o[d0][r]) : (o[d0][r] - lam * t);
                    o[d0][r] = v; ssq[r] = fmaf(v, v, ssq[r]); } }
#pragma unroll
        for (int r = 0; r < 16; ++r) {
            float s = ssq[r];
            s += xor_lt32<1>(s); s += xor_lt32<2>(s); s += xor_lt32<4>(s); s += xor_lt32<8>(s); s += xor_lt32<16>(s);
            ssq[r] = __builtin_amdgcn_rsqf(s * (1.0f / 128.0f) + 1e-5f) * (1.0f - lambda_init);
        }
        bf16* Ow = Ob + (rowbase + q0 + widb * QBLK + 4 * hib) * 1024 + h * 128 + r32b;
#pragma unroll
        for (int d0 = 0; d0 < 4; ++d0) { const float gg = subg[d0 * 32 + r32b];
#pragma unroll
            for (int r = 0; r < 16; ++r) Ow[(size_t)crow(r, 0) * 1024 + d0 * 32] = (bf16)f2bf(o[d0][r] * ssq[r] * gg); }
    }
}


#define XB_TMO      128
#define XB_XCNT(j)  (256  + 64 * (j))
#define XB_XSUB(j)  (1280 + 64 * (j))
#define XB_XGEN(j)  (2304 + 64 * (j))
#define XB_TOP      3328
#define XB_TOPGEN   3392
#define XCD_BAR_WORDS 3456
#define XB_SPIN_CAP (1u << 22)
__device__ __forceinline__ unsigned xb_ld(unsigned* p)              { return __hip_atomic_load(p, __ATOMIC_RELAXED, __HIP_MEMORY_SCOPE_AGENT); }
__device__ __forceinline__ unsigned xb_add(unsigned* p, unsigned v) { return __hip_atomic_fetch_add(p, v, __ATOMIC_RELAXED, __HIP_MEMORY_SCOPE_AGENT); }
__device__ __forceinline__ unsigned xb_xcc_id() { return (unsigned)__builtin_amdgcn_s_getreg((3 << 11) | 20) & 0xFu; }
#define XB_SPIN(cond, bar) do { unsigned _sp = 0; while (cond) { __builtin_amdgcn_s_sleep(1); \
    if ((++_sp & 255u) == 0u) { if (xb_ld(&(bar)[XB_TMO])) break; if (_sp > XB_SPIN_CAP) { atomicAdd(&(bar)[XB_TMO], 1u); break; } } } } while (0)
struct XcdBarrier { unsigned* bar; unsigned x; volatile LAS unsigned* st; };
__device__ __forceinline__ XcdBarrier xcd_barrier_post(unsigned* bar, volatile LAS unsigned* st) {
    XcdBarrier b; b.bar = bar; b.x = xb_xcc_id(); b.st = st;
    if (mk_tid() == 0) (void)xb_add(&bar[XB_XCNT(b.x)], 1u);
    return b;
}
__device__ __forceinline__ void xcd_barrier_complete(unsigned* bar, unsigned x, unsigned& nloc, unsigned& nx) {
    const unsigned G = gridDim.x * gridDim.y * gridDim.z;
    unsigned sum, cnt, mine, sp = 0u;
    for (;;) {
        sum = 0u; cnt = 0u; mine = 0u;
#pragma unroll
        for (unsigned j = 0; j < 16; ++j) { const unsigned c = xb_ld(&bar[XB_XCNT(j)]); sum += c; cnt += (c > 0u) ? 1u : 0u; mine = (j == x) ? c : mine; }
        if (sum == G) break;
        __builtin_amdgcn_s_sleep(1);
        if ((++sp & 255u) == 0u) { if (xb_ld(&bar[XB_TMO])) break; if (sp > XB_SPIN_CAP) { atomicAdd(&bar[XB_TMO], 1u); break; } }
    }
    nloc = mine > 0u ? mine : 1u; nx = cnt > 0u ? cnt : 1u;
}
__device__ __forceinline__ void xcd_barrier(const XcdBarrier& b) {
    asm volatile("s_waitcnt vmcnt(0)" ::: "memory");
    __syncthreads();
    if (mk_tid() == 0) {
        unsigned* bar = b.bar;
        __builtin_amdgcn_s_waitcnt(0);
        unsigned nloc = b.st[0], nx = b.st[1];
        if (nloc == 0u) { xcd_barrier_complete(bar, b.x, nloc, nx); b.st[0] = nloc; b.st[1] = nx; }
        const unsigned old = xb_add(&bar[XB_XSUB(b.x)], 1u);
        const unsigned gen = old / nloc;
        if (old + 1u == (gen + 1u) * nloc) {
            __builtin_amdgcn_fence(__ATOMIC_RELEASE, "agent");
            asm volatile("s_waitcnt vmcnt(0)" ::: "memory");
            const unsigned og = xb_add(&bar[XB_TOP], 1u);
            const unsigned tg = og / nx;
            if (og + 1u == (tg + 1u) * nx) xb_add(&bar[XB_TOPGEN], 1u);
            else XB_SPIN(xb_ld(&bar[XB_TOPGEN]) == tg, bar);
            __builtin_amdgcn_fence(__ATOMIC_ACQUIRE, "agent");
            xb_add(&bar[XB_XGEN(b.x)], 1u);
            asm volatile("s_waitcnt vmcnt(0)" ::: "memory");
        } else {
            XB_SPIN(xb_ld(&bar[XB_XGEN(b.x)]) == gen, bar);
            __builtin_amdgcn_fence(__ATOMIC_ACQUIRE, "agent");
            asm volatile("s_waitcnt vmcnt(0)" ::: "memory");
        }
    }
    __syncthreads();
}

constexpr int LDS_BYTES = 147456;
constexpr int N_PHASES = 1 + 2 * (4 * 5 + 1);
#ifndef MK_MASK
#define MK_MASK 0xFFFF
#endif
#define EN(k) ((MK_MASK >> (k)) & 1)

__global__ void __launch_bounds__(NTHREADS, 2) fwd_megakernel(Args args) {
    extern __shared__ __attribute__((aligned(16))) unsigned char lds[];
    cg::grid_group grid = cg::this_grid();
    const int lo = args.ph_lo, hi = args.ph_hi;
    int ph = 0;
#define RUN() (ph >= lo && ph < hi)
#if MK_PROBE
    unsigned long long t_last = __builtin_amdgcn_s_memrealtime(), t_a = 0, t_b = 0;
#define SEAMK(k) do { if (ph >= lo && ph + 1 < hi) grid.sync(); ++ph; { const unsigned long long t_now = __builtin_amdgcn_s_memrealtime(); \
        if ((MK_PROBE_A >> (k)) & 1) t_a += t_now - t_last; if ((MK_PROBE_B >> (k)) & 1) t_b += t_now - t_last; t_last = t_now; } } while (0)
#else
#define SEAMK(k) do { if (ph >= lo && ph + 1 < hi) { if (ph == 0) { grid.sync(); xbar = xcd_barrier_post((unsigned*)(ws + WS_CTL) + CW_BAR, xst); } else xcd_barrier(xbar); } ++ph; } while (0)
#endif
#define SEAM() SEAMK(0)
    unsigned char* ws = args.ws;
    volatile LAS unsigned* xst = (volatile LAS unsigned*)((LAS unsigned char*)lds + 131072 + 256);
    if (mk_tid() == 0) { xst[0] = 0u; xst[1] = 0u; }
    __syncthreads();
    XcdBarrier xbar; xbar.bar = (unsigned*)(ws + WS_CTL) + CW_BAR; xbar.x = 0; xbar.st = xst;
    PG8_LAS unsigned char* glds = (PG8_LAS unsigned char*)lds;
    const int G = gridDim.x, c = blockIdx.x;

    if (EN(0) && RUN()) { _Pragma("unroll 1") for (int rep = 0; rep < 1 + (MK_DUP_MISC & 1); ++rep) { phase_prologue(args, (LAS unsigned char*)lds); __syncthreads(); }
                          phase_prep(args, 0); }
    SEAMK(1);
#pragma unroll 1
    for (int g = 0; g < 2; ++g) {
        float* xg = args.out + (size_t)g * MG * D; bf16* XB = (bf16*)(ws + WS_XB);
        float* rsq_base = (float*)(ws + WS_ROWSQ);
#pragma unroll 1
        for (int i = 0; i < DEPTH; ++i) {
            const int j = i >> 1;
            float* rsq_n1 = rsq_base + (size_t)(2 * i) * MG * 16; float* rsq_n2 = rsq_base + (size_t)(2 * i + 1) * MG * 16; float* rsq_nx = rsq_base + (size_t)(2 * i + 2) * MG * 16;
            if ((i & 1) == 0) {
                if (EN(2) && RUN()) {
                    pg8::Gemm gm{XB, (const bf16*)(ws + WS_WMI) + (size_t)j * 2048 * D, MG, 2048, D}; pg8::StaticOrder S; S.init(MG, 2048, G, c);
                    pg8::EpiProj<0> E{(bf16*)(ws + WS_BIG), 2048, rsq_n1, 0, 1.f, nullptr, 0};
                    _Pragma("unroll 1") for (int rep = 0; rep < MK_DUP; ++rep) pg8::gemm_phase<pg8::EpiProj<0>, pg8::StaticOrder, true, true>(glds, gm, S, E);
                }
                SEAMK(3);
                if (EN(3) && RUN()) { _Pragma("unroll 1") for (int rep = 0; rep < 1 + ((MK_DUP_MISC >> 2) & 1); ++rep) phase_stencil(args, g, j); }
                SEAMK(4);
                if (EN(4) && RUN()) {
                    pg8::Gemm gm{(const bf16*)(ws + WS_BIG + 64 * MiB), (const bf16*)(ws + WS_WMO) + (size_t)j * D * D, MG, D, D}; pg8::StaticOrder S; S.init(MG, D, G, c);
                    pg8::EpiRes E{xg, XB, rsq_n2, 0};
                    if (MK_DUP_RES == 1) { pg8::EpiNull E0; pg8::gemm_phase<pg8::EpiNull, pg8::StaticOrder, true, true>(glds, gm, S, E0); }
                    if (MK_DUP_RES == 2) { pg8::EpiRes E0 = E; E0.dry = 1; pg8::gemm_phase<pg8::EpiRes, pg8::StaticOrder, true, true>(glds, gm, S, E0); }
                    pg8::gemm_phase<pg8::EpiRes, pg8::StaticOrder, true, true>(glds, gm, S, E);
                }
                SEAMK(5);
            } else {
                if (EN(5) && RUN()) {
                    pg8::Gemm gm{XB, (const bf16*)(ws + WS_WQKV) + (size_t)j * 3072 * D, MG, 3072, D}; pg8::StaticOrder S; S.init(MG, 3072, G, c);
                    pg8::EpiProj<1> E{(bf16*)(ws + WS_BIG), 1024, rsq_n1, (size_t)MG * 1024, QSCALE, (unsigned*)(ws + WS_CTL) + CW_NRM + 256 * (g * 2 + j), g ? 14 : 13};
                    _Pragma("unroll 1") for (int rep = 0; rep < MK_DUP; ++rep) pg8::gemm_phase<pg8::EpiProj<1>, pg8::StaticOrder, true, true>(glds, gm, S, E);
                }
                SEAMK(6);
                if (EN(6) && RUN()) phase_attention(args, g, i, (char*)lds);
                SEAMK(7);
                if (EN(7) && RUN()) {
                    pg8::Gemm gm{(const bf16*)(ws + WS_BIG), (const bf16*)(ws + WS_WAO) + (size_t)j * D * D, MG, D, D}; pg8::StaticOrder S; S.init(MG, D, G, c);
                    pg8::EpiRes E{xg, XB, rsq_n2, 0};
                    if (MK_DUP_RES == 1) { pg8::EpiNull E0; pg8::gemm_phase<pg8::EpiNull, pg8::StaticOrder, true, true>(glds, gm, S, E0); }
                    if (MK_DUP_RES == 2) { pg8::EpiRes E0 = E; E0.dry = 1; pg8::gemm_phase<pg8::EpiRes, pg8::StaticOrder, true, true>(glds, gm, S, E0); }
                    pg8::gemm_phase<pg8::EpiRes, pg8::StaticOrder, true, true>(glds, gm, S, E);
                }
                SEAMK(8);
            }
            if (EN(8) && RUN()) {
                pg8::Gemm gm{XB, (const bf16*)(ws + WS_W1) + (size_t)i * FF * D, MG, FF, D}; pg8::StaticOrder S; S.init(MG, FF, G, c);
                pg8::EpiProj<2> E{(bf16*)(ws + WS_BIG), FF, rsq_n2, 0, 1.f, nullptr, 0};
                _Pragma("unroll 1") for (int rep = 0; rep < MK_DUP; ++rep) pg8::gemm_phase<pg8::EpiProj<2>, pg8::StaticOrder, true, true>(glds, gm, S, E);
            }
            SEAMK(9);
            if (EN(9) && RUN()) {
                pg8::Gemm gm{(const bf16*)(ws + WS_BIG), (const bf16*)(ws + WS_W2) + (size_t)i * D * FF, MG, D, FF}; pg8::StaticOrder S; S.init(MG, D, G, c);
                pg8::EpiRes E{xg, XB, rsq_nx, 0};
                if (MK_DUP_RES == 1) { pg8::EpiNull E0; pg8::gemm_phase<pg8::EpiNull, pg8::StaticOrder, true, true>(glds, gm, S, E0); }
                    if (MK_DUP_RES == 2) { pg8::EpiRes E0 = E; E0.dry = 1; pg8::gemm_phase<pg8::EpiRes, pg8::StaticOrder, true, true>(glds, gm, S, E0); }
                    pg8::gemm_phase<pg8::EpiRes, pg8::StaticOrder, true, true>(glds, gm, S, E);
            }
            SEAMK(10);
        }
        if (EN(10) && RUN()) { phase_final(args, g); if (g == 0) phase_prep(args, 1); }
        SEAMK(11);
    }
#if MK_PROBE
    if (blockIdx.x == 0 && (mk_tid() >> 6) == 0) {
        const float da = (float)t_a * 1e-5f / 1.5f, db = (float)t_b * 1e-5f;
        for (int g = 0; g < 2; ++g) { float* r0 = args.out + (size_t)g * MG * D; const int lane = mk_tid() & 63;
            for (int q = 0; q < 16; ++q) r0[q * 64 + lane] += da;
            if (lane == 0) r0[(size_t)2048 * D] += db; }
    }
#endif
#undef RUN
#undef SEAM
}

extern "C" void kernel_launch(void* const* d_in, const int* in_sizes, int n_in, void* d_out, int out_size, void* d_ws, size_t ws_size, hipStream_t stream) {
    static int grid = 0;
    if (grid == 0) {
        if (n_in != 19 || in_sizes[0] != MG * D || in_sizes[1] != MG * D || out_size != MTOT * D || ws_size < WS_END) {
            fprintf(stderr, "kernel_launch: unexpected shapes: n_in %d in0 %d in1 %d out %d ws %zu (need %zu); nothing launched\n", n_in, n_in > 0 ? in_sizes[0] : -1, n_in > 1 ? in_sizes[1] : -1, out_size, ws_size, (size_t)WS_END);
            grid = -1; return; }
        int dev = 0, cus = 0, per_cu = 0;
        hipGetDevice(&dev);
        hipDeviceGetAttribute(&cus, hipDeviceAttributeMultiprocessorCount, dev);
        if (hipFuncSetAttribute((const void*)fwd_megakernel, hipFuncAttributeMaxDynamicSharedMemorySize, LDS_BYTES) != hipSuccess) { fprintf(stderr, "kernel_launch: hipFuncSetAttribute failed\n"); grid = -1; return; }
        if (hipOccupancyMaxActiveBlocksPerMultiprocessor(&per_cu, (const void*)fwd_megakernel, NTHREADS, LDS_BYTES) != hipSuccess || per_cu < 1) { fprintf(stderr, "kernel_launch: occupancy query failed (%d)\n", per_cu); per_cu = 1; }
        (void)hipGetLastError();
        grid = cus * per_cu;
        if (grid > 256) grid = 256;
    }
    if (grid < 0) return;
    Args a{};
    for (int i = 0; i < 19; ++i) a.in[i] = (const float*)d_in[i];
    a.out = (float*)d_out; a.ws = (unsigned char*)d_ws;
#if MK_PER_PHASE
    for (int p = 0; p < N_PHASES; ++p) {
        a.ph_lo = p; a.ph_hi = p + 1;
        void* kargs[] = {&a};
        hipError_t e = hipLaunchCooperativeKernel((const void*)fwd_megakernel, dim3(grid), dim3(NTHREADS), kargs, LDS_BYTES, stream);
        if (e != hipSuccess) { fprintf(stderr, "kernel_launch: cooperative launch %d failed: %s\n", p, hipGetErrorString(e)); break; }
    }
#else
    a.ph_lo = 0; a.ph_hi = N_PHASES;
    void* kargs[] = {&a};
    hipError_t e = hipLaunchCooperativeKernel((const void*)fwd_megakernel, dim3(grid), dim3(NTHREADS), kargs, LDS_BYTES, stream);
    if (e != hipSuccess) fprintf(stderr, "kernel_launch: cooperative launch failed: %s (grid %d)\n", hipGetErrorString(e), grid);
#endif
}
```

```cpp
#include <hip/hip_runtime.h>
#include <hip/hip_cooperative_groups.h>
#include <cstdio>
#include <cstdint>
namespace cg = cooperative_groups;

#ifndef MK_WINDOW
#define MK_WINDOW 1
#endif
#ifndef MK_PROBE
#define MK_PROBE 0
#endif
#ifndef MK_PROBE_A
#define MK_PROBE_A (1 << 7)
#endif
#ifndef MK_PROBE_B
#define MK_PROBE_B ((1 << 3) | (1 << 5) | (1 << 6) | (1 << 8) | (1 << 9) | (1 << 10))
#endif
#ifndef MK_DUP
#define MK_DUP 1
#endif
#ifndef MK_DUP_ATT
#define MK_DUP_ATT 1
#endif
#ifndef MK_DUP_MISC
#define MK_DUP_MISC 0
#endif
#ifndef MK_DUP_RES
#define MK_DUP_RES 0
#endif
#ifndef MK_PER_PHASE
#define MK_PER_PHASE 0
#endif

__device__ __forceinline__ int mk_tid() { int t = threadIdx.x; asm volatile("" : "+v"(t)); return t; }

template <int M> __device__ __forceinline__ float xor_lt32(float v) { return __int_as_float(__builtin_amdgcn_ds_swizzle(__float_as_int(v), (M << 10) | 0x1f)); }
__device__ __forceinline__ float sum_x32(float v) { auto rr = __builtin_amdgcn_permlane32_swap(__float_as_uint(v), __float_as_uint(v), false, false); return __uint_as_float(rr[0]) + __uint_as_float(rr[1]); }

namespace pg8 {
#define PG8_LAS __attribute__((address_space(3)))
typedef unsigned short bf16_t;
typedef short bf16x8 __attribute__((ext_vector_type(8)));
typedef float f32x4 __attribute__((ext_vector_type(4)));
typedef unsigned u32x4 __attribute__((ext_vector_type(4)));
constexpr int BM = 256, BK = 64, HALF = 128, HTB = HALF * BK * 2  , STAGE_BYTES = 8 * HTB, NXCD = 8, WGM = 8;

__host__ __device__ __forceinline__ int lds_byte(int r, int c) { const int st = (r >> 4) * 2 + (c >> 5), rr = r & 15, cc = c & 31, ob = rr * 64 + cc * 2; return st * 1024 + (ob ^ (((ob >> 9) & 1) << 5)); }
__host__ __device__ __forceinline__ void stage_rc(int b, int& R, int& C) { const int st = b / 1024, sb = b % 1024, swz = sb ^ (((sb >> 9) & 1) << 5); R = (st >> 1) * 16 + swz / 64; C = (st & 1) * 32 + (swz % 64) / 2; }
__host__ __device__ __forceinline__ int perm32(int rho) { const int n = rho >> 4, i = rho & 15; return 8 * (i >> 2) + 4 * n + (i & 3); }

struct Unit { int pm, pn; };
struct Gemm { const bf16_t* A; const bf16_t* Bt; int M, N, K; };

struct StaticOrder {
    int nM, nN, nwg, G, c;
    __host__ __device__ void init(int M, int N, int G_, int c_) { nM = M / BM; nN = N / BM; nwg = nM * nN; G = G_; c = c_; }
    __host__ __device__ bool next(int i, Unit& u) const {
        const long L = (long)i * G + c; if (L >= nwg) return false;
        int wgid = (int)L; { const int q = nwg / NXCD, r = nwg % NXCD, xcd = wgid % NXCD, off = wgid / NXCD; wgid = (xcd < r ? xcd * (q + 1) : r * (q + 1) + (xcd - r) * q) + off; }
        const int nig = WGM * nN, gid = wgid / nig, fm = gid * WGM, gsz = (nM - fm) < WGM ? (nM - fm) : WGM;
        u.pm = fm + ((wgid % nig) % gsz); u.pn = (wgid % nig) / gsz; return true;
    }
    __device__ __forceinline__ void a_ready(const Unit&) const {}
    __device__ __forceinline__ void done(const Unit&) const {}
};

__device__ __forceinline__ unsigned cvt_pk_bf16(float lo, float hi) { unsigned r; asm volatile("v_cvt_pk_bf16_f32 %0, %1, %2" : "=v"(r) : "v"(lo), "v"(hi)); return r; }
typedef float f32x2 __attribute__((ext_vector_type(2)));
template <int MODE> struct EpiProj {
    static constexpr bool PERM = true, AFTER_DRAIN = false;
    bf16_t* O; int ldc; const float* rowsq; size_t split_stride; float scale0; unsigned* nrm; int logS; PG8_LAS float* rl;
    __device__ __forceinline__ void operator()(const f32x4 (&acc)[2][2][4][2], const Unit& u, int wr, int wc, int fr, int fq) const {
        const int row0 = u.pm * BM + wr * 64 + fr; int colt = u.pn * BM; bf16_t* base = O; float sc = 1.f; int t = 0;
        if (MODE == 1) { t = colt >> 10; base += (size_t)t * split_stride; colt &= 1023; if (t == 0) sc = scale0; }
        const int col0 = colt + wc * 32 + 8 * fq;
        float nmx[2] = {0.f, 0.f};
        { const int t = (wr * 4 + wc) * 64 + fq * 16 + fr;
          const f32x4* rp = (const f32x4*)(rowsq + (size_t)(u.pm * BM + (t >> 1)) * 16) + (t & 1) * 2; const f32x4 a0 = rp[0], a1 = rp[1];
          float s = ((a0[0] + a0[1]) + (a0[2] + a0[3])) + ((a1[0] + a1[1]) + (a1[2] + a1[3]));
          s += xor_lt32<1>(s);
          if ((t & 1) == 0) rl[t >> 1] = __builtin_amdgcn_rsqf(s * (1.0f / 1024.0f) + 1e-6f);
          asm volatile("s_waitcnt lgkmcnt(0)" ::: "memory"); __builtin_amdgcn_s_barrier(); asm volatile("" ::: "memory"); }
#pragma unroll
        for (int ai = 0; ai < 2; ++ai)
#pragma unroll
            for (int m = 0; m < 4; ++m) {
                const int row = row0 + ai * HALF + m * 16;
                const float rs = rl[wr * 64 + fr + ai * HALF + m * 16] * sc;
                bf16_t* rowp = base + (size_t)row * ldc + col0;
#pragma unroll
                for (int bj = 0; bj < 2; ++bj) {
                    f32x4 v0 = acc[ai][bj][m][0] * rs, v1 = acc[ai][bj][m][1] * rs;
                    if (MODE == 2) {
#pragma unroll
                        for (int e = 0; e < 4; ++e) { const float a = fmaxf(v0[e], 0.f), b = fmaxf(v1[e], 0.f); v0[e] = a * a; v1[e] = b * b; }
                    }
                    if (MODE == 1) {
                        float s = (v0[0] * v0[0] + v0[1] * v0[1]) + (v0[2] * v0[2] + v0[3] * v0[3]) + (v1[0] * v1[0] + v1[1] * v1[1]) + (v1[2] * v1[2] + v1[3] * v1[3]);
                        s += xor_lt32<16>(s); s = sum_x32(s);
                        nmx[bj] = fmaxf(nmx[bj], s);
                    }
                    u32x4 w; w.x = cvt_pk_bf16(v0[0], v0[1]); w.y = cvt_pk_bf16(v0[2], v0[3]); w.z = cvt_pk_bf16(v1[0], v1[1]); w.w = cvt_pk_bf16(v1[2], v1[3]);
                    *(u32x4*)(rowp + bj * HALF) = w;
                }
            }
        if (MODE == 1) {
            if (t < 2) {
                const int b = (u.pm * BM) >> logS;
#pragma unroll
                for (int bj = 0; bj < 2; ++bj) {
                    float v = nmx[bj];
                    v = fmaxf(v, xor_lt32<1>(v)); v = fmaxf(v, xor_lt32<2>(v)); v = fmaxf(v, xor_lt32<4>(v)); v = fmaxf(v, xor_lt32<8>(v));
                    const int map = (colt >> 6) + 2 * bj + (wc >> 1), half = wc & 1;
                    if (fr == 0 && fq == 0) atomicMax(nrm + (((t * 2 + b) * 16 + map) * 2 + half), __float_as_uint(v));
                }
            }
        }
    }
};
struct EpiRes {
    static constexpr bool PERM = false, AFTER_DRAIN = false;
    float* x; bf16_t* xb; float* rowsq; int dry;
    __device__ __forceinline__ void operator()(const f32x4 (&acc)[2][2][4][2], const Unit& u, int wr, int wc, int fr, int fq) const {
        typedef unsigned u32x2v __attribute__((ext_vector_type(2)));
        const int col0 = u.pn * BM + wc * 32 + 4 * fq;
#pragma unroll
        for (int ai = 0; ai < 2; ++ai)
#pragma unroll
            for (int m = 0; m < 4; ++m) {
                const int row = u.pm * BM + ai * HALF + wr * 64 + m * 16 + fr; const size_t off = (size_t)row * 1024 + col0;
                float ss = 0.f;
#pragma unroll
                for (int bj = 0; bj < 2; ++bj)
#pragma unroll
                    for (int n = 0; n < 2; ++n) {
                        const f32x4 xo = *(const f32x4*)(x + off + bj * HALF + n * 16);
                        const f32x4 xn = xo + acc[ai][bj][m][n];
                        *(f32x4*)(x + off + bj * HALF + n * 16) = dry ? xo : xn;
                        ss += (xn[0] * xn[0] + xn[1] * xn[1]) + (xn[2] * xn[2] + xn[3] * xn[3]);
                        u32x2v w; w.x = cvt_pk_bf16(xn[0], xn[1]); w.y = cvt_pk_bf16(xn[2], xn[3]);
                        *(u32x2v*)(xb + off + bj * HALF + n * 16) = w;
                    }
                ss += xor_lt32<16>(ss); ss = sum_x32(ss);
                if (fq == 0) rowsq[(size_t)row * 16 + u.pn * 4 + wc] = ss;
            }
    }
};

struct EpiNull {
    static constexpr bool PERM = false, AFTER_DRAIN = false;
    __device__ __forceinline__ void operator()(const f32x4 (&acc)[2][2][4][2], const Unit& u, int wr, int wc, int fr, int fq) const {
#pragma unroll
        for (int ai = 0; ai < 2; ++ai)
#pragma unroll
            for (int bj = 0; bj < 2; ++bj)
#pragma unroll
                for (int m = 0; m < 4; ++m)
#pragma unroll
                    for (int n = 0; n < 2; ++n) asm volatile("" :: "v"(acc[ai][bj][m][n]));
    }
};

template <class Epi, class Sched, bool ALIGN_EPI = false, bool SP2 = false>
__device__ __forceinline__ void gemm_phase(PG8_LAS unsigned char* lds, const Gemm g, const Sched& S, const Epi& E) {
    const int tid = mk_tid(), wid = __builtin_amdgcn_readfirstlane(tid >> 6), lane = tid & 63, wr = wid >> 2, wc = wid & 3, fr = lane & 15, fq = lane >> 4;
    const int K = g.K, nt = K / BK;
    unsigned voffA[2], voffB[2];
#pragma unroll
    for (int i = 0; i < 2; ++i) { int R, C; stage_rc(tid * 16 + i * 8192, R, C); const int Rb = Epi::PERM ? ((R & ~31) + perm32(R & 31)) : R;
        voffA[i] = (unsigned)(R * K + C) * 2u; voffB[i] = (unsigned)(Rb * K + C) * 2u; }
    const size_t kstep = (size_t)(BK * 2);
    const size_t hstep = (size_t)HALF * K * 2;
    const size_t tstep = 2 * hstep;
    const unsigned ldsw = (unsigned)wid * 1024u;
    const int aoff = lds_byte(wr * 64 + fr, fq * 8), boff = lds_byte(wc * 32 + fr, fq * 8);
#define PG8_SA(b, h) (((b) * 2 + (h)) * HTB)
#define PG8_SB(b, h) ((4 + (b) * 2 + (h)) * HTB)
#define PG8_STAGE(bufoff, gbase, voff) do { _Pragma("unroll") for (int _i = 0; _i < 2; ++_i) \
        __builtin_amdgcn_global_load_lds((const unsigned*)((const char*)(gbase) + (voff)[_i]), (PG8_LAS unsigned*)(lds + (bufoff) + ldsw + _i * 8192), 16, 0, 0); } while (0)
#define PG8_LDA(dst, b, h) do { _Pragma("unroll") for (int m = 0; m < 4; ++m) _Pragma("unroll") for (int k = 0; k < 2; ++k) dst[m][k] = *(const PG8_LAS bf16x8*)(lds + PG8_SA(b, h) + aoff + m * 2048 + k * 1024); } while (0)
#define PG8_LDB(dst, b, h) do { _Pragma("unroll") for (int n = 0; n < 2; ++n) _Pragma("unroll") for (int k = 0; k < 2; ++k) dst[n][k] = *(const PG8_LAS bf16x8*)(lds + PG8_SB(b, h) + boff + n * 2048 + k * 1024); } while (0)
#define PG8_MMA(ai, bj, At, Bt) do { __builtin_amdgcn_s_setprio(1); _Pragma("unroll") for (int m = 0; m < 4; ++m) _Pragma("unroll") for (int n = 0; n < 2; ++n) _Pragma("unroll") for (int k = 0; k < 2; ++k) \
        acc[ai][bj][m][n] = __builtin_amdgcn_mfma_f32_16x16x32_bf16(Bt[n][k], At[m][k], acc[ai][bj][m][n], 0, 0, 0); __builtin_amdgcn_s_setprio(0); } while (0)
#define PG8_WAIT_V(n) asm volatile("s_waitcnt vmcnt(" #n ")" ::: "memory")
#define PG8_WAIT_L(n) asm volatile("s_waitcnt lgkmcnt(" #n ")" ::: "memory")
#define PG8_BAR __builtin_amdgcn_s_barrier()
#define PG8_SCHED __builtin_amdgcn_sched_barrier(0)
    Unit cur, nxt; int ui = 0;
    if (!S.next(0, cur)) return;
    f32x4 acc[2][2][4][2];
#pragma unroll
    for (int a = 0; a < 2; ++a)
#pragma unroll
        for (int b = 0; b < 2; ++b)
#pragma unroll
            for (int m = 0; m < 4; ++m)
#pragma unroll
                for (int n = 0; n < 2; ++n) acc[a][b][m][n] = (f32x4){0.f, 0.f, 0.f, 0.f};
    bf16x8 At[4][2], B0[2][2], B1[2][2];
    const char* cA = (const char*)g.A + (size_t)cur.pm * tstep; const char* cB = (const char*)g.Bt + (size_t)cur.pn * tstep;
    S.a_ready(cur);
    if constexpr (SP2) {
        PG8_STAGE(PG8_SB(0, 0), cB, voffB); PG8_STAGE(PG8_SB(0, 1), cB + hstep, voffB); PG8_STAGE(PG8_SA(0, 0), cA, voffA); PG8_STAGE(PG8_SA(0, 1), cA + hstep, voffA);
        if (wr == 1) PG8_BAR;
        PG8_WAIT_V(2); PG8_BAR;
        PG8_STAGE(PG8_SB(1, 0), cB + kstep, voffB); PG8_STAGE(PG8_SA(1, 0), cA + kstep, voffA); PG8_STAGE(PG8_SB(1, 1), cB + hstep + kstep, voffB);
        PG8_WAIT_V(6); PG8_BAR;
    } else {
        PG8_STAGE(PG8_SB(0, 0), cB, voffB); PG8_STAGE(PG8_SA(0, 0), cA, voffA); PG8_STAGE(PG8_SB(0, 1), cB + hstep, voffB); PG8_STAGE(PG8_SA(0, 1), cA + hstep, voffA);
        if (wr == 1) PG8_BAR;
        PG8_WAIT_V(4); PG8_BAR;
        PG8_STAGE(PG8_SB(1, 0), cB + kstep, voffB); PG8_STAGE(PG8_SA(1, 0), cA + kstep, voffA); PG8_STAGE(PG8_SB(1, 1), cB + hstep + kstep, voffB);
        PG8_WAIT_V(6); PG8_BAR;
    }
    for (;;) {
        const bool has_next = S.next(ui + 1, nxt);
        const char* nA = has_next ? (const char*)g.A + (size_t)nxt.pm * tstep : cA; const char* nB = has_next ? (const char*)g.Bt + (size_t)nxt.pn * tstep : cB;
        for (int t = 0; t < nt; t += 2) {
            const bool last = (t == nt - 2);
            const char* a1 = cA + (size_t)(t + 1) * kstep;
            const char* a2 = last ? nA : cA + (size_t)(t + 2) * kstep; const char* b2 = last ? nB : cB + (size_t)(t + 2) * kstep;
            const char* a3 = a2 + kstep; const char* b3 = b2 + kstep;
            if (last && has_next) S.a_ready(nxt);
            if constexpr (SP2) {
            PG8_LDB(B0, 0, 0); PG8_LDB(B1, 0, 1); PG8_SCHED; PG8_LDA(At, 0, 0); PG8_STAGE(PG8_SA(1, 1), a1 + hstep, voffA);
            PG8_WAIT_V(8); PG8_WAIT_L(0); PG8_BAR; PG8_MMA(0, 0, At, B0); PG8_MMA(0, 1, At, B1); PG8_BAR; PG8_SCHED;
            PG8_LDA(At, 0, 1); PG8_STAGE(PG8_SB(0, 0), b2, voffB); PG8_STAGE(PG8_SB(0, 1), b2 + hstep, voffB); PG8_STAGE(PG8_SA(0, 0), a2, voffA);
            PG8_WAIT_V(8); PG8_WAIT_L(0); PG8_BAR; PG8_MMA(1, 0, At, B0); PG8_MMA(1, 1, At, B1); PG8_BAR; PG8_SCHED;
            PG8_LDB(B0, 1, 0); PG8_LDB(B1, 1, 1); PG8_SCHED; PG8_LDA(At, 1, 0); PG8_STAGE(PG8_SA(0, 1), a2 + hstep, voffA);
            PG8_WAIT_V(8); PG8_WAIT_L(0); PG8_BAR; PG8_MMA(0, 0, At, B0); PG8_MMA(0, 1, At, B1); PG8_BAR; PG8_SCHED;
            PG8_LDA(At, 1, 1); PG8_STAGE(PG8_SB(1, 0), b3, voffB); PG8_STAGE(PG8_SB(1, 1), b3 + hstep, voffB); PG8_STAGE(PG8_SA(1, 0), a3, voffA);
            PG8_WAIT_V(8); PG8_WAIT_L(0); PG8_BAR; PG8_MMA(1, 0, At, B0); PG8_MMA(1, 1, At, B1); PG8_BAR; PG8_SCHED;
            } else {
            PG8_LDB(B0, 0, 0); PG8_SCHED; PG8_LDA(At, 0, 0); PG8_STAGE(PG8_SA(1, 1), a1 + hstep, voffA);
            PG8_WAIT_L(8); PG8_BAR; PG8_WAIT_L(0); PG8_MMA(0, 0, At, B0); PG8_BAR; PG8_SCHED;
            PG8_LDB(B1, 0, 1); PG8_STAGE(PG8_SB(0, 0), b2, voffB);
            PG8_BAR; PG8_WAIT_L(0); PG8_MMA(0, 1, At, B1); PG8_BAR;
            PG8_LDA(At, 0, 1); PG8_STAGE(PG8_SA(0, 0), a2, voffA);
            PG8_BAR; PG8_WAIT_L(0); PG8_MMA(1, 0, At, B0); PG8_BAR; PG8_SCHED;
            PG8_STAGE(PG8_SB(0, 1), b2 + hstep, voffB);
            PG8_WAIT_V(6); PG8_BAR; PG8_MMA(1, 1, At, B1); PG8_BAR;
            PG8_LDB(B0, 1, 0); PG8_SCHED; PG8_LDA(At, 1, 0); PG8_STAGE(PG8_SA(0, 1), a2 + hstep, voffA);
            PG8_WAIT_L(8); PG8_BAR; PG8_WAIT_L(0); PG8_MMA(0, 0, At, B0); PG8_BAR; PG8_SCHED;
            PG8_LDB(B1, 1, 1); PG8_STAGE(PG8_SB(1, 0), b3, voffB);
            PG8_BAR; PG8_WAIT_L(0); PG8_MMA(0, 1, At, B1); PG8_BAR;
            PG8_LDA(At, 1, 1); PG8_STAGE(PG8_SA(1, 0), a3, voffA);
            PG8_BAR; PG8_WAIT_L(0); PG8_MMA(1, 0, At, B0); PG8_BAR; PG8_SCHED;
            PG8_STAGE(PG8_SB(1, 1), b3 + hstep, voffB);
            PG8_WAIT_V(6); PG8_BAR; PG8_MMA(1, 1, At, B1); PG8_BAR;
            }
        }
        if constexpr (ALIGN_EPI) { if (wr == 0) PG8_BAR; }
        if constexpr (!Epi::AFTER_DRAIN) { E(acc, cur, wr, wc, fr, fq); S.done(cur); }
        if (!has_next) break;
#pragma unroll
        for (int a = 0; a < 2; ++a)
#pragma unroll
            for (int b = 0; b < 2; ++b)
#pragma unroll
                for (int m = 0; m < 4; ++m)
#pragma unroll
                    for (int n = 0; n < 2; ++n) acc[a][b][m][n] = (f32x4){0.f, 0.f, 0.f, 0.f};
        cur = nxt; cA = nA; cB = nB; ++ui;
        if constexpr (ALIGN_EPI) { if (wr == 1) PG8_BAR; }
    }
    PG8_WAIT_V(0);
    if constexpr (!ALIGN_EPI) { if (wr == 0) PG8_BAR; }
    PG8_BAR;
    if constexpr (Epi::AFTER_DRAIN) { E.fused(acc, cur, wr, wc, fr, fq, lds, wid, lane); S.done(cur); }
#undef PG8_SA
#undef PG8_SB
#undef PG8_STAGE
#undef PG8_LDA
#undef PG8_LDB
#undef PG8_MMA
#undef PG8_WAIT_V
#undef PG8_WAIT_L
#undef PG8_BAR
#undef PG8_SCHED
}
}

namespace att {
typedef unsigned short bf16_t;
using bf16x8 = __attribute__((ext_vector_type(8))) short;
using s16x4  = __attribute__((ext_vector_type(4))) short;
using f32x16 = __attribute__((ext_vector_type(16))) float;
using u32x4  = __attribute__((ext_vector_type(4))) unsigned;
constexpr int NW = 8, QBLK = 32, KVBLK = 64, LD = 1024;
constexpr int SHM_V = KVBLK * 128 * 2, SHM_K = KVBLK * 64 * 2;
constexpr int OFF_V = 0, OFF_K = 2 * SHM_V, OFF_WS = OFF_K + 2 * SHM_K, OFF_UNIT = OFF_WS + NW * 64 * 4, LDS_BYTES = OFF_UNIT + 128;
constexpr int SDEPTH = 1;
constexpr float THR2 = 16.f;
#define KSWZ(row, colB) ((row) * 128 + ((colB) ^ ((((row) >> 1) & 7) << 4)))
#define SBAR() __builtin_amdgcn_sched_barrier(0)
#define SGB_MFMA_VALU(N, V) do { _Pragma("unroll") for (int _g = 0; _g < (N); ++_g) { __builtin_amdgcn_sched_group_barrier(0x008, 1, 0); __builtin_amdgcn_sched_group_barrier(0x400, (V), 0); } } while (0)
__device__ __forceinline__ int crow(int r, int hi) { return (r & 3) + 8 * (r >> 2) + 4 * hi; }
__device__ __forceinline__ unsigned cvtpk(float lo, float hi) { unsigned r; asm volatile("v_cvt_pk_bf16_f32 %0, %1, %2" : "=v"(r) : "v"(lo), "v"(hi)); return r; }

__device__ __forceinline__ void split3(float a, unsigned& h, unsigned& l, unsigned& ll) {
  h = cvtpk(a, 0.f) & 0xffffu; const float r1 = a - __uint_as_float(h << 16);
  l = cvtpk(r1, 0.f) & 0xffffu; const float r2 = r1 - __uint_as_float(l << 16);
  ll = cvtpk(r2, 0.f) & 0xffffu;
}
__device__ __forceinline__ void tile_ctl(int rel, float dq, float m_reg, float nc2, float smax, int hi, bf16x8& qx, int& mode, bool& skip) {
  mode = (rel <= -64) ? 1 : (rel >= 32) ? 2 : 0;
  const float dmin = (mode == 1) ? (float)(-rel - 63) : (float)(rel - 31);
  skip = (mode != 0) && (smax + nc2 * dmin <= THR2);
  const float A = (mode == 1 ? nc2 * dq : -nc2 * dq) - m_reg;
  unsigned ah, al, all_; split3(A, ah, al, all_);
  const unsigned sg = (mode == 1) ? 0x3F80u : 0xBF80u;
  u32x4 w = {ah | (al << 16), all_ | (sg << 16), sg | (sg << 16), 0u};
  if (hi != 0 || mode == 0) w = u32x4{0u, 0u, 0u, 0u};
  qx = *reinterpret_cast<bf16x8*>(&w);
}
__device__ __forceinline__ void partialSM(f32x16& p0, f32x16& p1, float& m_reg, float& alpha, int mode, bool skip, float dqh, float nc2) {
  if (mode == 0) {
    const float dq1 = dqh - 32.f;
#pragma unroll
    for (int r = 0; r < 16; ++r) p0[r] = fmaf(__builtin_fabsf(dqh - (float)((r & 3) + 8 * (r >> 2))), nc2, p0[r]) - m_reg;
#pragma unroll
    for (int r = 0; r < 16; ++r) p1[r] = fmaf(__builtin_fabsf(dq1 - (float)((r & 3) + 8 * (r >> 2))), nc2, p1[r]) - m_reg;
  }
  alpha = 1.f;
  if (!skip) {
    float pmax = p0[0];
#pragma unroll
    for (int r = 1; r < 16; ++r) pmax = fmaxf(pmax, p0[r]);
#pragma unroll
    for (int r = 0; r < 16; ++r) pmax = fmaxf(pmax, p1[r]);
    { auto rr = __builtin_amdgcn_permlane32_swap(__float_as_uint(pmax), __float_as_uint(pmax), false, false);
      pmax = fmaxf(__uint_as_float(rr[0]), __uint_as_float(rr[1])); }
    if (__builtin_expect(!__all(pmax <= THR2), 0)) {
      const float dl = fmaxf(pmax, 0.f); m_reg += dl; alpha = __builtin_amdgcn_exp2f(-dl);
#pragma unroll
      for (int r = 0; r < 16; ++r) p0[r] -= dl;
#pragma unroll
      for (int r = 0; r < 16; ++r) p1[r] -= dl;
    }
  }
}
__device__ __forceinline__ void expP0(f32x16& p0) {
#pragma unroll
  for (int r = 0; r < 16; ++r) p0[r] = __builtin_amdgcn_exp2f(p0[r]);
}
__device__ __forceinline__ void finishSM(f32x16& p0, f32x16& p1, float alpha, float& l_reg, bf16x8& pa0, bf16x8& pa1, bf16x8& pa2, bf16x8& pa3) {
#pragma unroll
  for (int r = 0; r < 16; ++r) p1[r] = __builtin_amdgcn_exp2f(p1[r]);
  float ps = 0;
#pragma unroll
  for (int r = 0; r < 16; ++r) ps += p0[r];
#pragma unroll
  for (int r = 0; r < 16; ++r) ps += p1[r];
  { auto rr = __builtin_amdgcn_permlane32_swap(__float_as_uint(ps), __float_as_uint(ps), false, false);
    ps = __uint_as_float(rr[0]) + __uint_as_float(rr[1]); }
  l_reg = l_reg * alpha + ps;
#define PK4(P, BASE, OUT) do { unsigned a0 = cvtpk(P[BASE + 0], P[BASE + 1]), a1 = cvtpk(P[BASE + 2], P[BASE + 3]);   \
    unsigned b0 = cvtpk(P[BASE + 4], P[BASE + 5]), b1 = cvtpk(P[BASE + 6], P[BASE + 7]);                              \
    auto r0 = __builtin_amdgcn_permlane32_swap(a0, b0, false, false); auto r1 = __builtin_amdgcn_permlane32_swap(a1, b1, false, false); \
    u32x4 w = {r0[0], r1[0], r0[1], r1[1]}; OUT = *reinterpret_cast<bf16x8*>(&w); } while (0)
  PK4(p0, 0, pa0); PK4(p0, 8, pa1); PK4(p1, 0, pa2); PK4(p1, 8, pa3);
#undef PK4
}
__device__ __forceinline__ void qkt(f32x16& p0, f32x16& p1, const char* Ks, const bf16x8* qr, int r32, int hi, bf16x8 kx0, bf16x8 kx1, bf16x8 qx) {
  p0 = __builtin_amdgcn_mfma_f32_32x32x16_bf16(kx0, qx, f32x16{}, 0, 0, 0); p1 = __builtin_amdgcn_mfma_f32_32x32x16_bf16(kx1, qx, f32x16{}, 0, 0, 0);
#pragma unroll
  for (int d0 = 0; d0 < 4; ++d0) { const int cb = d0 * 32 + hi * 16;
    bf16x8 b0 = *reinterpret_cast<const bf16x8*>(Ks + KSWZ(r32, cb));
    bf16x8 b1 = *reinterpret_cast<const bf16x8*>(Ks + KSWZ(32 + r32, cb));
    p0 = __builtin_amdgcn_mfma_f32_32x32x16_bf16(b0, qr[d0], p0, 0, 0, 0);
    p1 = __builtin_amdgcn_mfma_f32_32x32x16_bf16(b1, qr[d0], p1, 0, 0, 0); }
}
__device__ __forceinline__ int v_st(int k, int c) { const int kk = (k & ~0xC) | ((k & 4) << 1) | ((k & 8) >> 1); return ((kk >> 3) * 4 + (c >> 5)) * 512 + ((kk & 7) * 32 + (c & 31)) * 2; }
__device__ __forceinline__ int v_rd_base(int lane) { return ((lane & 3) << 3) | (((lane >> 2) & 3) << 6) | (((lane >> 4) & 1) << 5) | (((lane >> 5) & 1) << 8); }
constexpr int v_rd_off(int d0, int ks, int half) { return d0 * 512 + ks * 4096 + half * 2048; }
template <int OFF> __device__ __forceinline__ s16x4 tr_read(int vb) {
  s16x4 r; asm volatile("ds_read_b64_tr_b16 %0, %1 offset:%2" : "=&v"(r) : "v"(vb), "i"(OFF) : "memory"); return r;
}
#define PV_RD(D0, L, H) do { L[0] = tr_read<v_rd_off(D0, 0, 0)>(vb); H[0] = tr_read<v_rd_off(D0, 0, 1)>(vb); L[1] = tr_read<v_rd_off(D0, 1, 0)>(vb); H[1] = tr_read<v_rd_off(D0, 1, 1)>(vb); \
    L[2] = tr_read<v_rd_off(D0, 2, 0)>(vb); H[2] = tr_read<v_rd_off(D0, 2, 1)>(vb); L[3] = tr_read<v_rd_off(D0, 3, 0)>(vb); H[3] = tr_read<v_rd_off(D0, 3, 1)>(vb); } while (0)
#define PV_RD2(D0, KS, L, H) do { L[KS] = tr_read<v_rd_off(D0, KS, 0)>(vb); H[KS] = tr_read<v_rd_off(D0, KS, 1)>(vb); } while (0)
#define PV_WAIT(N, L, H) asm volatile("s_waitcnt lgkmcnt(" #N ")" : "+v"(L[0]), "+v"(H[0]), "+v"(L[1]), "+v"(H[1]), "+v"(L[2]), "+v"(H[2]), "+v"(L[3]), "+v"(H[3]))
#define PV_PK(L, H, KS) (bf16x8){L[KS][0], L[KS][1], L[KS][2], L[KS][3], H[KS][0], H[KS][1], H[KS][2], H[KS][3]}
#define PV_MF(D0, KS, PA, L, H, R) do { o[D0] = __builtin_amdgcn_mfma_f32_32x32x16_bf16(PA, PV_PK(L, H, KS), o[D0], 0, 0, 0); \
    if (EXPS) { px[R] = __builtin_amdgcn_exp2f(px[R]); asm volatile("" : "+v"(px)); } SBAR(); } while (0)
template <bool EXPS> __device__ __forceinline__ void pv_d0(f32x16* o, int vb, bf16x8 pa0, bf16x8 pa1, bf16x8 pa2, bf16x8 pa3, f32x16& px) {
  s16x4 la[4], ha[4], lb[4], hb[4];
  SBAR(); PV_RD(0, la, ha); SBAR();
  PV_RD2(1, 0, lb, hb); PV_WAIT(2, la, ha);  PV_MF(0, 0, pa0, la, ha, 0);
  PV_RD2(1, 1, lb, hb);                       PV_MF(0, 1, pa1, la, ha, 1);
  PV_RD2(1, 2, lb, hb);                       PV_MF(0, 2, pa2, la, ha, 2);
  PV_RD2(1, 3, lb, hb);                       PV_MF(0, 3, pa3, la, ha, 3);
  PV_RD2(2, 0, la, ha); PV_WAIT(2, lb, hb);  PV_MF(1, 0, pa0, lb, hb, 4);
  PV_RD2(2, 1, la, ha);                       PV_MF(1, 1, pa1, lb, hb, 5);
  PV_RD2(2, 2, la, ha);                       PV_MF(1, 2, pa2, lb, hb, 6);
  PV_RD2(2, 3, la, ha);                       PV_MF(1, 3, pa3, lb, hb, 7);
  PV_RD2(3, 0, lb, hb); PV_WAIT(2, la, ha);  PV_MF(2, 0, pa0, la, ha, 8);
  PV_RD2(3, 1, lb, hb);                       PV_MF(2, 1, pa1, la, ha, 9);
  PV_RD2(3, 2, lb, hb);                       PV_MF(2, 2, pa2, la, ha, 10);
  PV_RD2(3, 3, lb, hb);                       PV_MF(2, 3, pa3, la, ha, 11);
                        PV_WAIT(0, lb, hb);  PV_MF(3, 0, pa0, lb, hb, 12);
                                              PV_MF(3, 1, pa1, lb, hb, 13);
                                              PV_MF(3, 2, pa2, lb, hb, 14);
                                              PV_MF(3, 3, pa3, lb, hb, 15);
}

__device__ __forceinline__ void attn_pass(const bf16_t* __restrict__ Qw, const bf16_t* __restrict__ Kh, const bf16_t* __restrict__ Vh,
                                          int NT, float dqbase, int rel0, float nc2, float smax, f32x16 (&o)[4], char* lds) {
  const int tid = mk_tid(), wid = tid >> 6, lane = tid & 63, r32 = lane & 31, hi = lane >> 5;
  char* V_lds = lds + OFF_V; char* K_lds = lds + OFF_K;
  float* ws = (float*)(lds + OFF_WS) + wid * 64; float* li_l = ws; float* al_l = ws + 32;
  float m_reg = 0.f, l_reg = 0; bf16x8 qr[4];
#pragma unroll
  for (int d = 0; d < 4; ++d) o[d] = f32x16{};
#pragma unroll
  for (int d0 = 0; d0 < 4; ++d0) qr[d0] = *reinterpret_cast<const bf16x8*>(Qw + d0 * 16);
  const float dqh0 = dqbase - (float)(4 * hi);
  bf16x8 kx0, kx1;
  { unsigned bh, bl, bll; u32x4 w;
    split3(-nc2 * (float)r32, bh, bl, bll); w = u32x4{0x3F803F80u, 0x3F80u | (bh << 16), bl | (bll << 16), 0u}; if (hi) w = u32x4{0u, 0u, 0u, 0u}; kx0 = *reinterpret_cast<bf16x8*>(&w);
    split3(-nc2 * (float)(32 + r32), bh, bl, bll); w = u32x4{0x3F803F80u, 0x3F80u | (bh << 16), bl | (bll << 16), 0u}; if (hi) w = u32x4{0u, 0u, 0u, 0u}; kx1 = *reinterpret_cast<bf16x8*>(&w); }
  bf16x8 qx; int mdA, mdB; bool skA, skB;
#define CTL(j, MD, SK) tile_ctl(rel0 + (j) * KVBLK, dqbase - (float)((j) * KVBLK), m_reg, nc2, smax, hi, qx, MD, SK)
  const int sr = tid >> 4, sc = (tid & 15) * 8, vst0 = v_st(sr, sc), vst1 = v_st(32 + sr, sc);
  const int krow = tid >> 3, kcol = (tid & 7) * 8, kst = KSWZ(krow, kcol * 2);
  const int vb0 = (int)(uintptr_t)V_lds + v_rd_base(lane);
  struct { bf16x8 vs0, vs1, ks0; } sr_[SDEPTH];
#define SLOAD(i, k0) do { sr_[i].vs0 = *reinterpret_cast<const bf16x8*>(&Vh[(long)((k0) + sr) * LD + sc]); sr_[i].vs1 = *reinterpret_cast<const bf16x8*>(&Vh[(long)((k0) + 32 + sr) * LD + sc]); \
    sr_[i].ks0 = *reinterpret_cast<const bf16x8*>(&Kh[(long)((k0) + krow) * LD + kcol]); } while (0)
#define SWRITE(b, i) do { *(bf16x8*)(V_lds + (b) * SHM_V + vst0) = sr_[i].vs0; *(bf16x8*)(V_lds + (b) * SHM_V + vst1) = sr_[i].vs1; \
    *(bf16x8*)(K_lds + (b) * SHM_K + kst) = sr_[i].ks0; } while (0)
#define SWAIT() do { if constexpr (SDEPTH == 2) asm volatile("s_waitcnt vmcnt(3)" ::: "memory"); else asm volatile("s_waitcnt vmcnt(0)" ::: "memory"); } while (0)
#define RESC(a) do { if (__any((a) < 1.f)) { if (hi == 0) al_l[r32] = (a); asm volatile("s_waitcnt lgkmcnt(0)" ::: "memory"); \
    _Pragma("unroll") for (int d = 0; d < 4; ++d) _Pragma("unroll") for (int r = 0; r < 16; ++r) o[d][r] *= al_l[crow(r, hi)]; } } while (0)
  f32x16 pA0, pA1, pB0, pB1; float alA, alB; bf16x8 pa0, pa1, pa2, pa3;
  constexpr int SE = 0, SO = SDEPTH - 1;
  __syncthreads();
  SLOAD(SE, 0); asm volatile("s_waitcnt vmcnt(0)" ::: "memory"); SWRITE(0, SE); __syncthreads();
  CTL(0, mdA, skA); qkt(pA0, pA1, K_lds, qr, r32, hi, kx0, kx1, qx); partialSM(pA0, pA1, m_reg, alA, mdA, skA, dqh0, nc2); expP0(pA0);
  SLOAD(SO, KVBLK); if constexpr (SDEPTH == 2) { if (2 < NT) SLOAD(SE, 2 * KVBLK); }
  SWAIT(); SWRITE(1, SO); __syncthreads();
  for (int j = 1; j + 1 < NT; j += 2) {
    SBAR(); CTL(j, mdB, skB); qkt(pB0, pB1, K_lds + SHM_K, qr, r32, hi, kx0, kx1, qx);
    finishSM(pA0, pA1, alA, l_reg, pa0, pa1, pa2, pa3); SBAR();
    SLOAD(SO, (j + SDEPTH) * KVBLK); SBAR();
    partialSM(pB0, pB1, m_reg, alB, mdB, skB, dqh0 - (float)(j * KVBLK), nc2); SBAR();
    pv_d0<true>(o, vb0, pa0, pa1, pa2, pa3, pB0);
    __syncthreads(); SWAIT(); SWRITE(0, SE);
    RESC(alB); __syncthreads();
    SBAR(); CTL(j + 1, mdA, skA); qkt(pA0, pA1, K_lds, qr, r32, hi, kx0, kx1, qx);
    finishSM(pB0, pB1, alB, l_reg, pa0, pa1, pa2, pa3); SBAR();
    if (SDEPTH == 1 || j + 3 < NT) SLOAD(SE, (j + 1 + SDEPTH) * KVBLK); SBAR();
    partialSM(pA0, pA1, m_reg, alA, mdA, skA, dqh0 - (float)((j + 1) * KVBLK), nc2); SBAR();
    pv_d0<true>(o, vb0 + SHM_V, pa0, pa1, pa2, pa3, pA0);
    __syncthreads(); SWAIT(); SWRITE(1, SO);
    RESC(alA); __syncthreads();
  }
  SBAR(); CTL(NT - 1, mdB, skB); qkt(pB0, pB1, K_lds + SHM_K, qr, r32, hi, kx0, kx1, qx);
  finishSM(pA0, pA1, alA, l_reg, pa0, pa1, pa2, pa3); SBAR();
  partialSM(pB0, pB1, m_reg, alB, mdB, skB, dqh0 - (float)((NT - 1) * KVBLK), nc2); SBAR();
  pv_d0<true>(o, vb0, pa0, pa1, pa2, pa3, pB0);
  __syncthreads(); RESC(alB);
  finishSM(pB0, pB1, alB, l_reg, pa0, pa1, pa2, pa3); SBAR();
  pv_d0<false>(o, vb0 + SHM_V, pa0, pa1, pa2, pa3, pB0);
  if (hi == 0) li_l[r32] = l_reg; asm volatile("s_waitcnt lgkmcnt(0)" ::: "memory");
#pragma unroll
  for (int r = 0; r < 16; ++r) { const float rli = __builtin_amdgcn_rcpf(li_l[crow(r, hi)]);
#pragma unroll
    for (int d0 = 0; d0 < 4; ++d0) o[d0][r] *= rli; }
#undef CTL
#undef SLOAD
#undef SWRITE
#undef SWAIT
#undef RESC
}
}

typedef unsigned short bf16;
typedef unsigned v4u __attribute__((ext_vector_type(4)));
typedef unsigned v2u __attribute__((ext_vector_type(2)));
typedef float f32x4 __attribute__((ext_vector_type(4)));
#define LAS __attribute__((address_space(3)))
constexpr int NWAVES = 8, NTHREADS = 512;
constexpr int D = 1024, FF = 4096, MG = 16384, MTOT = 32768;
constexpr int DEPTH = 4;
constexpr float QSCALE = 0.125f * 1.4426950408889634f;
constexpr size_t MiB = 1u << 20;
constexpr size_t WS_CTL = 0, WS_ZERO_END = 64 * 1024;
constexpr size_t WS_WMI = 2 * MiB, WS_WMO = 10 * MiB, WS_WQKV = 14 * MiB, WS_WAO = 26 * MiB, WS_W1 = 30 * MiB, WS_W2 = 62 * MiB;
constexpr size_t WS_XB = 94 * MiB, WS_BIG = 126 * MiB, WS_ROWSQ = 254 * MiB, WS_END = WS_ROWSQ + 9 * (size_t)MG * 64;
static_assert(WS_ZERO_END <= WS_WMI, "ws map");
constexpr int CW_ATTCTR = 0;
constexpr int CW_ARR = 8192;
constexpr int CW_BAR = 4096;
constexpr int CW_NRM = 1024;

struct Args {
    const float* in[19]; float* out; unsigned char* ws; int ph_lo, ph_hi;
};

__device__ __forceinline__ unsigned f2bf(float f) { unsigned u = __builtin_bit_cast(unsigned, f); return (u + 0x7fffu + ((u >> 16) & 1u)) >> 16; }
__device__ __forceinline__ unsigned pk2(float lo, float hi) { return f2bf(lo) | (f2bf(hi) << 16); }
__device__ __forceinline__ float bflo(unsigned w) { return __uint_as_float(w << 16); }
__device__ __forceinline__ float bfhi(unsigned w) { return __uint_as_float(w & 0xffff0000u); }
__device__ __forceinline__ float wave_sum(float v) {
    v += xor_lt32<1>(v); v += xor_lt32<2>(v); v += xor_lt32<4>(v); v += xor_lt32<8>(v); v += xor_lt32<16>(v);
    return sum_x32(v);
}

__device__ __forceinline__ void transpose_item(const float* W, int ldw, int N, const float* gs, bf16* WT, int ldk, int koff, LAS float* scr, int item, int lane) {
    const int nblk = N / 32, kb = item / nblk, nb = item % nblk, k0 = 64 * kb, n0 = 32 * nb;
#pragma unroll
    for (int i = 0; i < 8; ++i) { const int kk = 8 * i + (lane >> 3), c4 = (lane & 7) * 4;
        f32x4 v = *(const f32x4*)(W + (size_t)(k0 + kk) * ldw + n0 + c4); if (gs) v = v * gs[k0 + kk];
        scr[kk * 33 + c4] = v[0]; scr[kk * 33 + c4 + 1] = v[1]; scr[kk * 33 + c4 + 2] = v[2]; scr[kk * 33 + c4 + 3] = v[3]; }
    asm volatile("s_waitcnt lgkmcnt(0)" ::: "memory");
    const int c = lane & 7;
#pragma unroll
    for (int j = 0; j < 4; ++j) { const int n = (lane >> 3) + 8 * j; const LAS float* s = scr + (8 * c) * 33 + n;
        v4u o; o.x = pk2(s[0 * 33], s[1 * 33]); o.y = pk2(s[2 * 33], s[3 * 33]); o.z = pk2(s[4 * 33], s[5 * 33]); o.w = pk2(s[6 * 33], s[7 * 33]);
        *(v4u*)(WT + (size_t)(n0 + n) * ldk + koff + k0 + 8 * c) = o; }
    asm volatile("s_waitcnt lgkmcnt(0)" ::: "memory");
}

__device__ __forceinline__ void phase_prologue(const Args& a, LAS unsigned char* lds) {
    const int tid = mk_tid(), lane = tid & 63, wave = tid >> 6;
    const int gt = blockIdx.x * NTHREADS + tid, NGT = gridDim.x * NTHREADS;
    const int gw = blockIdx.x * NWAVES + wave, NGW = gridDim.x * NWAVES;
    { v4u z = {0u, 0u, 0u, 0u}; v4u* p = (v4u*)(a.ws + WS_CTL); for (int i = gt; i < (int)(WS_ZERO_END / 16); i += NGT) p[i] = z; }
    LAS float* scr = (LAS float*)(lds + wave * 16384);
    const float* norm1_g = a.in[2]; const float* norm2_g = a.in[3];
    constexpr int I_MI = 16 * 64, I_MO = 8 * 32, I_QKV = 16 * 96, I_AO = 16 * 32, I_W1 = 16 * 128, I_W2 = 64 * 32;
    constexpr int T_MI = 2 * I_MI, T_MO = T_MI + 2 * I_MO, T_QKV = T_MO + 2 * I_QKV, T_AO = T_QKV + 2 * I_AO, T_W1 = T_AO + 4 * I_W1, T_W2 = T_W1 + 4 * I_W2;
    for (int it = gw; it < T_W2; it += NGW) {
        if (it < T_MI) { const int j = it / I_MI, r = it % I_MI;
            transpose_item(a.in[5] + (size_t)j * D * 2048, 2048, 2048, norm1_g + (2 * j) * D, (bf16*)(a.ws + WS_WMI) + (size_t)j * 2048 * D, D, 0, scr, r, lane); }
        else if (it < T_MO) { const int q = it - T_MI, j = q / I_MO, r = q % I_MO;
            transpose_item(a.in[9] + (size_t)j * D * D + (size_t)512 * D, D, D, nullptr, (bf16*)(a.ws + WS_WMO) + (size_t)j * D * D, D, 512, scr, r, lane); }
        else if (it < T_QKV) { const int q = it - T_MO, j = q / I_QKV, r = q % I_QKV;
            transpose_item(a.in[10] + (size_t)j * D * 3072, 3072, 3072, norm1_g + (2 * j + 1) * D, (bf16*)(a.ws + WS_WQKV) + (size_t)j * 3072 * D, D, 0, scr, r, lane); }
        else if (it < T_AO) { const int q = it - T_QKV, j = q / I_AO, r = q % I_AO;
            transpose_item(a.in[11] + (size_t)j * D * D, D, D, nullptr, (bf16*)(a.ws + WS_WAO) + (size_t)j * D * D, D, 0, scr, r, lane); }
        else if (it < T_W1) { const int q = it - T_AO, i = q / I_W1, r = q % I_W1;
            transpose_item(a.in[17] + (size_t)i * D * FF, FF, FF, norm2_g + i * D, (bf16*)(a.ws + WS_W1) + (size_t)i * FF * D, D, 0, scr, r, lane); }
        else { const int q = it - T_W1, i = q / I_W2, r = q % I_W2;
            transpose_item(a.in[18] + (size_t)i * FF * D, D, D, nullptr, (bf16*)(a.ws + WS_W2) + (size_t)i * D * FF, FF, 0, scr, r, lane); }
    }
    for (int it = gw; it < 2 * 4 * 16 * 16; it += NGW) {
        const int cb = it & 15, nb = (it >> 4) & 15, g = (it >> 8) & 3, j = it >> 10;
        const float* pw = a.in[6] + ((size_t)(j * 4 + g) * 128 + cb * 8) * 128;
        const float* ps = a.in[7] + j * 512 + g * 128;
        const float* mo = a.in[9] + (size_t)j * D * D + (size_t)(g * 128) * D + nb * 64 + lane;
        float acc[8];
#pragma unroll
        for (int c = 0; c < 8; ++c) acc[c] = 0.f;
#pragma unroll 8
        for (int d = 0; d < 128; ++d) {
            const float m = mo[(size_t)d * D] * ps[d];
#pragma unroll
            for (int c = 0; c < 8; ++c) acc[c] = fmaf(pw[c * 128 + d], m, acc[c]);
        }
        v4u o; o.x = pk2(acc[0], acc[1]); o.y = pk2(acc[2], acc[3]); o.z = pk2(acc[4], acc[5]); o.w = pk2(acc[6], acc[7]);
        *(v4u*)((bf16*)(a.ws + WS_WMO) + (size_t)j * D * D + (size_t)(nb * 64 + lane) * D + g * 128 + cb * 8) = o;
    }
}

__device__ __forceinline__ void phase_prep(const Args& a, int g) {
    const int tid = mk_tid(), lane = tid & 63, gw = blockIdx.x * NWAVES + (tid >> 6), NGW = gridDim.x * NWAVES;
    const float* xin = g ? a.in[1] : a.in[0]; float* xo = a.out + (size_t)g * MG * D; bf16* xb = (bf16*)(a.ws + WS_XB); float* rsq = (float*)(a.ws + WS_ROWSQ);
    for (int m = gw; m < MG; m += NGW) {
        const f32x4* xr = (const f32x4*)(xin + (size_t)m * D) + lane; f32x4* orow = (f32x4*)(xo + (size_t)m * D) + lane; v2u* brow = (v2u*)(xb + (size_t)m * D) + lane;
        float s = 0.f;
#pragma unroll
        for (int j = 0; j < 4; ++j) { const f32x4 v = xr[64 * j]; orow[64 * j] = v; s += (v[0] * v[0] + v[1] * v[1]) + (v[2] * v[2] + v[3] * v[3]);
            v2u w; w.x = pk2(v[0], v[1]); w.y = pk2(v[2], v[3]); brow[64 * j] = w; }
        s = wave_sum(s);
        if (lane < 16) rsq[(size_t)m * 16 + lane] = lane == 0 ? s : 0.f;
    }
}
__device__ __forceinline__ void phase_final(const Args& a, int g) {
    const int tid = mk_tid(), lane = tid & 63, gw = blockIdx.x * NWAVES + (tid >> 6), NGW = gridDim.x * NWAVES;
    float* xo = a.out + (size_t)g * MG * D; const float* rsq = (const float*)(a.ws + WS_ROWSQ) + (size_t)8 * MG * 16; const f32x4* fg = (const f32x4*)a.in[4] + lane;
    for (int m = gw; m < MG; m += NGW) {
        float rsum;
        { const f32x4* rp = (const f32x4*)(rsq + (size_t)m * 16); const f32x4 a0 = rp[0], a1 = rp[1], a2 = rp[2], a3 = rp[3];
          rsum = (((a0[0] + a0[1]) + (a0[2] + a0[3])) + ((a1[0] + a1[1]) + (a1[2] + a1[3]))) + (((a2[0] + a2[1]) + (a2[2] + a2[3])) + ((a3[0] + a3[1]) + (a3[2] + a3[3]))); }
        const float rs = __builtin_amdgcn_rsqf(rsum * (1.0f / 1024.0f) + 1e-6f);
        f32x4* orow = (f32x4*)(xo + (size_t)m * D) + lane;
#pragma unroll
        for (int j = 0; j < 4; ++j) { f32x4 v = orow[64 * j]; const f32x4 gg = fg[64 * j]; v = v * rs * gg; orow[64 * j] = v; }
    }
}

__device__ __forceinline__ void unpack8(const v4u w, float (&f)[8]) {
    f[0] = bflo(w.x); f[1] = bfhi(w.x); f[2] = bflo(w.y); f[3] = bfhi(w.y); f[4] = bflo(w.z); f[5] = bfhi(w.z); f[6] = bflo(w.w); f[7] = bfhi(w.w);
}
__device__ __forceinline__ void phase_stencil(const Args& a, int g, int j) {
    const int S = g ? 16384 : 8192;
    const bf16* P = (const bf16*)(a.ws + WS_BIG); bf16* A2 = (bf16*)(a.ws + WS_BIG + 64 * MiB);
    const int tid = mk_tid(), chunk = tid & 127, tb = tid >> 7;
    for (int tile = blockIdx.x; tile < MG / 64; tile += gridDim.x) {
        const int row0 = tile * 64 + tb * 16;
        const int b0 = row0 & ~(S - 1), t0 = row0 & (S - 1);
        if (chunk < 64) {
            const int c0 = chunk * 8, hw = 1 << (chunk >> 4);
            const bf16* U = P + (size_t)b0 * 2048 + c0;
            float sum[8];
#pragma unroll
            for (int e = 0; e < 8; ++e) sum[e] = 0.f;
            { const int lo = max(t0 - hw, 0), hi = min(t0 + hw, S);
              for (int t = lo; t < hi; ++t) { float f[8]; unpack8(*(const v4u*)(U + (size_t)t * 2048), f);
#pragma unroll
                  for (int e = 0; e < 8; ++e) sum[e] += f[e]; } }
            for (int i = 0; i < 16; ++i) {
                const int t = t0 + i; const int lo = max(t - hw, 0), hi = min(t + hw, S);
                const float rc = 1.0f / (float)(hi - lo);
                float f[8]; unpack8(*(const v4u*)(U + (size_t)t * 2048), f);
                v4u o; o.x = pk2(sum[0] * rc - f[0], sum[1] * rc - f[1]); o.y = pk2(sum[2] * rc - f[2], sum[3] * rc - f[3]);
                o.z = pk2(sum[4] * rc - f[4], sum[5] * rc - f[5]); o.w = pk2(sum[6] * rc - f[6], sum[7] * rc - f[7]);
                *(v4u*)(A2 + (size_t)(b0 + t) * 1024 + c0) = o;
                if (t + hw < S) { float n[8]; unpack8(*(const v4u*)(U + (size_t)(t + hw) * 2048), n);
#pragma unroll
                    for (int e = 0; e < 8; ++e) sum[e] += n[e]; }
                if (t - hw >= 0) { float n[8]; unpack8(*(const v4u*)(U + (size_t)(t - hw) * 2048), n);
#pragma unroll
                    for (int e = 0; e < 8; ++e) sum[e] -= n[e]; }
            }
        } else {
            const int c0 = (chunk - 64) * 8;
            const bf16* Hc = P + (size_t)b0 * 2048 + 512 + c0; const bf16* Gb = Hc + 512; const bf16* Gc = Hc + 1024;
            const float* cw = a.in[8] + (size_t)j * 3 * 512 + c0;
            float w0[8], w1[8], w2[8];
#pragma unroll
            for (int e = 0; e < 8; ++e) { w0[e] = cw[e]; w1[e] = cw[512 + e]; w2[e] = cw[1024 + e]; }
            float zp[8], zc[8];
            if (t0 > 0) { float hh[8], cc[8]; unpack8(*(const v4u*)(Hc + (size_t)(t0 - 1) * 2048), hh); unpack8(*(const v4u*)(Gc + (size_t)(t0 - 1) * 2048), cc);
#pragma unroll
                for (int e = 0; e < 8; ++e) zp[e] = hh[e] * cc[e]; }
            else {
#pragma unroll
                for (int e = 0; e < 8; ++e) zp[e] = 0.f; }
            { float hh[8], cc[8]; unpack8(*(const v4u*)(Hc + (size_t)t0 * 2048), hh); unpack8(*(const v4u*)(Gc + (size_t)t0 * 2048), cc);
#pragma unroll
              for (int e = 0; e < 8; ++e) zc[e] = hh[e] * cc[e]; }
            for (int i = 0; i < 16; ++i) {
                const int t = t0 + i; float zn[8];
                if (t + 1 < S) { float hh[8], cc[8]; unpack8(*(const v4u*)(Hc + (size_t)(t + 1) * 2048), hh); unpack8(*(const v4u*)(Gc + (size_t)(t + 1) * 2048), cc);
#pragma unroll
                    for (int e = 0; e < 8; ++e) zn[e] = hh[e] * cc[e]; }
                else {
#pragma unroll
                    for (int e = 0; e < 8; ++e) zn[e] = 0.f; }
                float gb[8], r[8]; unpack8(*(const v4u*)(Gb + (size_t)t * 2048), gb);
#pragma unroll
                for (int e = 0; e < 8; ++e) r[e] = gb[e] * (w0[e] * zp[e] + w1[e] * zc[e] + w2[e] * zn[e]);
                v4u o; o.x = pk2(r[0], r[1]); o.y = pk2(r[2], r[3]); o.z = pk2(r[4], r[5]); o.w = pk2(r[6], r[7]);
                *(v4u*)(A2 + (size_t)(b0 + t) * 1024 + 512 + c0) = o;
#pragma unroll
                for (int e = 0; e < 8; ++e) { zp[e] = zc[e]; zc[e] = zn[e]; }
            }
        }
    }
}

__device__ __forceinline__ void phase_attention(const Args& a, int g, int layer, char* lds) {
    using namespace att;
    const int S = g ? 16384 : 8192, logS = g ? 14 : 13; const int j = layer >> 1;
    const bf16* Qb = (const bf16*)(a.ws + WS_BIG); const bf16* Kb = Qb + (size_t)MG * 1024; const bf16* Vb = Kb + (size_t)MG * 1024; bf16* Ob = (bf16*)(a.ws + WS_BIG);
    unsigned* ctr = (unsigned*)(a.ws + WS_CTL) + CW_ATTCTR + 64 * (g * 2 + j);
    unsigned* arr = (unsigned*)(a.ws + WS_CTL) + CW_ARR + 1024 * (g * 2 + j);
    const unsigned* nrm = (const unsigned*)(a.ws + WS_CTL) + CW_NRM + 256 * (g * 2 + j);
    volatile unsigned* s_unit = (volatile unsigned*)(lds + OFF_UNIT);
    const float lambda_init = (layer == 1) ? 0.35550906759096926f : 0.5560582041556405f;
    float lam;
    { const float* q1 = a.in[12] + j * 64; const float* k1 = a.in[13] + j * 64; const float* q2 = a.in[14] + j * 64; const float* k2 = a.in[15] + j * 64;
      const int lane = mk_tid() & 63; float s1 = q1[lane] * k1[lane], s2 = q2[lane] * k2[lane]; s1 = wave_sum(s1); s2 = wave_sum(s2); lam = __expf(s1) - __expf(s2) + lambda_init; }
    const float* subg = a.in[16] + j * 128;
    for (;;) {
        const int tid = mk_tid(), wid = tid >> 6, lane = tid & 63, r32 = lane & 31, hi = lane >> 5;
        __syncthreads();
        if (tid == 0) s_unit[0] = atomicAdd(ctr, 1u);
        __syncthreads();
        const int tk = (int)s_unit[0];
        if (tk >= 1024 * MK_DUP_ATT) break;
        const int u = tk / MK_DUP_ATT; const bool dup = (tk % MK_DUP_ATT) != 0;
        const int h = 7 - (u >> 7), qbi = (u >> 1) & 63, pass = u & 1, uid = u >> 1;
        const int b = (qbi * 256) >> logS, q0 = (qbi * 256) & (S - 1);
        const size_t rowbase = (size_t)b * S;
        const float slope2 = __builtin_amdgcn_exp2f(-(float)(h + 1)) * 1.4426950408889634f;
        const int qpos = q0 + wid * QBLK + r32;
        f32x16 o[4];
        {
            const int map = 2 * h + pass;
            int klo = 0, khi = S; float smax;
            { const unsigned* nq = nrm + ((0 * 2 + b) * 16 + map) * 2; const unsigned* nk = nrm + ((1 * 2 + b) * 16 + map) * 2;
              const float qn2 = __uint_as_float(__hip_atomic_load(nq, __ATOMIC_RELAXED, __HIP_MEMORY_SCOPE_AGENT)) + __uint_as_float(__hip_atomic_load(nq + 1, __ATOMIC_RELAXED, __HIP_MEMORY_SCOPE_AGENT));
              const float kn2 = __uint_as_float(__hip_atomic_load(nk, __ATOMIC_RELAXED, __HIP_MEMORY_SCOPE_AGENT)) + __uint_as_float(__hip_atomic_load(nk + 1, __ATOMIC_RELAXED, __HIP_MEMORY_SCOPE_AGENT));
              smax = sqrtf(qn2 * kn2) * 1.02f;
#if MK_WINDOW
              float sown;
              { const bf16* qp = Qb + (rowbase + q0 + wid * QBLK + r32) * 1024 + map * 64 + hi * 32; const bf16* kp = Kb + (rowbase + q0 + wid * QBLK + r32) * 1024 + map * 64 + hi * 32;
                float acc = 0.f, qq = 0.f;
#pragma unroll
                for (int c = 0; c < 4; ++c) { const v4u qa = *(const v4u*)(qp + c * 8), ka = *(const v4u*)(kp + c * 8);
                    acc += bflo(qa.x) * bflo(ka.x) + bfhi(qa.x) * bfhi(ka.x) + bflo(qa.y) * bflo(ka.y) + bfhi(qa.y) * bfhi(ka.y)
                         + bflo(qa.z) * bflo(ka.z) + bfhi(qa.z) * bfhi(ka.z) + bflo(qa.w) * bflo(ka.w) + bfhi(qa.w) * bfhi(ka.w);
                    qq += bflo(qa.x) * bflo(qa.x) + bfhi(qa.x) * bfhi(qa.x) + bflo(qa.y) * bflo(qa.y) + bfhi(qa.y) * bfhi(qa.y)
                        + bflo(qa.z) * bflo(qa.z) + bfhi(qa.z) * bfhi(qa.z) + bflo(qa.w) * bflo(qa.w) + bfhi(qa.w) * bfhi(qa.w); }
                acc = sum_x32(acc); qq = sum_x32(qq);
                acc = fminf(acc, xor_lt32<1>(acc)); acc = fminf(acc, xor_lt32<2>(acc)); acc = fminf(acc, xor_lt32<4>(acc)); acc = fminf(acc, xor_lt32<8>(acc)); acc = fminf(acc, xor_lt32<16>(acc));
                qq = fmaxf(qq, xor_lt32<1>(qq)); qq = fmaxf(qq, xor_lt32<2>(qq)); qq = fmaxf(qq, xor_lt32<4>(qq)); qq = fmaxf(qq, xor_lt32<8>(qq)); qq = fmaxf(qq, xor_lt32<16>(qq));
                float* wmin = (float*)(lds + OFF_UNIT) + 8;
                if (lane == 0) { wmin[wid] = acc; wmin[8 + wid] = qq; }
                __syncthreads();
                sown = fminf(fminf(fminf(wmin[0], wmin[1]), fminf(wmin[2], wmin[3])), fminf(fminf(wmin[4], wmin[5]), fminf(wmin[6], wmin[7])));
                sown = fminf(sown, 0.f) - 0.25f;
                const float qu2 = fmaxf(fmaxf(fmaxf(wmin[8], wmin[9]), fmaxf(wmin[10], wmin[11])), fmaxf(fmaxf(wmin[12], wmin[13]), fmaxf(wmin[14], wmin[15])));
                smax = fminf(smax, sqrtf(qu2 * kn2) * 1.02f);
              }
              const float wf = (smax - sown + 24.f) / slope2;
              const int wi = (wf < (float)S) ? (int)wf + 1 : S;
              klo = max(q0 - wi, 0) & ~127; khi = min((q0 + 256 + wi + 127) & ~127, S);
#endif
            }
            const int NT = (khi - klo) >> 6;
            const bf16* Qw = Qb + (rowbase + q0 + wid * QBLK + r32) * 1024 + map * 64 + hi * 8;
            const bf16* Kh = Kb + (rowbase + klo) * 1024 + map * 64;
            const bf16* Vh = Vb + (rowbase + klo) * 1024 + h * 128;
            attn_pass(Qw, Kh, Vh, NT, (float)(qpos - klo), klo - (q0 + __builtin_amdgcn_readfirstlane(wid) * QBLK), -slope2, smax, o, lds);
        }
        if (dup) continue;
        const int t2 = mk_tid(); const int r32b = t2 & 31, hib = (t2 >> 5) & 1, widb = t2 >> 6;
        if (t2 == 0) s_unit[1] = atomicAdd(arr + 2 * uid, 1u);
        __syncthreads();
        const unsigned first = s_unit[1];
        f32x4* sp = (f32x4*)(uid < 256 ? (float*)(a.ws + WS_XB) + (size_t)uid * 32768 : (float*)(a.ws + WS_BIG + 96 * MiB) + (size_t)(uid - 256) * 32768) + t2;
        if (first == 0u) {
#pragma unroll
            for (int d0 = 0; d0 < 4; ++d0)
#pragma unroll
                for (int q = 0; q < 4; ++q) {
                    const f32x4 w = {o[d0][4 * q], o[d0][4 * q + 1], o[d0][4 * q + 2], o[d0][4 * q + 3]};
                    asm volatile("global_store_dwordx4 %0, %1, off sc1" :: "v"(sp + (d0 * 4 + q) * 512), "v"(w) : "memory");
                }
            asm volatile("s_waitcnt vmcnt(0)" ::: "memory");
            __syncthreads();
            if (t2 == 0) __hip_atomic_store(arr + 2 * uid + 1, 1u, __ATOMIC_RELEASE, __HIP_MEMORY_SCOPE_AGENT);
            continue;
        }
        if (t2 == 0) { unsigned spn = 0; while (__hip_atomic_load(arr + 2 * uid + 1, __ATOMIC_RELAXED, __HIP_MEMORY_SCOPE_AGENT) == 0u) { __builtin_amdgcn_s_sleep(2); if (++spn > (1u << 24)) break; } }
        __syncthreads();
        __builtin_amdgcn_fence(__ATOMIC_ACQUIRE, "agent");
        float ssq[16];
#pragma unroll
        for (int r = 0; r < 16; ++r) ssq[r] = 0.f;
        f32x4 w[16];
#pragma unroll
        for (int i = 0; i < 16; ++i) asm volatile("global_load_dwordx4 %0, %1, off sc1" : "=v"(w[i]) : "v"(sp + i * 512) : "memory");
        asm volatile("s_waitcnt vmcnt(0)" : "+v"(w[0]), "+v"(w[1]), "+v"(w[2]), "+v"(w[3]), "+v"(w[4]), "+v"(w[5]), "+v"(w[6]), "+v"(w[7]),
                                             "+v"(w[8]), "+v"(w[9]), "+v"(w[10]), "+v"(w[11]), "+v"(w[12]), "+v"(w[13]), "+v"(w[14]), "+v"(w[15]) :: "memory");
#pragma unroll
        for (int d0 = 0; d0 < 4; ++d0)
#pragma unroll
            for (int q = 0; q < 4; ++q) {
#pragma unroll
                for (int e = 0; e < 4; ++e) { const int r = 4 * q + e; const float t = w[d0 * 4 + q][e]; const float v = pass ? (t - lam * o[d0][r]) : (o[d0][r] - lam * t);
                    o[d0][r] = v; ssq[r] = fmaf(v, v, ssq[r]); } }
#pragma unroll
        for (int r = 0; r < 16; ++r) {
            float s = ssq[r];
            s += xor_lt32<1>(s); s += xor_lt32<2>(s); s += xor_lt32<4>(s); s += xor_lt32<8>(s); s += xor_lt32<16>(s);
            ssq[r] = __builtin_amdgcn_rsqf(s * (1.0f / 128.0f) + 1e-5f) * (1.0f - lambda_init);
        }
        bf16* Ow = Ob + (rowbase + q0 + widb * QBLK + 4 * hib) * 1024 + h * 128 + r32b;
#pragma unroll
        for (int d0 = 0; d0 < 4; ++d0) { const float gg = subg[d0 * 32 + r32b];
#pragma unroll
            for (int r = 0; r < 16; ++r) Ow[(size_t)crow(r, 0) * 1024 + d0 * 32] = (bf16)f2bf(o[d0][r] * ssq[r] * gg); }
    }
}


#define XB_TMO      128
#define XB_XCNT(j)  (256  + 64 * (j))
#define XB_XSUB(j)  (1280 + 64 * (j))
#define XB_XGEN(j)  (2304 + 64 * (j))
#define XB_TOP      3328
#define XB_TOPGEN   3392
#define XCD_BAR_WORDS 3456
#define XB_SPIN_CAP (1u << 22)
__device__ __forceinline__ unsigned xb_ld(unsigned* p)              { return __hip_atomic_load(p, __ATOMIC_RELAXED, __HIP_MEMORY_SCOPE_AGENT); }
__device__ __forceinline__ unsigned xb_add(unsigned* p, unsigned v) { return __hip_atomic_fetch_add(p, v, __ATOMIC_RELAXED, __HIP_MEMORY_SCOPE_AGENT); }
__device__ __forceinline__ unsigned xb_xcc_id() { return (unsigned)__builtin_amdgcn_s_getreg((3 << 11) | 20) & 0xFu; }
#define XB_SPIN(cond, bar) do { unsigned _sp = 0; while (cond) { __builtin_amdgcn_s_sleep(1); \
    if ((++_sp & 255u) == 0u) { if (xb_ld(&(bar)[XB_TMO])) break; if (_sp > XB_SPIN_CAP) { atomicAdd(&(bar)[XB_TMO], 1u); break; } } } } while (0)
struct XcdBarrier { unsigned* bar; unsigned x; volatile LAS unsigned* st; };
__device__ __forceinline__ XcdBarrier xcd_barrier_post(unsigned* bar, volatile LAS unsigned* st) {
    XcdBarrier b; b.bar = bar; b.x = xb_xcc_id(); b.st = st;
    if (mk_tid() == 0) (void)xb_add(&bar[XB_XCNT(b.x)], 1u);
    return b;
}
__device__ __forceinline__ void xcd_barrier_complete(unsigned* bar, unsigned x, unsigned& nloc, unsigned& nx) {
    const unsigned G = gridDim.x * gridDim.y * gridDim.z;
    unsigned sum, cnt, mine, sp = 0u;
    for (;;) {
        sum = 0u; cnt = 0u; mine = 0u;
#pragma unroll
        for (unsigned j = 0; j < 16; ++j) { const unsigned c = xb_ld(&bar[XB_XCNT(j)]); sum += c; cnt += (c > 0u) ? 1u : 0u; mine = (j == x) ? c : mine; }
        if (sum == G) break;
        __builtin_amdgcn_s_sleep(1);
        if ((++sp & 255u) == 0u) { if (xb_ld(&bar[XB_TMO])) break; if (sp > XB_SPIN_CAP) { atomicAdd(&bar[XB_TMO], 1u); break; } }
    }
    nloc = mine > 0u ? mine : 1u; nx = cnt > 0u ? cnt : 1u;
}
__device__ __forceinline__ void xcd_barrier(const XcdBarrier& b) {
    asm volatile("s_waitcnt vmcnt(0)" ::: "memory");
    __syncthreads();
    if (mk_tid() == 0) {
        unsigned* bar = b.bar;
        __builtin_amdgcn_s_waitcnt(0);
        unsigned nloc = b.st[0], nx = b.st[1];
        if (nloc == 0u) { xcd_barrier_complete(bar, b.x, nloc, nx); b.st[0] = nloc; b.st[1] = nx; }
        const unsigned old = xb_add(&bar[XB_XSUB(b.x)], 1u);
        const unsigned gen = old / nloc;
        if (old + 1u == (gen + 1u) * nloc) {
            __builtin_amdgcn_fence(__ATOMIC_RELEASE, "agent");
            asm volatile("s_waitcnt vmcnt(0)" ::: "memory");
            const unsigned og = xb_add(&bar[XB_TOP], 1u);
            const unsigned tg = og / nx;
            if (og + 1u == (tg + 1u) * nx) xb_add(&bar[XB_TOPGEN], 1u);
            else XB_SPIN(xb_ld(&bar[XB_TOPGEN]) == tg, bar);
            __builtin_amdgcn_fence(__ATOMIC_ACQUIRE, "agent");
            xb_add(&bar[XB_XGEN(b.x)], 1u);
            asm volatile("s_waitcnt vmcnt(0)" ::: "memory");
        } else {
            XB_SPIN(xb_ld(&bar[XB_XGEN(b.x)]) == gen, bar);
            __builtin_amdgcn_fence(__ATOMIC_ACQUIRE, "agent");
            asm volatile("s_waitcnt vmcnt(0)" ::: "memory");
        }
    }
    __syncthreads();
}

constexpr int LDS_BYTES = 147456;
constexpr int N_PHASES = 1 + 2 * (4 * 5 + 1);
#ifndef MK_MASK
#define MK_MASK 0xFFFF
#endif
#define EN(k) ((MK_MASK >> (k)) & 1)

__global__ void __launch_bounds__(NTHREADS, 2) fwd_megakernel(Args args) {
    extern __shared__ __attribute__((aligned(16))) unsigned char lds[];
    cg::grid_group grid = cg::this_grid();
    const int lo = args.ph_lo, hi = args.ph_hi;
    int ph = 0;
#define RUN() (ph >= lo && ph < hi)
#if MK_PROBE
    unsigned long long t_last = __builtin_amdgcn_s_memrealtime(), t_a = 0, t_b = 0;
#define SEAMK(k) do { if (ph >= lo && ph + 1 < hi) grid.sync(); ++ph; { const unsigned long long t_now = __builtin_amdgcn_s_memrealtime(); \
        if ((MK_PROBE_A >> (k)) & 1) t_a += t_now - t_last; if ((MK_PROBE_B >> (k)) & 1) t_b += t_now - t_last; t_last = t_now; } } while (0)
#else
#define SEAMK(k) do { if (ph >= lo && ph + 1 < hi) { if (ph == 0) { grid.sync(); xbar = xcd_barrier_post((unsigned*)(ws + WS_CTL) + CW_BAR, xst); } else xcd_barrier(xbar); } ++ph; } while (0)
#endif
#define SEAM() SEAMK(0)
    unsigned char* ws = args.ws;
    volatile LAS unsigned* xst = (volatile LAS unsigned*)((LAS unsigned char*)lds + 131072 + 256);
    if (mk_tid() == 0) { xst[0] = 0u; xst[1] = 0u; }
    __syncthreads();
    XcdBarrier xbar; xbar.bar = (unsigned*)(ws + WS_CTL) + CW_BAR; xbar.x = 0; xbar.st = xst;
    PG8_LAS unsigned char* glds = (PG8_LAS unsigned char*)lds;
    const int G = gridDim.x, c = blockIdx.x;

    if (EN(0) && RUN()) { _Pragma("unroll 1") for (int rep = 0; rep < 1 + (MK_DUP_MISC & 1); ++rep) { phase_prologue(args, (LAS unsigned char*)lds); __syncthreads(); }
                          phase_prep(args, 0); }
    SEAMK(1);
#pragma unroll 1
    for (int g = 0; g < 2; ++g) {
        float* xg = args.out + (size_t)g * MG * D; bf16* XB = (bf16*)(ws + WS_XB);
        float* rsq_base = (float*)(ws + WS_ROWSQ);
#pragma unroll 1
        for (int i = 0; i < DEPTH; ++i) {
            const int j = i >> 1;
            float* rsq_n1 = rsq_base + (size_t)(2 * i) * MG * 16; float* rsq_n2 = rsq_base + (size_t)(2 * i + 1) * MG * 16; float* rsq_nx = rsq_base + (size_t)(2 * i + 2) * MG * 16;
            if ((i & 1) == 0) {
                if (EN(2) && RUN()) {
                    pg8::Gemm gm{XB, (const bf16*)(ws + WS_WMI) + (size_t)j * 2048 * D, MG, 2048, D}; pg8::StaticOrder S; S.init(MG, 2048, G, c);
                    pg8::EpiProj<0> E{(bf16*)(ws + WS_BIG), 2048, rsq_n1, 0, 1.f, nullptr, 0, (PG8_LAS float*)(glds + 131072 + 1024)};
                    _Pragma("unroll 1") for (int rep = 0; rep < MK_DUP; ++rep) pg8::gemm_phase<pg8::EpiProj<0>, pg8::StaticOrder, true, true>(glds, gm, S, E);
                }
                SEAMK(3);
                if (EN(3) && RUN()) { _Pragma("unroll 1") for (int rep = 0; rep < 1 + ((MK_DUP_MISC >> 2) & 1); ++rep) phase_stencil(args, g, j); }
                SEAMK(4);
                if (EN(4) && RUN()) {
                    pg8::Gemm gm{(const bf16*)(ws + WS_BIG + 64 * MiB), (const bf16*)(ws + WS_WMO) + (size_t)j * D * D, MG, D, D}; pg8::StaticOrder S; S.init(MG, D, G, c);
                    pg8::EpiRes E{xg, XB, rsq_n2, 0};
                    if (MK_DUP_RES == 1) { pg8::EpiNull E0; pg8::gemm_phase<pg8::EpiNull, pg8::StaticOrder, true, true>(glds, gm, S, E0); }
                    if (MK_DUP_RES == 2) { pg8::EpiRes E0 = E; E0.dry = 1; pg8::gemm_phase<pg8::EpiRes, pg8::StaticOrder, true, true>(glds, gm, S, E0); }
                    pg8::gemm_phase<pg8::EpiRes, pg8::StaticOrder, true, true>(glds, gm, S, E);
                }
                SEAMK(5);
            } else {
                if (EN(5) && RUN()) {
                    pg8::Gemm gm{XB, (const bf16*)(ws + WS_WQKV) + (size_t)j * 3072 * D, MG, 3072, D}; pg8::StaticOrder S; S.init(MG, 3072, G, c);
                    pg8::EpiProj<1> E{(bf16*)(ws + WS_BIG), 1024, rsq_n1, (size_t)MG * 1024, QSCALE, (unsigned*)(ws + WS_CTL) + CW_NRM + 256 * (g * 2 + j), g ? 14 : 13, (PG8_LAS float*)(glds + 131072 + 1024)};
                    _Pragma("unroll 1") for (int rep = 0; rep < MK_DUP; ++rep) pg8::gemm_phase<pg8::EpiProj<1>, pg8::StaticOrder, true, true>(glds, gm, S, E);
                }
                SEAMK(6);
                if (EN(6) && RUN()) phase_attention(args, g, i, (char*)lds);
                SEAMK(7);
                if (EN(7) && RUN()) {
                    pg8::Gemm gm{(const bf16*)(ws + WS_BIG), (const bf16*)(ws + WS_WAO) + (size_t)j * D * D, MG, D, D}; pg8::StaticOrder S; S.init(MG, D, G, c);
                    pg8::EpiRes E{xg, XB, rsq_n2, 0};
                    if (MK_DUP_RES == 1) { pg8::EpiNull E0; pg8::gemm_phase<pg8::EpiNull, pg8::StaticOrder, true, true>(glds, gm, S, E0); }
                    if (MK_DUP_RES == 2) { pg8::EpiRes E0 = E; E0.dry = 1; pg8::gemm_phase<pg8::EpiRes, pg8::StaticOrder, true, true>(glds, gm, S, E0); }
                    pg8::gemm_phase<pg8::EpiRes, pg8::StaticOrder, true, true>(glds, gm, S, E);
                }
                SEAMK(8);
            }
            if (EN(8) && RUN()) {
                pg8::Gemm gm{XB, (const bf16*)(ws + WS_W1) + (size_t)i * FF * D, MG, FF, D}; pg8::StaticOrder S; S.init(MG, FF, G, c);
                pg8::EpiProj<2> E{(bf16*)(ws + WS_BIG), FF, rsq_n2, 0, 1.f, nullptr, 0, (PG8_LAS float*)(glds + 131072 + 1024)};
                _Pragma("unroll 1") for (int rep = 0; rep < MK_DUP; ++rep) pg8::gemm_phase<pg8::EpiProj<2>, pg8::StaticOrder, true, true>(glds, gm, S, E);
            }
            SEAMK(9);
            if (EN(9) && RUN()) {
                pg8::Gemm gm{(const bf16*)(ws + WS_BIG), (const bf16*)(ws + WS_W2) + (size_t)i * D * FF, MG, D, FF}; pg8::StaticOrder S; S.init(MG, D, G, c);
                pg8::EpiRes E{xg, XB, rsq_nx, 0};
                if (MK_DUP_RES == 1) { pg8::EpiNull E0; pg8::gemm_phase<pg8::EpiNull, pg8::StaticOrder, true, true>(glds, gm, S, E0); }
                    if (MK_DUP_RES == 2) { pg8::EpiRes E0 = E; E0.dry = 1; pg8::gemm_phase<pg8::EpiRes, pg8::StaticOrder, true, true>(glds, gm, S, E0); }
                    pg8::gemm_phase<pg8::EpiRes, pg8::StaticOrder, true, true>(glds, gm, S, E);
            }
            SEAMK(10);
        }
        if (EN(10) && RUN()) { phase_final(args, g); if (g == 0) phase_prep(args, 1); }
        SEAMK(11);
    }
#if MK_PROBE
    if (blockIdx.x == 0 && (mk_tid() >> 6) == 0) {
        const float da = (float)t_a * 1e-5f / 1.5f, db = (float)t_b * 1e-5f;
        for (int g = 0; g < 2; ++g) { float* r0 = args.out + (size_t)g * MG * D; const int lane = mk_tid() & 63;
            for (int q = 0; q < 16; ++q) r0[q * 64 + lane] += da;
            if (lane == 0) r0[(size_t)2048 * D] += db; }
    }
#endif
#undef RUN
#undef SEAM
}

extern "C" void kernel_launch(void* const* d_in, const int* in_sizes, int n_in, void* d_out, int out_size, void* d_ws, size_t ws_size, hipStream_t stream) {
    static int grid = 0;
    if (grid == 0) {
        if (n_in != 19 || in_sizes[0] != MG * D || in_sizes[1] != MG * D || out_size != MTOT * D || ws_size < WS_END) {
            fprintf(stderr, "kernel_launch: unexpected shapes: n_in %d in0 %d in1 %d out %d ws %zu (need %zu); nothing launched\n", n_in, n_in > 0 ? in_sizes[0] : -1, n_in > 1 ? in_sizes[1] : -1, out_size, ws_size, (size_t)WS_END);
            grid = -1; return; }
        int dev = 0, cus = 0, per_cu = 0;
        hipGetDevice(&dev);
        hipDeviceGetAttribute(&cus, hipDeviceAttributeMultiprocessorCount, dev);
        if (hipFuncSetAttribute((const void*)fwd_megakernel, hipFuncAttributeMaxDynamicSharedMemorySize, LDS_BYTES) != hipSuccess) { fprintf(stderr, "kernel_launch: hipFuncSetAttribute failed\n"); grid = -1; return; }
        if (hipOccupancyMaxActiveBlocksPerMultiprocessor(&per_cu, (const void*)fwd_megakernel, NTHREADS, LDS_BYTES) != hipSuccess || per_cu < 1) { fprintf(stderr, "kernel_launch: occupancy query failed (%d)\n", per_cu); per_cu = 1; }
        (void)hipGetLastError();
        grid = cus * per_cu;
        if (grid > 256) grid = 256;
    }
    if (grid < 0) return;
    Args a{};
    for (int i = 0; i < 19; ++i) a.in[i] = (const float*)d_in[i];
    a.out = (float*)d_out; a.ws = (unsigned char*)d_ws;
#if MK_PER_PHASE
    for (int p = 0; p < N_PHASES; ++p) {
        a.ph_lo = p; a.ph_hi = p + 1;
        void* kargs[] = {&a};
        hipError_t e = hipLaunchCooperativeKernel((const void*)fwd_megakernel, dim3(grid), dim3(NTHREADS), kargs, LDS_BYTES, stream);
        if (e != hipSuccess) { fprintf(stderr, "kernel_launch: cooperative launch %d failed: %s\n", p, hipGetErrorString(e)); break; }
    }
#else
    a.ph_lo = 0; a.ph_hi = N_PHASES;
    void* kargs[] = {&a};
    hipError_t e = hipLaunchCooperativeKernel((const void*)fwd_megakernel, dim3(grid), dim3(NTHREADS), kargs, LDS_BYTES, stream);
    if (e != hipSuccess) fprintf(stderr, "kernel_launch: cooperative launch failed: %s (grid %d)\n", hipGetErrorString(e), grid);
#endif
}
```

```cpp
#include <hip/hip_runtime.h>
#include <hip/hip_cooperative_groups.h>
#include <cstdio>
#include <cstdint>
namespace cg = cooperative_groups;

#ifndef MK_WINDOW
#define MK_WINDOW 1
#endif
#ifndef MK_PROBE
#define MK_PROBE 0
#endif
#ifndef MK_PROBE_A
#define MK_PROBE_A (1 << 7)
#endif
#ifndef MK_PROBE_B
#define MK_PROBE_B ((1 << 3) | (1 << 5) | (1 << 6) | (1 << 8) | (1 << 9) | (1 << 10))
#endif
#ifndef MK_DUP
#define MK_DUP 1
#endif
#ifndef MK_DUP_ATT
#define MK_DUP_ATT 1
#endif
#ifndef MK_DUP_MISC
#define MK_DUP_MISC 0
#endif
#ifndef MK_DUP_RES
#define MK_DUP_RES 0
#endif
#ifndef MK_PER_PHASE
#define MK_PER_PHASE 0
#endif

__device__ __forceinline__ int mk_tid() { int t = threadIdx.x; asm volatile("" : "+v"(t)); return t; }

template <int M> __device__ __forceinline__ float xor_lt32(float v) { return __int_as_float(__builtin_amdgcn_ds_swizzle(__float_as_int(v), (M << 10) | 0x1f)); }
__device__ __forceinline__ float sum_x32(float v) { auto rr = __builtin_amdgcn_permlane32_swap(__float_as_uint(v), __float_as_uint(v), false, false); return __uint_as_float(rr[0]) + __uint_as_float(rr[1]); }

namespace pg8 {
#define PG8_LAS __attribute__((address_space(3)))
typedef unsigned short bf16_t;
typedef short bf16x8 __attribute__((ext_vector_type(8)));
typedef float f32x4 __attribute__((ext_vector_type(4)));
typedef unsigned u32x4 __attribute__((ext_vector_type(4)));
constexpr int BM = 256, BK = 64, HALF = 128, HTB = HALF * BK * 2  , STAGE_BYTES = 8 * HTB, NXCD = 8, WGM = 8;

__host__ __device__ __forceinline__ int lds_byte(int r, int c) { const int st = (r >> 4) * 2 + (c >> 5), rr = r & 15, cc = c & 31, ob = rr * 64 + cc * 2; return st * 1024 + (ob ^ (((ob >> 9) & 1) << 5)); }
__host__ __device__ __forceinline__ void stage_rc(int b, int& R, int& C) { const int st = b / 1024, sb = b % 1024, swz = sb ^ (((sb >> 9) & 1) << 5); R = (st >> 1) * 16 + swz / 64; C = (st & 1) * 32 + (swz % 64) / 2; }
__host__ __device__ __forceinline__ int perm32(int rho) { const int n = rho >> 4, i = rho & 15; return 8 * (i >> 2) + 4 * n + (i & 3); }

struct Unit { int pm, pn; };
struct Gemm { const bf16_t* A; const bf16_t* Bt; int M, N, K; };

struct StaticOrder {
    int nM, nN, nwg, G, c;
    __host__ __device__ void init(int M, int N, int G_, int c_) { nM = M / BM; nN = N / BM; nwg = nM * nN; G = G_; c = c_; }
    __host__ __device__ bool next(int i, Unit& u) const {
        const long L = (long)i * G + c; if (L >= nwg) return false;
        int wgid = (int)L; { const int q = nwg / NXCD, r = nwg % NXCD, xcd = wgid % NXCD, off = wgid / NXCD; wgid = (xcd < r ? xcd * (q + 1) : r * (q + 1) + (xcd - r) * q) + off; }
        const int nig = WGM * nN, gid = wgid / nig, fm = gid * WGM, gsz = (nM - fm) < WGM ? (nM - fm) : WGM;
        u.pm = fm + ((wgid % nig) % gsz); u.pn = (wgid % nig) / gsz; return true;
    }
    __device__ __forceinline__ void a_ready(const Unit&) const {}
    __device__ __forceinline__ void done(const Unit&) const {}
};

__device__ __forceinline__ unsigned cvt_pk_bf16(float lo, float hi) { unsigned r; asm volatile("v_cvt_pk_bf16_f32 %0, %1, %2" : "=v"(r) : "v"(lo), "v"(hi)); return r; }
typedef float f32x2 __attribute__((ext_vector_type(2)));
template <int MODE> struct EpiProj {
    static constexpr bool PERM = true, AFTER_DRAIN = false;
    bf16_t* O; int ldc; const float* rowsq; size_t split_stride; float scale0; unsigned* nrm; int logS; PG8_LAS float* rl;
    __device__ __forceinline__ void operator()(const f32x4 (&acc)[2][2][4][2], const Unit& u, int wr, int wc, int fr, int fq) const {
        const int row0 = u.pm * BM + wr * 64 + fr; int colt = u.pn * BM; bf16_t* base = O; float sc = 1.f; int t = 0;
        if (MODE == 1) { t = colt >> 10; base += (size_t)t * split_stride; colt &= 1023; if (t == 0) sc = scale0; }
        const int col0 = colt + wc * 32 + 8 * fq;
        float nmx[2] = {0.f, 0.f};
        { const int t = (wr * 4 + wc) * 64 + fq * 16 + fr;
          const f32x4* rp = (const f32x4*)(rowsq + (size_t)(u.pm * BM + (t >> 1)) * 16) + (t & 1) * 2; const f32x4 a0 = rp[0], a1 = rp[1];
          float s = ((a0[0] + a0[1]) + (a0[2] + a0[3])) + ((a1[0] + a1[1]) + (a1[2] + a1[3]));
          s += xor_lt32<1>(s);
          if ((t & 1) == 0) rl[t >> 1] = __builtin_amdgcn_rsqf(s * (1.0f / 1024.0f) + 1e-6f);
          asm volatile("s_waitcnt lgkmcnt(0)" ::: "memory"); __builtin_amdgcn_s_barrier(); asm volatile("" ::: "memory"); }
#pragma unroll
        for (int ai = 0; ai < 2; ++ai)
#pragma unroll
            for (int m = 0; m < 4; ++m) {
                const int row = row0 + ai * HALF + m * 16;
                const float rs = rl[wr * 64 + fr + ai * HALF + m * 16] * sc;
                bf16_t* rowp = base + (size_t)row * ldc + col0;
#pragma unroll
                for (int bj = 0; bj < 2; ++bj) {
                    f32x4 v0 = acc[ai][bj][m][0] * rs, v1 = acc[ai][bj][m][1] * rs;
                    if (MODE == 2) {
#pragma unroll
                        for (int e = 0; e < 4; ++e) { const float a = fmaxf(v0[e], 0.f), b = fmaxf(v1[e], 0.f); v0[e] = a * a; v1[e] = b * b; }
                    }
                    if (MODE == 1) {
                        float s = (v0[0] * v0[0] + v0[1] * v0[1]) + (v0[2] * v0[2] + v0[3] * v0[3]) + (v1[0] * v1[0] + v1[1] * v1[1]) + (v1[2] * v1[2] + v1[3] * v1[3]);
                        s += xor_lt32<16>(s); s = sum_x32(s);
                        nmx[bj] = fmaxf(nmx[bj], s);
                    }
                    u32x4 w; w.x = cvt_pk_bf16(v0[0], v0[1]); w.y = cvt_pk_bf16(v0[2], v0[3]); w.z = cvt_pk_bf16(v1[0], v1[1]); w.w = cvt_pk_bf16(v1[2], v1[3]);
                    *(u32x4*)(rowp + bj * HALF) = w;
                }
            }
        if (MODE == 1) {
            if (t < 2) {
                const int b = (u.pm * BM) >> logS;
#pragma unroll
                for (int bj = 0; bj < 2; ++bj) {
                    float v = nmx[bj];
                    v = fmaxf(v, xor_lt32<1>(v)); v = fmaxf(v, xor_lt32<2>(v)); v = fmaxf(v, xor_lt32<4>(v)); v = fmaxf(v, xor_lt32<8>(v));
                    const int map = (colt >> 6) + 2 * bj + (wc >> 1), half = wc & 1;
                    if (fr == 0 && fq == 0) atomicMax(nrm + (((t * 2 + b) * 16 + map) * 2 + half), __float_as_uint(v));
                }
            }
        }
    }
};
struct EpiRes {
    static constexpr bool PERM = false, AFTER_DRAIN = false;
    float* x; bf16_t* xb; float* rowsq; int dry;
    __device__ __forceinline__ void operator()(const f32x4 (&acc)[2][2][4][2], const Unit& u, int wr, int wc, int fr, int fq) const {
        typedef unsigned u32x2v __attribute__((ext_vector_type(2)));
        const int col0 = u.pn * BM + wc * 32 + 4 * fq;
#pragma unroll
        for (int ai = 0; ai < 2; ++ai)
#pragma unroll
            for (int m = 0; m < 4; ++m) {
                const int row = u.pm * BM + ai * HALF + wr * 64 + m * 16 + fr; const size_t off = (size_t)row * 1024 + col0;
                float ss = 0.f;
#pragma unroll
                for (int bj = 0; bj < 2; ++bj)
#pragma unroll
                    for (int n = 0; n < 2; ++n) {
                        const f32x4 xo = *(const f32x4*)(x + off + bj * HALF + n * 16);
                        const f32x4 xn = xo + acc[ai][bj][m][n];
                        *(f32x4*)(x + off + bj * HALF + n * 16) = dry ? xo : xn;
                        ss += (xn[0] * xn[0] + xn[1] * xn[1]) + (xn[2] * xn[2] + xn[3] * xn[3]);
                        u32x2v w; w.x = cvt_pk_bf16(xn[0], xn[1]); w.y = cvt_pk_bf16(xn[2], xn[3]);
                        *(u32x2v*)(xb + off + bj * HALF + n * 16) = w;
                    }
                ss += xor_lt32<16>(ss); ss = sum_x32(ss);
                if (fq == 0) rowsq[(size_t)row * 16 + u.pn * 4 + wc] = ss;
            }
    }
};

struct EpiNull {
    static constexpr bool PERM = false, AFTER_DRAIN = false;
    __device__ __forceinline__ void operator()(const f32x4 (&acc)[2][2][4][2], const Unit& u, int wr, int wc, int fr, int fq) const {
#pragma unroll
        for (int ai = 0; ai < 2; ++ai)
#pragma unroll
            for (int bj = 0; bj < 2; ++bj)
#pragma unroll
                for (int m = 0; m < 4; ++m)
#pragma unroll
                    for (int n = 0; n < 2; ++n) asm volatile("" :: "v"(acc[ai][bj][m][n]));
    }
};

template <class Epi, class Sched, bool ALIGN_EPI = false, bool SP2 = false>
__device__ __forceinline__ void gemm_phase(PG8_LAS unsigned char* lds, const Gemm g, const Sched& S, const Epi& E) {
    const int tid = mk_tid(), wid = __builtin_amdgcn_readfirstlane(tid >> 6), lane = tid & 63, wr = wid >> 2, wc = wid & 3, fr = lane & 15, fq = lane >> 4;
    const int K = g.K, nt = K / BK;
    unsigned voffA[2], voffB[2];
#pragma unroll
    for (int i = 0; i < 2; ++i) { int R, C; stage_rc(tid * 16 + i * 8192, R, C); const int Rb = Epi::PERM ? ((R & ~31) + perm32(R & 31)) : R;
        voffA[i] = (unsigned)(R * K + C) * 2u; voffB[i] = (unsigned)(Rb * K + C) * 2u; }
    const size_t kstep = (size_t)(BK * 2);
    const size_t hstep = (size_t)HALF * K * 2;
    const size_t tstep = 2 * hstep;
    const unsigned ldsw = (unsigned)wid * 1024u;
    const int aoff = lds_byte(wr * 64 + fr, fq * 8), boff = lds_byte(wc * 32 + fr, fq * 8);
#define PG8_SA(b, h) (((b) * 2 + (h)) * HTB)
#define PG8_SB(b, h) ((4 + (b) * 2 + (h)) * HTB)
#define PG8_STAGE(bufoff, gbase, voff) do { _Pragma("unroll") for (int _i = 0; _i < 2; ++_i) \
        __builtin_amdgcn_global_load_lds((const unsigned*)((const char*)(gbase) + (voff)[_i]), (PG8_LAS unsigned*)(lds + (bufoff) + ldsw + _i * 8192), 16, 0, 0); } while (0)
#define PG8_LDA(dst, b, h) do { _Pragma("unroll") for (int m = 0; m < 4; ++m) _Pragma("unroll") for (int k = 0; k < 2; ++k) dst[m][k] = *(const PG8_LAS bf16x8*)(lds + PG8_SA(b, h) + aoff + m * 2048 + k * 1024); } while (0)
#define PG8_LDB(dst, b, h) do { _Pragma("unroll") for (int n = 0; n < 2; ++n) _Pragma("unroll") for (int k = 0; k < 2; ++k) dst[n][k] = *(const PG8_LAS bf16x8*)(lds + PG8_SB(b, h) + boff + n * 2048 + k * 1024); } while (0)
#define PG8_MMA(ai, bj, At, Bt) do { __builtin_amdgcn_s_setprio(1); _Pragma("unroll") for (int m = 0; m < 4; ++m) _Pragma("unroll") for (int n = 0; n < 2; ++n) _Pragma("unroll") for (int k = 0; k < 2; ++k) \
        acc[ai][bj][m][n] = __builtin_amdgcn_mfma_f32_16x16x32_bf16(Bt[n][k], At[m][k], acc[ai][bj][m][n], 0, 0, 0); __builtin_amdgcn_s_setprio(0); } while (0)
#define PG8_WAIT_V(n) asm volatile("s_waitcnt vmcnt(" #n ")" ::: "memory")
#define PG8_WAIT_L(n) asm volatile("s_waitcnt lgkmcnt(" #n ")" ::: "memory")
#define PG8_BAR __builtin_amdgcn_s_barrier()
#define PG8_SCHED __builtin_amdgcn_sched_barrier(0)
    Unit cur, nxt; int ui = 0;
    if (!S.next(0, cur)) return;
    f32x4 acc[2][2][4][2];
#pragma unroll
    for (int a = 0; a < 2; ++a)
#pragma unroll
        for (int b = 0; b < 2; ++b)
#pragma unroll
            for (int m = 0; m < 4; ++m)
#pragma unroll
                for (int n = 0; n < 2; ++n) acc[a][b][m][n] = (f32x4){0.f, 0.f, 0.f, 0.f};
    bf16x8 At[4][2], B0[2][2], B1[2][2];
    const char* cA = (const char*)g.A + (size_t)cur.pm * tstep; const char* cB = (const char*)g.Bt + (size_t)cur.pn * tstep;
    S.a_ready(cur);
    if constexpr (SP2) {
        PG8_STAGE(PG8_SB(0, 0), cB, voffB); PG8_STAGE(PG8_SB(0, 1), cB + hstep, voffB); PG8_STAGE(PG8_SA(0, 0), cA, voffA); PG8_STAGE(PG8_SA(0, 1), cA + hstep, voffA);
        if (wr == 1) PG8_BAR;
        PG8_WAIT_V(2); PG8_BAR;
        PG8_STAGE(PG8_SB(1, 0), cB + kstep, voffB); PG8_STAGE(PG8_SA(1, 0), cA + kstep, voffA); PG8_STAGE(PG8_SB(1, 1), cB + hstep + kstep, voffB);
        PG8_WAIT_V(6); PG8_BAR;
    } else {
        PG8_STAGE(PG8_SB(0, 0), cB, voffB); PG8_STAGE(PG8_SA(0, 0), cA, voffA); PG8_STAGE(PG8_SB(0, 1), cB + hstep, voffB); PG8_STAGE(PG8_SA(0, 1), cA + hstep, voffA);
        if (wr == 1) PG8_BAR;
        PG8_WAIT_V(4); PG8_BAR;
        PG8_STAGE(PG8_SB(1, 0), cB + kstep, voffB); PG8_STAGE(PG8_SA(1, 0), cA + kstep, voffA); PG8_STAGE(PG8_SB(1, 1), cB + hstep + kstep, voffB);
        PG8_WAIT_V(6); PG8_BAR;
    }
    for (;;) {
        const bool has_next = S.next(ui + 1, nxt);
        const char* nA = has_next ? (const char*)g.A + (size_t)nxt.pm * tstep : cA; const char* nB = has_next ? (const char*)g.Bt + (size_t)nxt.pn * tstep : cB;
        for (int t = 0; t < nt; t += 2) {
            const bool last = (t == nt - 2);
            const char* a1 = cA + (size_t)(t + 1) * kstep;
            const char* a2 = last ? nA : cA + (size_t)(t + 2) * kstep; const char* b2 = last ? nB : cB + (size_t)(t + 2) * kstep;
            const char* a3 = a2 + kstep; const char* b3 = b2 + kstep;
            if (last && has_next) S.a_ready(nxt);
            if constexpr (SP2) {
            PG8_LDB(B0, 0, 0); PG8_LDB(B1, 0, 1); PG8_SCHED; PG8_LDA(At, 0, 0); PG8_STAGE(PG8_SA(1, 1), a1 + hstep, voffA);
            PG8_WAIT_V(8); PG8_WAIT_L(0); PG8_BAR; PG8_MMA(0, 0, At, B0); PG8_MMA(0, 1, At, B1); PG8_BAR; PG8_SCHED;
            PG8_LDA(At, 0, 1); PG8_STAGE(PG8_SB(0, 0), b2, voffB); PG8_STAGE(PG8_SB(0, 1), b2 + hstep, voffB); PG8_STAGE(PG8_SA(0, 0), a2, voffA);
            PG8_WAIT_V(8); PG8_WAIT_L(0); PG8_BAR; PG8_MMA(1, 0, At, B0); PG8_MMA(1, 1, At, B1); PG8_BAR; PG8_SCHED;
            PG8_LDB(B0, 1, 0); PG8_LDB(B1, 1, 1); PG8_SCHED; PG8_LDA(At, 1, 0); PG8_STAGE(PG8_SA(0, 1), a2 + hstep, voffA);
            PG8_WAIT_V(8); PG8_WAIT_L(0); PG8_BAR; PG8_MMA(0, 0, At, B0); PG8_MMA(0, 1, At, B1); PG8_BAR; PG8_SCHED;
            PG8_LDA(At, 1, 1); PG8_STAGE(PG8_SB(1, 0), b3, voffB); PG8_STAGE(PG8_SB(1, 1), b3 + hstep, voffB); PG8_STAGE(PG8_SA(1, 0), a3, voffA);
            PG8_WAIT_V(8); PG8_WAIT_L(0); PG8_BAR; PG8_MMA(1, 0, At, B0); PG8_MMA(1, 1, At, B1); PG8_BAR; PG8_SCHED;
            } else {
            PG8_LDB(B0, 0, 0); PG8_SCHED; PG8_LDA(At, 0, 0); PG8_STAGE(PG8_SA(1, 1), a1 + hstep, voffA);
            PG8_WAIT_L(8); PG8_BAR; PG8_WAIT_L(0); PG8_MMA(0, 0, At, B0); PG8_BAR; PG8_SCHED;
            PG8_LDB(B1, 0, 1); PG8_STAGE(PG8_SB(0, 0), b2, voffB);
            PG8_BAR; PG8_WAIT_L(0); PG8_MMA(0, 1, At, B1); PG8_BAR;
            PG8_LDA(At, 0, 1); PG8_STAGE(PG8_SA(0, 0), a2, voffA);
            PG8_BAR; PG8_WAIT_L(0); PG8_MMA(1, 0, At, B0); PG8_BAR; PG8_SCHED;
            PG8_STAGE(PG8_SB(0, 1), b2 + hstep, voffB);
            PG8_WAIT_V(6); PG8_BAR; PG8_MMA(1, 1, At, B1); PG8_BAR;
            PG8_LDB(B0, 1, 0); PG8_SCHED; PG8_LDA(At, 1, 0); PG8_STAGE(PG8_SA(0, 1), a2 + hstep, voffA);
            PG8_WAIT_L(8); PG8_BAR; PG8_WAIT_L(0); PG8_MMA(0, 0, At, B0); PG8_BAR; PG8_SCHED;
            PG8_LDB(B1, 1, 1); PG8_STAGE(PG8_SB(1, 0), b3, voffB);
            PG8_BAR; PG8_WAIT_L(0); PG8_MMA(0, 1, At, B1); PG8_BAR;
            PG8_LDA(At, 1, 1); PG8_STAGE(PG8_SA(1, 0), a3, voffA);
            PG8_BAR; PG8_WAIT_L(0); PG8_MMA(1, 0, At, B0); PG8_BAR; PG8_SCHED;
            PG8_STAGE(PG8_SB(1, 1), b3 + hstep, voffB);
            PG8_WAIT_V(6); PG8_BAR; PG8_MMA(1, 1, At, B1); PG8_BAR;
            }
        }
        if constexpr (ALIGN_EPI) { if (wr == 0) PG8_BAR; }
        if constexpr (!Epi::AFTER_DRAIN) { E(acc, cur, wr, wc, fr, fq); S.done(cur); }
        if (!has_next) break;
#pragma unroll
        for (int a = 0; a < 2; ++a)
#pragma unroll
            for (int b = 0; b < 2; ++b)
#pragma unroll
                for (int m = 0; m < 4; ++m)
#pragma unroll
                    for (int n = 0; n < 2; ++n) acc[a][b][m][n] = (f32x4){0.f, 0.f, 0.f, 0.f};
        cur = nxt; cA = nA; cB = nB; ++ui;
        if constexpr (ALIGN_EPI) { if (wr == 1) PG8_BAR; }
    }
    PG8_WAIT_V(0);
    if constexpr (!ALIGN_EPI) { if (wr == 0) PG8_BAR; }
    PG8_BAR;
    if constexpr (Epi::AFTER_DRAIN) { E.fused(acc, cur, wr, wc, fr, fq, lds, wid, lane); S.done(cur); }
#undef PG8_SA
#undef PG8_SB
#undef PG8_STAGE
#undef PG8_LDA
#undef PG8_LDB
#undef PG8_MMA
#undef PG8_WAIT_V
#undef PG8_WAIT_L
#undef PG8_BAR
#undef PG8_SCHED
}
}

namespace att {
typedef unsigned short bf16_t;
using bf16x8 = __attribute__((ext_vector_type(8))) short;
using s16x4  = __attribute__((ext_vector_type(4))) short;
using f32x16 = __attribute__((ext_vector_type(16))) float;
using u32x4  = __attribute__((ext_vector_type(4))) unsigned;
constexpr int NW = 8, QBLK = 32, KVBLK = 64, LD = 1024;
constexpr int SHM_V = KVBLK * 128 * 2, SHM_K = KVBLK * 64 * 2;
constexpr int NSLOT = 3;
constexpr int OFF_V = 0, OFF_K = NSLOT * SHM_V, OFF_WS = OFF_K + NSLOT * SHM_K, OFF_UNIT = OFF_WS + NW * 64 * 4, LDS_BYTES = OFF_UNIT + 128;
constexpr int SDEPTH = 1;
constexpr float THR2 = 16.f;
#define KSWZ(row, colB) ((row) * 128 + ((colB) ^ ((((row) >> 1) & 7) << 4)))
#define SBAR() __builtin_amdgcn_sched_barrier(0)
#define SGB_MFMA_VALU(N, V) do { _Pragma("unroll") for (int _g = 0; _g < (N); ++_g) { __builtin_amdgcn_sched_group_barrier(0x008, 1, 0); __builtin_amdgcn_sched_group_barrier(0x400, (V), 0); } } while (0)
__device__ __forceinline__ int crow(int r, int hi) { return (r & 3) + 8 * (r >> 2) + 4 * hi; }
__device__ __forceinline__ unsigned cvtpk(float lo, float hi) { unsigned r; asm volatile("v_cvt_pk_bf16_f32 %0, %1, %2" : "=v"(r) : "v"(lo), "v"(hi)); return r; }

__device__ __forceinline__ void split3(float a, unsigned& h, unsigned& l, unsigned& ll) {
  h = cvtpk(a, 0.f) & 0xffffu; const float r1 = a - __uint_as_float(h << 16);
  l = cvtpk(r1, 0.f) & 0xffffu; const float r2 = r1 - __uint_as_float(l << 16);
  ll = cvtpk(r2, 0.f) & 0xffffu;
}
__device__ __forceinline__ void tile_ctl(int rel, float dq, float m_reg, float nc2, float smax, int hi, bf16x8& qx, int& mode, bool& skip) {
  mode = (rel <= -64) ? 1 : (rel >= 32) ? 2 : 0;
  const float dmin = (mode == 1) ? (float)(-rel - 63) : (float)(rel - 31);
  skip = (mode != 0) && (smax + nc2 * dmin <= THR2);
  const float A = (mode == 1 ? nc2 * dq : -nc2 * dq) - m_reg;
  unsigned ah, al, all_; split3(A, ah, al, all_);
  const unsigned sg = (mode == 1) ? 0x3F80u : 0xBF80u;
  u32x4 w = {ah | (al << 16), all_ | (sg << 16), sg | (sg << 16), 0u};
  if (hi != 0 || mode == 0) w = u32x4{0u, 0u, 0u, 0u};
  qx = *reinterpret_cast<bf16x8*>(&w);
}
__device__ __forceinline__ void partialSM(f32x16& p0, f32x16& p1, float& m_reg, float& alpha, int mode, bool skip, float dqh, float nc2) {
  if (mode == 0) {
    const float dq1 = dqh - 32.f;
#pragma unroll
    for (int r = 0; r < 16; ++r) p0[r] = fmaf(__builtin_fabsf(dqh - (float)((r & 3) + 8 * (r >> 2))), nc2, p0[r]) - m_reg;
#pragma unroll
    for (int r = 0; r < 16; ++r) p1[r] = fmaf(__builtin_fabsf(dq1 - (float)((r & 3) + 8 * (r >> 2))), nc2, p1[r]) - m_reg;
  }
  alpha = 1.f;
  if (!skip) {
    float pmax = p0[0];
#pragma unroll
    for (int r = 1; r < 16; ++r) pmax = fmaxf(pmax, p0[r]);
#pragma unroll
    for (int r = 0; r < 16; ++r) pmax = fmaxf(pmax, p1[r]);
    { auto rr = __builtin_amdgcn_permlane32_swap(__float_as_uint(pmax), __float_as_uint(pmax), false, false);
      pmax = fmaxf(__uint_as_float(rr[0]), __uint_as_float(rr[1])); }
    if (__builtin_expect(!__all(pmax <= THR2), 0)) {
      const float dl = fmaxf(pmax, 0.f); m_reg += dl; alpha = __builtin_amdgcn_exp2f(-dl);
#pragma unroll
      for (int r = 0; r < 16; ++r) p0[r] -= dl;
#pragma unroll
      for (int r = 0; r < 16; ++r) p1[r] -= dl;
    }
  }
}
__device__ __forceinline__ void expP0(f32x16& p0) {
#pragma unroll
  for (int r = 0; r < 16; ++r) p0[r] = __builtin_amdgcn_exp2f(p0[r]);
}
__device__ __forceinline__ void finishSM(f32x16& p0, f32x16& p1, float alpha, float& l_reg, bf16x8& pa0, bf16x8& pa1, bf16x8& pa2, bf16x8& pa3) {
#pragma unroll
  for (int r = 0; r < 16; ++r) p1[r] = __builtin_amdgcn_exp2f(p1[r]);
  float ps = 0;
#pragma unroll
  for (int r = 0; r < 16; ++r) ps += p0[r];
#pragma unroll
  for (int r = 0; r < 16; ++r) ps += p1[r];
  { auto rr = __builtin_amdgcn_permlane32_swap(__float_as_uint(ps), __float_as_uint(ps), false, false);
    ps = __uint_as_float(rr[0]) + __uint_as_float(rr[1]); }
  l_reg = l_reg * alpha + ps;
#define PK4(P, BASE, OUT) do { unsigned a0 = cvtpk(P[BASE + 0], P[BASE + 1]), a1 = cvtpk(P[BASE + 2], P[BASE + 3]);   \
    unsigned b0 = cvtpk(P[BASE + 4], P[BASE + 5]), b1 = cvtpk(P[BASE + 6], P[BASE + 7]);                              \
    auto r0 = __builtin_amdgcn_permlane32_swap(a0, b0, false, false); auto r1 = __builtin_amdgcn_permlane32_swap(a1, b1, false, false); \
    u32x4 w = {r0[0], r1[0], r0[1], r1[1]}; OUT = *reinterpret_cast<bf16x8*>(&w); } while (0)
  PK4(p0, 0, pa0); PK4(p0, 8, pa1); PK4(p1, 0, pa2); PK4(p1, 8, pa3);
#undef PK4
}
__device__ __forceinline__ void qkt(f32x16& p0, f32x16& p1, const char* Ks, const bf16x8* qr, int r32, int hi, bf16x8 kx0, bf16x8 kx1, bf16x8 qx) {
  p0 = __builtin_amdgcn_mfma_f32_32x32x16_bf16(kx0, qx, f32x16{}, 0, 0, 0); p1 = __builtin_amdgcn_mfma_f32_32x32x16_bf16(kx1, qx, f32x16{}, 0, 0, 0);
#pragma unroll
  for (int d0 = 0; d0 < 4; ++d0) { const int cb = d0 * 32 + hi * 16;
    bf16x8 b0 = *reinterpret_cast<const bf16x8*>(Ks + KSWZ(r32, cb));
    bf16x8 b1 = *reinterpret_cast<const bf16x8*>(Ks + KSWZ(32 + r32, cb));
    p0 = __builtin_amdgcn_mfma_f32_32x32x16_bf16(b0, qr[d0], p0, 0, 0, 0);
    p1 = __builtin_amdgcn_mfma_f32_32x32x16_bf16(b1, qr[d0], p1, 0, 0, 0); }
}
__device__ __forceinline__ int v_st(int k, int c) { const int kk = (k & ~0xC) | ((k & 4) << 1) | ((k & 8) >> 1); return ((kk >> 3) * 4 + (c >> 5)) * 512 + ((kk & 7) * 32 + (c & 31)) * 2; }
__device__ __forceinline__ int v_rd_base(int lane) { return ((lane & 3) << 3) | (((lane >> 2) & 3) << 6) | (((lane >> 4) & 1) << 5) | (((lane >> 5) & 1) << 8); }
constexpr int v_rd_off(int d0, int ks, int half) { return d0 * 512 + ks * 4096 + half * 2048; }
template <int OFF> __device__ __forceinline__ s16x4 tr_read(int vb) {
  s16x4 r; asm volatile("ds_read_b64_tr_b16 %0, %1 offset:%2" : "=&v"(r) : "v"(vb), "i"(OFF) : "memory"); return r;
}
#define PV_RDK(KS, L, H) do { L[0] = tr_read<v_rd_off(0, KS, 0)>(vb); H[0] = tr_read<v_rd_off(0, KS, 1)>(vb); L[1] = tr_read<v_rd_off(1, KS, 0)>(vb); H[1] = tr_read<v_rd_off(1, KS, 1)>(vb); \
    L[2] = tr_read<v_rd_off(2, KS, 0)>(vb); H[2] = tr_read<v_rd_off(2, KS, 1)>(vb); L[3] = tr_read<v_rd_off(3, KS, 0)>(vb); H[3] = tr_read<v_rd_off(3, KS, 1)>(vb); } while (0)
#define PV_RD2(KS, D0, L, H) do { L[D0] = tr_read<v_rd_off(D0, KS, 0)>(vb); H[D0] = tr_read<v_rd_off(D0, KS, 1)>(vb); } while (0)
#define PV_WAIT(N, L, H) asm volatile("s_waitcnt lgkmcnt(" #N ")" : "+v"(L[0]), "+v"(H[0]), "+v"(L[1]), "+v"(H[1]), "+v"(L[2]), "+v"(H[2]), "+v"(L[3]), "+v"(H[3]))
#define PV_PK(L, H, D0) (bf16x8){L[D0][0], L[D0][1], L[D0][2], L[D0][3], H[D0][0], H[D0][1], H[D0][2], H[D0][3]}
#define PV_MF(D0, PA, L, H, R) do { o[D0] = __builtin_amdgcn_mfma_f32_32x32x16_bf16(PA, PV_PK(L, H, D0), o[D0], 0, 0, 0); \
    if (EXPS) { px[R] = __builtin_amdgcn_exp2f(px[R]); asm volatile("" : "+v"(px)); } SBAR(); } while (0)
template <bool EXPS> __device__ __forceinline__ void pv_d0(f32x16* o, int vb, bf16x8 pa0, bf16x8 pa1, bf16x8 pa2, bf16x8 pa3, f32x16& px) {
  s16x4 la[4], ha[4], lb[4], hb[4];
  SBAR(); PV_RDK(0, la, ha); SBAR();
  PV_RD2(1, 0, lb, hb); PV_WAIT(2, la, ha);  PV_MF(0, pa0, la, ha, 0);
  PV_RD2(1, 1, lb, hb);                       PV_MF(1, pa0, la, ha, 1);
  PV_RD2(1, 2, lb, hb);                       PV_MF(2, pa0, la, ha, 2);
  PV_RD2(1, 3, lb, hb);                       PV_MF(3, pa0, la, ha, 3);
  PV_RD2(2, 0, la, ha); PV_WAIT(2, lb, hb);  PV_MF(0, pa1, lb, hb, 4);
  PV_RD2(2, 1, la, ha);                       PV_MF(1, pa1, lb, hb, 5);
  PV_RD2(2, 2, la, ha);                       PV_MF(2, pa1, lb, hb, 6);
  PV_RD2(2, 3, la, ha);                       PV_MF(3, pa1, lb, hb, 7);
  PV_RD2(3, 0, lb, hb); PV_WAIT(2, la, ha);  PV_MF(0, pa2, la, ha, 8);
  PV_RD2(3, 1, lb, hb);                       PV_MF(1, pa2, la, ha, 9);
  PV_RD2(3, 2, lb, hb);                       PV_MF(2, pa2, la, ha, 10);
  PV_RD2(3, 3, lb, hb);                       PV_MF(3, pa2, la, ha, 11);
                        PV_WAIT(0, lb, hb);  PV_MF(0, pa3, lb, hb, 12);
                                              PV_MF(1, pa3, lb, hb, 13);
                                              PV_MF(2, pa3, lb, hb, 14);
                                              PV_MF(3, pa3, lb, hb, 15);
}

__device__ __forceinline__ void attn_pass(const bf16_t* __restrict__ Qw, const bf16_t* __restrict__ Kh, const bf16_t* __restrict__ Vh,
                                          int NT, float dqbase, int rel0, float nc2, float smax, f32x16 (&o)[4], char* lds) {
  const int tid = mk_tid(), wid = tid >> 6, lane = tid & 63, r32 = lane & 31, hi = lane >> 5;
  char* V_lds = lds + OFF_V; char* K_lds = lds + OFF_K;
  float* ws = (float*)(lds + OFF_WS) + wid * 64; float* li_l = ws; float* al_l = ws + 32;
  float m_reg = 0.f, l_reg = 0; bf16x8 qr[4];
#pragma unroll
  for (int d = 0; d < 4; ++d) o[d] = f32x16{};
#pragma unroll
  for (int d0 = 0; d0 < 4; ++d0) qr[d0] = *reinterpret_cast<const bf16x8*>(Qw + d0 * 16);
  const float dqh0 = dqbase - (float)(4 * hi);
  bf16x8 kx0, kx1;
  { unsigned bh, bl, bll; u32x4 w;
    split3(-nc2 * (float)r32, bh, bl, bll); w = u32x4{0x3F803F80u, 0x3F80u | (bh << 16), bl | (bll << 16), 0u}; if (hi) w = u32x4{0u, 0u, 0u, 0u}; kx0 = *reinterpret_cast<bf16x8*>(&w);
    split3(-nc2 * (float)(32 + r32), bh, bl, bll); w = u32x4{0x3F803F80u, 0x3F80u | (bh << 16), bl | (bll << 16), 0u}; if (hi) w = u32x4{0u, 0u, 0u, 0u}; kx1 = *reinterpret_cast<bf16x8*>(&w); }
  bf16x8 qx; int mdA, mdB; bool skA, skB;
#define CTL(j, MD, SK) tile_ctl(rel0 + (j) * KVBLK, dqbase - (float)((j) * KVBLK), m_reg, nc2, smax, hi, qx, MD, SK)
  const int sr = tid >> 4, sc = (tid & 15) * 8, vst0 = v_st(sr, sc), vst1 = v_st(32 + sr, sc);
  const int krow = tid >> 3, kcol = (tid & 7) * 8, kst = KSWZ(krow, kcol * 2);
  const int vb0 = (int)(uintptr_t)V_lds + v_rd_base(lane);
  struct { bf16x8 vs0, vs1, ks0; } sg;
#define SLOAD(k0) do { sg.vs0 = *reinterpret_cast<const bf16x8*>(&Vh[(long)((k0) + sr) * LD + sc]); sg.vs1 = *reinterpret_cast<const bf16x8*>(&Vh[(long)((k0) + 32 + sr) * LD + sc]); \
    sg.ks0 = *reinterpret_cast<const bf16x8*>(&Kh[(long)((k0) + krow) * LD + kcol]); } while (0)
#define SWRITE(b) do { *(bf16x8*)(V_lds + (b) * SHM_V + vst0) = sg.vs0; *(bf16x8*)(V_lds + (b) * SHM_V + vst1) = sg.vs1; *(bf16x8*)(K_lds + (b) * SHM_K + kst) = sg.ks0; } while (0)
#define SWAIT() asm volatile("s_waitcnt vmcnt(0)" ::: "memory")
#define RESC(a) do { if (__any((a) < 1.f)) { if (hi == 0) al_l[r32] = (a); asm volatile("s_waitcnt lgkmcnt(0)" ::: "memory"); \
    _Pragma("unroll") for (int d = 0; d < 4; ++d) _Pragma("unroll") for (int r = 0; r < 16; ++r) o[d][r] *= al_l[crow(r, hi)]; } } while (0)
  f32x16 pA0, pA1, pB0, pB1; float alA, alB; bf16x8 pa0, pa1, pa2, pa3;
  int b_prev = 0, b_cur = 1, b_next = 2;
#define ROT() do { const int t_ = b_prev; b_prev = b_cur; b_cur = b_next; b_next = t_; } while (0)
#define STEP(j, X0, X1, Y0, Y1, MDX, SKX, ALX, ALY, WR, LD_) do { SBAR(); \
    if (WR) { SWAIT(); SWRITE(b_next); } if (LD_) SLOAD(((j) + 2) * KVBLK); SBAR(); \
    CTL(j, MDX, SKX); qkt(X0, X1, K_lds + b_cur * SHM_K, qr, r32, hi, kx0, kx1, qx); \
    finishSM(Y0, Y1, ALY, l_reg, pa0, pa1, pa2, pa3); SBAR(); \
    partialSM(X0, X1, m_reg, ALX, MDX, SKX, dqh0 - (float)((j) * KVBLK), nc2); SBAR(); \
    pv_d0<true>(o, vb0 + b_prev * SHM_V, pa0, pa1, pa2, pa3, X0); \
    RESC(ALX); __syncthreads(); } while (0)
  __syncthreads();
  SLOAD(0); SWAIT(); SWRITE(0); SLOAD(KVBLK); __syncthreads();
  SWAIT(); SWRITE(1); if (2 < NT) SLOAD(2 * KVBLK);
  CTL(0, mdA, skA); qkt(pA0, pA1, K_lds, qr, r32, hi, kx0, kx1, qx); partialSM(pA0, pA1, m_reg, alA, mdA, skA, dqh0, nc2); expP0(pA0);
  __syncthreads();
  for (int j = 1; j + 1 < NT; j += 2) {
    STEP(j, pB0, pB1, pA0, pA1, mdB, skB, alB, alA, true, true); ROT();
    STEP(j + 1, pA0, pA1, pB0, pB1, mdA, skA, alA, alB, true, (j + 3 < NT)); ROT();
  }
  STEP(NT - 1, pB0, pB1, pA0, pA1, mdB, skB, alB, alA, false, false); ROT();
  finishSM(pB0, pB1, alB, l_reg, pa0, pa1, pa2, pa3); SBAR();
  pv_d0<false>(o, vb0 + b_prev * SHM_V, pa0, pa1, pa2, pa3, pB0);
  if (hi == 0) li_l[r32] = l_reg; asm volatile("s_waitcnt lgkmcnt(0)" ::: "memory");
#pragma unroll
  for (int r = 0; r < 16; ++r) { const float rli = __builtin_amdgcn_rcpf(li_l[crow(r, hi)]);
#pragma unroll
    for (int d0 = 0; d0 < 4; ++d0) o[d0][r] *= rli; }
#undef CTL
#undef STEP
#undef ROT
#undef SLOAD
#undef SWRITE
#undef SWAIT
#undef RESC
}
}

typedef unsigned short bf16;
typedef unsigned v4u __attribute__((ext_vector_type(4)));
typedef unsigned v2u __attribute__((ext_vector_type(2)));
typedef float f32x4 __attribute__((ext_vector_type(4)));
#define LAS __attribute__((address_space(3)))
constexpr int NWAVES = 8, NTHREADS = 512;
constexpr int D = 1024, FF = 4096, MG = 16384, MTOT = 32768;
constexpr int DEPTH = 4;
constexpr float QSCALE = 0.125f * 1.4426950408889634f;
constexpr size_t MiB = 1u << 20;
constexpr size_t WS_CTL = 0, WS_ZERO_END = 64 * 1024;
constexpr size_t WS_WMI = 2 * MiB, WS_WMO = 10 * MiB, WS_WQKV = 14 * MiB, WS_WAO = 26 * MiB, WS_W1 = 30 * MiB, WS_W2 = 62 * MiB;
constexpr size_t WS_XB = 94 * MiB, WS_BIG = 126 * MiB, WS_ROWSQ = 254 * MiB, WS_END = WS_ROWSQ + 9 * (size_t)MG * 64;
static_assert(WS_ZERO_END <= WS_WMI, "ws map");
constexpr int CW_ATTCTR = 0;
constexpr int CW_ARR = 8192;
constexpr int CW_BAR = 4096;
constexpr int CW_NRM = 1024;

struct Args {
    const float* in[19]; float* out; unsigned char* ws; int ph_lo, ph_hi;
};

__device__ __forceinline__ unsigned f2bf(float f) { unsigned u = __builtin_bit_cast(unsigned, f); return (u + 0x7fffu + ((u >> 16) & 1u)) >> 16; }
__device__ __forceinline__ unsigned pk2(float lo, float hi) { return f2bf(lo) | (f2bf(hi) << 16); }
__device__ __forceinline__ float bflo(unsigned w) { return __uint_as_float(w << 16); }
__device__ __forceinline__ float bfhi(unsigned w) { return __uint_as_float(w & 0xffff0000u); }
__device__ __forceinline__ float wave_sum(float v) {
    v += xor_lt32<1>(v); v += xor_lt32<2>(v); v += xor_lt32<4>(v); v += xor_lt32<8>(v); v += xor_lt32<16>(v);
    return sum_x32(v);
}

__device__ __forceinline__ void transpose_item(const float* W, int ldw, int N, const float* gs, bf16* WT, int ldk, int koff, LAS float* scr, int item, int lane) {
    const int nblk = N / 32, kb = item / nblk, nb = item % nblk, k0 = 64 * kb, n0 = 32 * nb;
#pragma unroll
    for (int i = 0; i < 8; ++i) { const int kk = 8 * i + (lane >> 3), c4 = (lane & 7) * 4;
        f32x4 v = *(const f32x4*)(W + (size_t)(k0 + kk) * ldw + n0 + c4); if (gs) v = v * gs[k0 + kk];
        scr[kk * 33 + c4] = v[0]; scr[kk * 33 + c4 + 1] = v[1]; scr[kk * 33 + c4 + 2] = v[2]; scr[kk * 33 + c4 + 3] = v[3]; }
    asm volatile("s_waitcnt lgkmcnt(0)" ::: "memory");
    const int c = lane & 7;
#pragma unroll
    for (int j = 0; j < 4; ++j) { const int n = (lane >> 3) + 8 * j; const LAS float* s = scr + (8 * c) * 33 + n;
        v4u o; o.x = pk2(s[0 * 33], s[1 * 33]); o.y = pk2(s[2 * 33], s[3 * 33]); o.z = pk2(s[4 * 33], s[5 * 33]); o.w = pk2(s[6 * 33], s[7 * 33]);
        *(v4u*)(WT + (size_t)(n0 + n) * ldk + koff + k0 + 8 * c) = o; }
    asm volatile("s_waitcnt lgkmcnt(0)" ::: "memory");
}

__device__ __forceinline__ void phase_prologue(const Args& a, LAS unsigned char* lds) {
    const int tid = mk_tid(), lane = tid & 63, wave = tid >> 6;
    const int gt = blockIdx.x * NTHREADS + tid, NGT = gridDim.x * NTHREADS;
    const int gw = blockIdx.x * NWAVES + wave, NGW = gridDim.x * NWAVES;
    { v4u z = {0u, 0u, 0u, 0u}; v4u* p = (v4u*)(a.ws + WS_CTL); for (int i = gt; i < (int)(WS_ZERO_END / 16); i += NGT) p[i] = z; }
    LAS float* scr = (LAS float*)(lds + wave * 16384);
    const float* norm1_g = a.in[2]; const float* norm2_g = a.in[3];
    constexpr int I_MI = 16 * 64, I_MO = 8 * 32, I_QKV = 16 * 96, I_AO = 16 * 32, I_W1 = 16 * 128, I_W2 = 64 * 32;
    constexpr int T_MI = 2 * I_MI, T_MO = T_MI + 2 * I_MO, T_QKV = T_MO + 2 * I_QKV, T_AO = T_QKV + 2 * I_AO, T_W1 = T_AO + 4 * I_W1, T_W2 = T_W1 + 4 * I_W2;
    for (int it = gw; it < T_W2; it += NGW) {
        if (it < T_MI) { const int j = it / I_MI, r = it % I_MI;
            transpose_item(a.in[5] + (size_t)j * D * 2048, 2048, 2048, norm1_g + (2 * j) * D, (bf16*)(a.ws + WS_WMI) + (size_t)j * 2048 * D, D, 0, scr, r, lane); }
        else if (it < T_MO) { const int q = it - T_MI, j = q / I_MO, r = q % I_MO;
            transpose_item(a.in[9] + (size_t)j * D * D + (size_t)512 * D, D, D, nullptr, (bf16*)(a.ws + WS_WMO) + (size_t)j * D * D, D, 512, scr, r, lane); }
        else if (it < T_QKV) { const int q = it - T_MO, j = q / I_QKV, r = q % I_QKV;
            transpose_item(a.in[10] + (size_t)j * D * 3072, 3072, 3072, norm1_g + (2 * j + 1) * D, (bf16*)(a.ws + WS_WQKV) + (size_t)j * 3072 * D, D, 0, scr, r, lane); }
        else if (it < T_AO) { const int q = it - T_QKV, j = q / I_AO, r = q % I_AO;
            transpose_item(a.in[11] + (size_t)j * D * D, D, D, nullptr, (bf16*)(a.ws + WS_WAO) + (size_t)j * D * D, D, 0, scr, r, lane); }
        else if (it < T_W1) { const int q = it - T_AO, i = q / I_W1, r = q % I_W1;
            transpose_item(a.in[17] + (size_t)i * D * FF, FF, FF, norm2_g + i * D, (bf16*)(a.ws + WS_W1) + (size_t)i * FF * D, D, 0, scr, r, lane); }
        else { const int q = it - T_W1, i = q / I_W2, r = q % I_W2;
            transpose_item(a.in[18] + (size_t)i * FF * D, D, D, nullptr, (bf16*)(a.ws + WS_W2) + (size_t)i * D * FF, FF, 0, scr, r, lane); }
    }
    for (int it = gw; it < 2 * 4 * 16 * 16; it += NGW) {
        const int cb = it & 15, nb = (it >> 4) & 15, g = (it >> 8) & 3, j = it >> 10;
        const float* pw = a.in[6] + ((size_t)(j * 4 + g) * 128 + cb * 8) * 128;
        const float* ps = a.in[7] + j * 512 + g * 128;
        const float* mo = a.in[9] + (size_t)j * D * D + (size_t)(g * 128) * D + nb * 64 + lane;
        float acc[8];
#pragma unroll
        for (int c = 0; c < 8; ++c) acc[c] = 0.f;
#pragma unroll 8
        for (int d = 0; d < 128; ++d) {
            const float m = mo[(size_t)d * D] * ps[d];
#pragma unroll
            for (int c = 0; c < 8; ++c) acc[c] = fmaf(pw[c * 128 + d], m, acc[c]);
        }
        v4u o; o.x = pk2(acc[0], acc[1]); o.y = pk2(acc[2], acc[3]); o.z = pk2(acc[4], acc[5]); o.w = pk2(acc[6], acc[7]);
        *(v4u*)((bf16*)(a.ws + WS_WMO) + (size_t)j * D * D + (size_t)(nb * 64 + lane) * D + g * 128 + cb * 8) = o;
    }
}

__device__ __forceinline__ void phase_prep(const Args& a, int g) {
    const int tid = mk_tid(), lane = tid & 63, gw = blockIdx.x * NWAVES + (tid >> 6), NGW = gridDim.x * NWAVES;
    const float* xin = g ? a.in[1] : a.in[0]; float* xo = a.out + (size_t)g * MG * D; bf16* xb = (bf16*)(a.ws + WS_XB); float* rsq = (float*)(a.ws + WS_ROWSQ);
    for (int m = gw; m < MG; m += NGW) {
        const f32x4* xr = (const f32x4*)(xin + (size_t)m * D) + lane; f32x4* orow = (f32x4*)(xo + (size_t)m * D) + lane; v2u* brow = (v2u*)(xb + (size_t)m * D) + lane;
        float s = 0.f;
#pragma unroll
        for (int j = 0; j < 4; ++j) { const f32x4 v = xr[64 * j]; orow[64 * j] = v; s += (v[0] * v[0] + v[1] * v[1]) + (v[2] * v[2] + v[3] * v[3]);
            v2u w; w.x = pk2(v[0], v[1]); w.y = pk2(v[2], v[3]); brow[64 * j] = w; }
        s = wave_sum(s);
        if (lane < 16) rsq[(size_t)m * 16 + lane] = lane == 0 ? s : 0.f;
    }
}
__device__ __forceinline__ void phase_final(const Args& a, int g) {
    const int tid = mk_tid(), lane = tid & 63, gw = blockIdx.x * NWAVES + (tid >> 6), NGW = gridDim.x * NWAVES;
    float* xo = a.out + (size_t)g * MG * D; const float* rsq = (const float*)(a.ws + WS_ROWSQ) + (size_t)8 * MG * 16; const f32x4* fg = (const f32x4*)a.in[4] + lane;
    for (int m = gw; m < MG; m += NGW) {
        float rsum;
        { const f32x4* rp = (const f32x4*)(rsq + (size_t)m * 16); const f32x4 a0 = rp[0], a1 = rp[1], a2 = rp[2], a3 = rp[3];
          rsum = (((a0[0] + a0[1]) + (a0[2] + a0[3])) + ((a1[0] + a1[1]) + (a1[2] + a1[3]))) + (((a2[0] + a2[1]) + (a2[2] + a2[3])) + ((a3[0] + a3[1]) + (a3[2] + a3[3]))); }
        const float rs = __builtin_amdgcn_rsqf(rsum * (1.0f / 1024.0f) + 1e-6f);
        f32x4* orow = (f32x4*)(xo + (size_t)m * D) + lane;
#pragma unroll
        for (int j = 0; j < 4; ++j) { f32x4 v = orow[64 * j]; const f32x4 gg = fg[64 * j]; v = v * rs * gg; orow[64 * j] = v; }
    }
}

__device__ __forceinline__ void unpack8(const v4u w, float (&f)[8]) {
    f[0] = bflo(w.x); f[1] = bfhi(w.x); f[2] = bflo(w.y); f[3] = bfhi(w.y); f[4] = bflo(w.z); f[5] = bfhi(w.z); f[6] = bflo(w.w); f[7] = bfhi(w.w);
}
__device__ __forceinline__ void phase_stencil(const Args& a, int g, int j) {
    const int S = g ? 16384 : 8192;
    const bf16* P = (const bf16*)(a.ws + WS_BIG); bf16* A2 = (bf16*)(a.ws + WS_BIG + 64 * MiB);
    const int tid = mk_tid(), chunk = tid & 127, tb = tid >> 7;
    for (int tile = blockIdx.x; tile < MG / 64; tile += gridDim.x) {
        const int row0 = tile * 64 + tb * 16;
        const int b0 = row0 & ~(S - 1), t0 = row0 & (S - 1);
        if (chunk < 64) {
            const int c0 = chunk * 8, hw = 1 << (chunk >> 4);
            const bf16* U = P + (size_t)b0 * 2048 + c0;
            float sum[8];
#pragma unroll
            for (int e = 0; e < 8; ++e) sum[e] = 0.f;
            { const int lo = max(t0 - hw, 0), hi = min(t0 + hw, S);
              for (int t = lo; t < hi; ++t) { float f[8]; unpack8(*(const v4u*)(U + (size_t)t * 2048), f);
#pragma unroll
                  for (int e = 0; e < 8; ++e) sum[e] += f[e]; } }
            for (int i = 0; i < 16; ++i) {
                const int t = t0 + i; const int lo = max(t - hw, 0), hi = min(t + hw, S);
                const float rc = 1.0f / (float)(hi - lo);
                float f[8]; unpack8(*(const v4u*)(U + (size_t)t * 2048), f);
                v4u o; o.x = pk2(sum[0] * rc - f[0], sum[1] * rc - f[1]); o.y = pk2(sum[2] * rc - f[2], sum[3] * rc - f[3]);
                o.z = pk2(sum[4] * rc - f[4], sum[5] * rc - f[5]); o.w = pk2(sum[6] * rc - f[6], sum[7] * rc - f[7]);
                *(v4u*)(A2 + (size_t)(b0 + t) * 1024 + c0) = o;
                if (t + hw < S) { float n[8]; unpack8(*(const v4u*)(U + (size_t)(t + hw) * 2048), n);
#pragma unroll
                    for (int e = 0; e < 8; ++e) sum[e] += n[e]; }
                if (t - hw >= 0) { float n[8]; unpack8(*(const v4u*)(U + (size_t)(t - hw) * 2048), n);
#pragma unroll
                    for (int e = 0; e < 8; ++e) sum[e] -= n[e]; }
            }
        } else {
            const int c0 = (chunk - 64) * 8;
            const bf16* Hc = P + (size_t)b0 * 2048 + 512 + c0; const bf16* Gb = Hc + 512; const bf16* Gc = Hc + 1024;
            const float* cw = a.in[8] + (size_t)j * 3 * 512 + c0;
            float w0[8], w1[8], w2[8];
#pragma unroll
            for (int e = 0; e < 8; ++e) { w0[e] = cw[e]; w1[e] = cw[512 + e]; w2[e] = cw[1024 + e]; }
            float zp[8], zc[8];
            if (t0 > 0) { float hh[8], cc[8]; unpack8(*(const v4u*)(Hc + (size_t)(t0 - 1) * 2048), hh); unpack8(*(const v4u*)(Gc + (size_t)(t0 - 1) * 2048), cc);
#pragma unroll
                for (int e = 0; e < 8; ++e) zp[e] = hh[e] * cc[e]; }
            else {
#pragma unroll
                for (int e = 0; e < 8; ++e) zp[e] = 0.f; }
            { float hh[8], cc[8]; unpack8(*(const v4u*)(Hc + (size_t)t0 * 2048), hh); unpack8(*(const v4u*)(Gc + (size_t)t0 * 2048), cc);
#pragma unroll
              for (int e = 0; e < 8; ++e) zc[e] = hh[e] * cc[e]; }
            for (int i = 0; i < 16; ++i) {
                const int t = t0 + i; float zn[8];
                if (t + 1 < S) { float hh[8], cc[8]; unpack8(*(const v4u*)(Hc + (size_t)(t + 1) * 2048), hh); unpack8(*(const v4u*)(Gc + (size_t)(t + 1) * 2048), cc);
#pragma unroll
                    for (int e = 0; e < 8; ++e) zn[e] = hh[e] * cc[e]; }
                else {
#pragma unroll
                    for (int e = 0; e < 8; ++e) zn[e] = 0.f; }
                float gb[8], r[8]; unpack8(*(const v4u*)(Gb + (size_t)t * 2048), gb);
#pragma unroll
                for (int e = 0; e < 8; ++e) r[e] = gb[e] * (w0[e] * zp[e] + w1[e] * zc[e] + w2[e] * zn[e]);
                v4u o; o.x = pk2(r[0], r[1]); o.y = pk2(r[2], r[3]); o.z = pk2(r[4], r[5]); o.w = pk2(r[6], r[7]);
                *(v4u*)(A2 + (size_t)(b0 + t) * 1024 + 512 + c0) = o;
#pragma unroll
                for (int e = 0; e < 8; ++e) { zp[e] = zc[e]; zc[e] = zn[e]; }
            }
        }
    }
}

__device__ __forceinline__ void phase_attention(const Args& a, int g, int layer, char* lds) {
    using namespace att;
    const int S = g ? 16384 : 8192, logS = g ? 14 : 13; const int j = layer >> 1;
    const bf16* Qb = (const bf16*)(a.ws + WS_BIG); const bf16* Kb = Qb + (size_t)MG * 1024; const bf16* Vb = Kb + (size_t)MG * 1024; bf16* Ob = (bf16*)(a.ws + WS_BIG);
    unsigned* ctr = (unsigned*)(a.ws + WS_CTL) + CW_ATTCTR + 64 * (g * 2 + j);
    unsigned* arr = (unsigned*)(a.ws + WS_CTL) + CW_ARR + 1024 * (g * 2 + j);
    const unsigned* nrm = (const unsigned*)(a.ws + WS_CTL) + CW_NRM + 256 * (g * 2 + j);
    volatile unsigned* s_unit = (volatile unsigned*)(lds + OFF_UNIT);
    const float lambda_init = (layer == 1) ? 0.35550906759096926f : 0.5560582041556405f;
    float lam;
    { const float* q1 = a.in[12] + j * 64; const float* k1 = a.in[13] + j * 64; const float* q2 = a.in[14] + j * 64; const float* k2 = a.in[15] + j * 64;
      const int lane = mk_tid() & 63; float s1 = q1[lane] * k1[lane], s2 = q2[lane] * k2[lane]; s1 = wave_sum(s1); s2 = wave_sum(s2); lam = __expf(s1) - __expf(s2) + lambda_init; }
    const float* subg = a.in[16] + j * 128;
    for (;;) {
        const int tid = mk_tid(), wid = tid >> 6, lane = tid & 63, r32 = lane & 31, hi = lane >> 5;
        __syncthreads();
        if (tid == 0) s_unit[0] = atomicAdd(ctr, 1u);
        __syncthreads();
        const int tk = (int)s_unit[0];
        if (tk >= 1024 * MK_DUP_ATT) break;
        const int u = tk / MK_DUP_ATT; const bool dup = (tk % MK_DUP_ATT) != 0;
        const int h = 7 - (u >> 7), qbi = (u >> 1) & 63, pass = u & 1, uid = u >> 1;
        const int b = (qbi * 256) >> logS, q0 = (qbi * 256) & (S - 1);
        const size_t rowbase = (size_t)b * S;
        const float slope2 = __builtin_amdgcn_exp2f(-(float)(h + 1)) * 1.4426950408889634f;
        const int qpos = q0 + wid * QBLK + r32;
        f32x16 o[4];
        {
            const int map = 2 * h + pass;
            int klo = 0, khi = S; float smax;
            { const unsigned* nq = nrm + ((0 * 2 + b) * 16 + map) * 2; const unsigned* nk = nrm + ((1 * 2 + b) * 16 + map) * 2;
              const float qn2 = __uint_as_float(__hip_atomic_load(nq, __ATOMIC_RELAXED, __HIP_MEMORY_SCOPE_AGENT)) + __uint_as_float(__hip_atomic_load(nq + 1, __ATOMIC_RELAXED, __HIP_MEMORY_SCOPE_AGENT));
              const float kn2 = __uint_as_float(__hip_atomic_load(nk, __ATOMIC_RELAXED, __HIP_MEMORY_SCOPE_AGENT)) + __uint_as_float(__hip_atomic_load(nk + 1, __ATOMIC_RELAXED, __HIP_MEMORY_SCOPE_AGENT));
              smax = sqrtf(qn2 * kn2) * 1.02f;
#if MK_WINDOW
              float sown;
              { const bf16* qp = Qb + (rowbase + q0 + wid * QBLK + r32) * 1024 + map * 64 + hi * 32; const bf16* kp = Kb + (rowbase + q0 + wid * QBLK + r32) * 1024 + map * 64 + hi * 32;
                float acc = 0.f, qq = 0.f;
#pragma unroll
                for (int c = 0; c < 4; ++c) { const v4u qa = *(const v4u*)(qp + c * 8), ka = *(const v4u*)(kp + c * 8);
                    acc += bflo(qa.x) * bflo(ka.x) + bfhi(qa.x) * bfhi(ka.x) + bflo(qa.y) * bflo(ka.y) + bfhi(qa.y) * bfhi(ka.y)
                         + bflo(qa.z) * bflo(ka.z) + bfhi(qa.z) * bfhi(ka.z) + bflo(qa.w) * bflo(ka.w) + bfhi(qa.w) * bfhi(ka.w);
                    qq += bflo(qa.x) * bflo(qa.x) + bfhi(qa.x) * bfhi(qa.x) + bflo(qa.y) * bflo(qa.y) + bfhi(qa.y) * bfhi(qa.y)
                        + bflo(qa.z) * bflo(qa.z) + bfhi(qa.z) * bfhi(qa.z) + bflo(qa.w) * bflo(qa.w) + bfhi(qa.w) * bfhi(qa.w); }
                acc = sum_x32(acc); qq = sum_x32(qq);
                acc = fminf(acc, xor_lt32<1>(acc)); acc = fminf(acc, xor_lt32<2>(acc)); acc = fminf(acc, xor_lt32<4>(acc)); acc = fminf(acc, xor_lt32<8>(acc)); acc = fminf(acc, xor_lt32<16>(acc));
                qq = fmaxf(qq, xor_lt32<1>(qq)); qq = fmaxf(qq, xor_lt32<2>(qq)); qq = fmaxf(qq, xor_lt32<4>(qq)); qq = fmaxf(qq, xor_lt32<8>(qq)); qq = fmaxf(qq, xor_lt32<16>(qq));
                float* wmin = (float*)(lds + OFF_UNIT) + 8;
                if (lane == 0) { wmin[wid] = acc; wmin[8 + wid] = qq; }
                __syncthreads();
                sown = fminf(fminf(fminf(wmin[0], wmin[1]), fminf(wmin[2], wmin[3])), fminf(fminf(wmin[4], wmin[5]), fminf(wmin[6], wmin[7])));
                sown = fminf(sown, 0.f) - 0.25f;
                const float qu2 = fmaxf(fmaxf(fmaxf(wmin[8], wmin[9]), fmaxf(wmin[10], wmin[11])), fmaxf(fmaxf(wmin[12], wmin[13]), fmaxf(wmin[14], wmin[15])));
                smax = fminf(smax, sqrtf(qu2 * kn2) * 1.02f);
              }
              const float wf = (smax - sown + 24.f) / slope2;
              const int wi = (wf < (float)S) ? (int)wf + 1 : S;
              klo = max(q0 - wi, 0) & ~127; khi = min((q0 + 256 + wi + 127) & ~127, S);
#endif
            }
            const int NT = (khi - klo) >> 6;
            const bf16* Qw = Qb + (rowbase + q0 + wid * QBLK + r32) * 1024 + map * 64 + hi * 8;
            const bf16* Kh = Kb + (rowbase + klo) * 1024 + map * 64;
            const bf16* Vh = Vb + (rowbase + klo) * 1024 + h * 128;
            attn_pass(Qw, Kh, Vh, NT, (float)(qpos - klo), klo - (q0 + __builtin_amdgcn_readfirstlane(wid) * QBLK), -slope2, smax, o, lds);
        }
        if (dup) continue;
        const int t2 = mk_tid(); const int r32b = t2 & 31, hib = (t2 >> 5) & 1, widb = t2 >> 6;
        if (t2 == 0) s_unit[1] = atomicAdd(arr + 2 * uid, 1u);
        __syncthreads();
        const unsigned first = s_unit[1];
        f32x4* sp = (f32x4*)(uid < 256 ? (float*)(a.ws + WS_XB) + (size_t)uid * 32768 : (float*)(a.ws + WS_BIG + 96 * MiB) + (size_t)(uid - 256) * 32768) + t2;
        if (first == 0u) {
#pragma unroll
            for (int d0 = 0; d0 < 4; ++d0)
#pragma unroll
                for (int q = 0; q < 4; ++q) {
                    const f32x4 w = {o[d0][4 * q], o[d0][4 * q + 1], o[d0][4 * q + 2], o[d0][4 * q + 3]};
                    asm volatile("global_store_dwordx4 %0, %1, off sc1" :: "v"(sp + (d0 * 4 + q) * 512), "v"(w) : "memory");
                }
            asm volatile("s_waitcnt vmcnt(0)" ::: "memory");
            __syncthreads();
            if (t2 == 0) __hip_atomic_store(arr + 2 * uid + 1, 1u, __ATOMIC_RELAXED, __HIP_MEMORY_SCOPE_AGENT);
            continue;
        }
        if (t2 == 0) { unsigned spn = 0; while (__hip_atomic_load(arr + 2 * uid + 1, __ATOMIC_RELAXED, __HIP_MEMORY_SCOPE_AGENT) == 0u) { __builtin_amdgcn_s_sleep(2); if (++spn > (1u << 24)) break; } }
        __syncthreads();
        float ssq[16];
#pragma unroll
        for (int r = 0; r < 16; ++r) ssq[r] = 0.f;
        f32x4 w[16];
#pragma unroll
        for (int i = 0; i < 16; ++i) asm volatile("global_load_dwordx4 %0, %1, off sc1" : "=v"(w[i]) : "v"(sp + i * 512) : "memory");
        asm volatile("s_waitcnt vmcnt(0)" : "+v"(w[0]), "+v"(w[1]), "+v"(w[2]), "+v"(w[3]), "+v"(w[4]), "+v"(w[5]), "+v"(w[6]), "+v"(w[7]),
                                             "+v"(w[8]), "+v"(w[9]), "+v"(w[10]), "+v"(w[11]), "+v"(w[12]), "+v"(w[13]), "+v"(w[14]), "+v"(w[15]) :: "memory");
#pragma unroll
        for (int d0 = 0; d0 < 4; ++d0)
#pragma unroll
            for (int q = 0; q < 4; ++q) {
#pragma unroll
                for (int e = 0; e < 4; ++e) { const int r = 4 * q + e; const float t = w[d0 * 4 + q][e]; const float v = pass ? (t - lam * o[d0][r]) : (o[d0][r] - lam * t);
                    o[d0][r] = v; ssq[r] = fmaf(v, v, ssq[r]); } }
#pragma unroll
        for (int r = 0; r < 16; ++r) {
            float s = ssq[r];
            s += xor_lt32<1>(s); s += xor_lt32<2>(s); s += xor_lt32<4>(s); s += xor_lt32<8>(s); s += xor_lt32<16>(s);
            ssq[r] = __builtin_amdgcn_rsqf(s * (1.0f / 128.0f) + 1e-5f) * (1.0f - lambda_init);
        }
        bf16* Ow = Ob + (rowbase + q0 + widb * QBLK + 4 * hib) * 1024 + h * 128 + r32b;
#pragma unroll
        for (int d0 = 0; d0 < 4; ++d0) { const float gg = subg[d0 * 32 + r32b];
#pragma unroll
            for (int r = 0; r < 16; ++r) Ow[(size_t)crow(r, 0) * 1024 + d0 * 32] = (bf16)f2bf(o[d0][r] * ssq[r] * gg); }
    }
}


#define XB_TMO      128
#define XB_XCNT(j)  (256  + 64 * (j))
#define XB_XSUB(j)  (1280 + 64 * (j))
#define XB_XGEN(j)  (2304 + 64 * (j))
#define XB_TOP      3328
#define XB_TOPGEN   3392
#define XCD_BAR_WORDS 3456
#define XB_SPIN_CAP (1u << 22)
__device__ __forceinline__ unsigned xb_ld(unsigned* p)              { return __hip_atomic_load(p, __ATOMIC_RELAXED, __HIP_MEMORY_SCOPE_AGENT); }
__device__ __forceinline__ unsigned xb_add(unsigned* p, unsigned v) { return __hip_atomic_fetch_add(p, v, __ATOMIC_RELAXED, __HIP_MEMORY_SCOPE_AGENT); }
__device__ __forceinline__ unsigned xb_xcc_id() { return (unsigned)__builtin_amdgcn_s_getreg((3 << 11) | 20) & 0xFu; }
#define XB_SPIN(cond, bar) do { unsigned _sp = 0; while (cond) { __builtin_amdgcn_s_sleep(1); \
    if ((++_sp & 255u) == 0u) { if (xb_ld(&(bar)[XB_TMO])) break; if (_sp > XB_SPIN_CAP) { atomicAdd(&(bar)[XB_TMO], 1u); break; } } } } while (0)
struct XcdBarrier { unsigned* bar; unsigned x; volatile LAS unsigned* st; };
__device__ __forceinline__ XcdBarrier xcd_barrier_post(unsigned* bar, volatile LAS unsigned* st) {
    XcdBarrier b; b.bar = bar; b.x = xb_xcc_id(); b.st = st;
    if (mk_tid() == 0) (void)xb_add(&bar[XB_XCNT(b.x)], 1u);
    return b;
}
__device__ __forceinline__ void xcd_barrier_complete(unsigned* bar, unsigned x, unsigned& nloc, unsigned& nx) {
    const unsigned G = gridDim.x * gridDim.y * gridDim.z;
    unsigned sum, cnt, mine, sp = 0u;
    for (;;) {
        sum = 0u; cnt = 0u; mine = 0u;
#pragma unroll
        for (unsigned j = 0; j < 16; ++j) { const unsigned c = xb_ld(&bar[XB_XCNT(j)]); sum += c; cnt += (c > 0u) ? 1u : 0u; mine = (j == x) ? c : mine; }
        if (sum == G) break;
        __builtin_amdgcn_s_sleep(1);
        if ((++sp & 255u) == 0u) { if (xb_ld(&bar[XB_TMO])) break; if (sp > XB_SPIN_CAP) { atomicAdd(&bar[XB_TMO], 1u); break; } }
    }
    nloc = mine > 0u ? mine : 1u; nx = cnt > 0u ? cnt : 1u;
}
__device__ __forceinline__ void xcd_barrier(const XcdBarrier& b) {
    asm volatile("s_waitcnt vmcnt(0)" ::: "memory");
    __syncthreads();
    if (mk_tid() == 0) {
        unsigned* bar = b.bar;
        __builtin_amdgcn_s_waitcnt(0);
        unsigned nloc = b.st[0], nx = b.st[1];
        if (nloc == 0u) { xcd_barrier_complete(bar, b.x, nloc, nx); b.st[0] = nloc; b.st[1] = nx; }
        const unsigned old = xb_add(&bar[XB_XSUB(b.x)], 1u);
        const unsigned gen = old / nloc;
        if (old + 1u == (gen + 1u) * nloc) {
            __builtin_amdgcn_fence(__ATOMIC_RELEASE, "agent");
            asm volatile("s_waitcnt vmcnt(0)" ::: "memory");
            const unsigned og = xb_add(&bar[XB_TOP], 1u);
            const unsigned tg = og / nx;
            if (og + 1u == (tg + 1u) * nx) xb_add(&bar[XB_TOPGEN], 1u);
            else XB_SPIN(xb_ld(&bar[XB_TOPGEN]) == tg, bar);
            __builtin_amdgcn_fence(__ATOMIC_ACQUIRE, "agent");
            xb_add(&bar[XB_XGEN(b.x)], 1u);
            asm volatile("s_waitcnt vmcnt(0)" ::: "memory");
        } else {
            XB_SPIN(xb_ld(&bar[XB_XGEN(b.x)]) == gen, bar);
            __builtin_amdgcn_fence(__ATOMIC_ACQUIRE, "agent");
            asm volatile("s_waitcnt vmcnt(0)" ::: "memory");
        }
    }
    __syncthreads();
}

constexpr int LDS_BYTES = 147456;
constexpr int N_PHASES = 1 + 2 * (4 * 5 + 1);
#ifndef MK_MASK
#define MK_MASK 0xFFFF
#endif
#define EN(k) ((MK_MASK >> (k)) & 1)

__global__ void __launch_bounds__(NTHREADS, 2) fwd_megakernel(Args args) {
    extern __shared__ __attribute__((aligned(16))) unsigned char lds[];
    cg::grid_group grid = cg::this_grid();
    const int lo = args.ph_lo, hi = args.ph_hi;
    int ph = 0;
#define RUN() (ph >= lo && ph < hi)
#if MK_PROBE
    unsigned long long t_last = __builtin_amdgcn_s_memrealtime(), t_a = 0, t_b = 0;
#define SEAMK(k) do { if (ph >= lo && ph + 1 < hi) grid.sync(); ++ph; { const unsigned long long t_now = __builtin_amdgcn_s_memrealtime(); \
        if ((MK_PROBE_A >> (k)) & 1) t_a += t_now - t_last; if ((MK_PROBE_B >> (k)) & 1) t_b += t_now - t_last; t_last = t_now; } } while (0)
#else
#define SEAMK(k) do { if (ph >= lo && ph + 1 < hi) { if (ph == 0) { grid.sync(); xbar = xcd_barrier_post((unsigned*)(ws + WS_CTL) + CW_BAR, xst); } else xcd_barrier(xbar); } ++ph; } while (0)
#endif
#define SEAM() SEAMK(0)
    unsigned char* ws = args.ws;
    volatile LAS unsigned* xst = (volatile LAS unsigned*)((LAS unsigned char*)lds + 131072 + 256);
    if (mk_tid() == 0) { xst[0] = 0u; xst[1] = 0u; }
    __syncthreads();
    XcdBarrier xbar; xbar.bar = (unsigned*)(ws + WS_CTL) + CW_BAR; xbar.x = 0; xbar.st = xst;
    PG8_LAS unsigned char* glds = (PG8_LAS unsigned char*)lds;
    const int G = gridDim.x, c = blockIdx.x;

    if (EN(0) && RUN()) { _Pragma("unroll 1") for (int rep = 0; rep < 1 + (MK_DUP_MISC & 1); ++rep) { phase_prologue(args, (LAS unsigned char*)lds); __syncthreads(); }
                          phase_prep(args, 0); }
    SEAMK(1);
#pragma unroll 1
    for (int g = 0; g < 2; ++g) {
        float* xg = args.out + (size_t)g * MG * D; bf16* XB = (bf16*)(ws + WS_XB);
        float* rsq_base = (float*)(ws + WS_ROWSQ);
#pragma unroll 1
        for (int i = 0; i < DEPTH; ++i) {
            const int j = i >> 1;
            float* rsq_n1 = rsq_base + (size_t)(2 * i) * MG * 16; float* rsq_n2 = rsq_base + (size_t)(2 * i + 1) * MG * 16; float* rsq_nx = rsq_base + (size_t)(2 * i + 2) * MG * 16;
            if ((i & 1) == 0) {
                if (EN(2) && RUN()) {
                    pg8::Gemm gm{XB, (const bf16*)(ws + WS_WMI) + (size_t)j * 2048 * D, MG, 2048, D}; pg8::StaticOrder S; S.init(MG, 2048, G, c);
                    pg8::EpiProj<0> E{(bf16*)(ws + WS_BIG), 2048, rsq_n1, 0, 1.f, nullptr, 0, (PG8_LAS float*)(glds + 131072 + 1024)};
                    _Pragma("unroll 1") for (int rep = 0; rep < MK_DUP; ++rep) pg8::gemm_phase<pg8::EpiProj<0>, pg8::StaticOrder, true, true>(glds, gm, S, E);
                }
                SEAMK(3);
                if (EN(3) && RUN()) { _Pragma("unroll 1") for (int rep = 0; rep < 1 + ((MK_DUP_MISC >> 2) & 1); ++rep) phase_stencil(args, g, j); }
                SEAMK(4);
                if (EN(4) && RUN()) {
                    pg8::Gemm gm{(const bf16*)(ws + WS_BIG + 64 * MiB), (const bf16*)(ws + WS_WMO) + (size_t)j * D * D, MG, D, D}; pg8::StaticOrder S; S.init(MG, D, G, c);
                    pg8::EpiRes E{xg, XB, rsq_n2, 0};
                    if (MK_DUP_RES == 1) { pg8::EpiNull E0; pg8::gemm_phase<pg8::EpiNull, pg8::StaticOrder, true, true>(glds, gm, S, E0); }
                    if (MK_DUP_RES == 2) { pg8::EpiRes E0 = E; E0.dry = 1; pg8::gemm_phase<pg8::EpiRes, pg8::StaticOrder, true, true>(glds, gm, S, E0); }
                    pg8::gemm_phase<pg8::EpiRes, pg8::StaticOrder, true, true>(glds, gm, S, E);
                }
                SEAMK(5);
            } else {
                if (EN(5) && RUN()) {
                    pg8::Gemm gm{XB, (const bf16*)(ws + WS_WQKV) + (size_t)j * 3072 * D, MG, 3072, D}; pg8::StaticOrder S; S.init(MG, 3072, G, c);
                    pg8::EpiProj<1> E{(bf16*)(ws + WS_BIG), 1024, rsq_n1, (size_t)MG * 1024, QSCALE, (unsigned*)(ws + WS_CTL) + CW_NRM + 256 * (g * 2 + j), g ? 14 : 13, (PG8_LAS float*)(glds + 131072 + 1024)};
                    _Pragma("unroll 1") for (int rep = 0; rep < MK_DUP; ++rep) pg8::gemm_phase<pg8::EpiProj<1>, pg8::StaticOrder, true, true>(glds, gm, S, E);
                }
                SEAMK(6);
                if (EN(6) && RUN()) phase_attention(args, g, i, (char*)lds);
                SEAMK(7);
                if (EN(7) && RUN()) {
                    pg8::Gemm gm{(const bf16*)(ws + WS_BIG), (const bf16*)(ws + WS_WAO) + (size_t)j * D * D, MG, D, D}; pg8::StaticOrder S; S.init(MG, D, G, c);
                    pg8::EpiRes E{xg, XB, rsq_n2, 0};
                    if (MK_DUP_RES == 1) { pg8::EpiNull E0; pg8::gemm_phase<pg8::EpiNull, pg8::StaticOrder, true, true>(glds, gm, S, E0); }
                    if (MK_DUP_RES == 2) { pg8::EpiRes E0 = E; E0.dry = 1; pg8::gemm_phase<pg8::EpiRes, pg8::StaticOrder, true, true>(glds, gm, S, E0); }
                    pg8::gemm_phase<pg8::EpiRes, pg8::StaticOrder, true, true>(glds, gm, S, E);
                }
                SEAMK(8);
            }
            if (EN(8) && RUN()) {
                pg8::Gemm gm{XB, (const bf16*)(ws + WS_W1) + (size_t)i * FF * D, MG, FF, D}; pg8::StaticOrder S; S.init(MG, FF, G, c);
                pg8::EpiProj<2> E{(bf16*)(ws + WS_BIG), FF, rsq_n2, 0, 1.f, nullptr, 0, (PG8_LAS float*)(glds + 131072 + 1024)};
                _Pragma("unroll 1") for (int rep = 0; rep < MK_DUP; ++rep) pg8::gemm_phase<pg8::EpiProj<2>, pg8::StaticOrder, true, true>(glds, gm, S, E);
            }
            SEAMK(9);
            if (EN(9) && RUN()) {
                pg8::Gemm gm{(const bf16*)(ws + WS_BIG), (const bf16*)(ws + WS_W2) + (size_t)i * D * FF, MG, D, FF}; pg8::StaticOrder S; S.init(MG, D, G, c);
                pg8::EpiRes E{xg, XB, rsq_nx, 0};
                if (MK_DUP_RES == 1) { pg8::EpiNull E0; pg8::gemm_phase<pg8::EpiNull, pg8::StaticOrder, true, true>(glds, gm, S, E0); }
                    if (MK_DUP_RES == 2) { pg8::EpiRes E0 = E; E0.dry = 1; pg8::gemm_phase<pg8::EpiRes, pg8::StaticOrder, true, true>(glds, gm, S, E0); }
                    pg8::gemm_phase<pg8::EpiRes, pg8::StaticOrder, true, true>(glds, gm, S, E);
            }
            SEAMK(10);
        }
        if (EN(10) && RUN()) { phase_final(args, g); if (g == 0) phase_prep(args, 1); }
        SEAMK(11);
    }
#if MK_PROBE
    if (blockIdx.x == 0 && (mk_tid() >> 6) == 0) {
        const float da = (float)t_a * 1e-5f / 1.5f, db = (float)t_b * 1e-5f;
        for (int g = 0; g < 2; ++g) { float* r0 = args.out + (size_t)g * MG * D; const int lane = mk_tid() & 63;
            for (int q = 0; q < 16; ++q) r0[q * 64 + lane] += da;
            if (lane == 0) r0[(size_t)2048 * D] += db; }
    }
#endif
#undef RUN
#undef SEAM
}

extern "C" void kernel_launch(void* const* d_in, const int* in_sizes, int n_in, void* d_out, int out_size, void* d_ws, size_t ws_size, hipStream_t stream) {
    static int grid = 0;
    if (grid == 0) {
        if (n_in != 19 || in_sizes[0] != MG * D || in_sizes[1] != MG * D || out_size != MTOT * D || ws_size < WS_END) {
            fprintf(stderr, "kernel_launch: unexpected shapes: n_in %d in0 %d in1 %d out %d ws %zu (need %zu); nothing launched\n", n_in, n_in > 0 ? in_sizes[0] : -1, n_in > 1 ? in_sizes[1] : -1, out_size, ws_size, (size_t)WS_END);
            grid = -1; return; }
        int dev = 0, cus = 0, per_cu = 0;
        hipGetDevice(&dev);
        hipDeviceGetAttribute(&cus, hipDeviceAttributeMultiprocessorCount, dev);
        if (hipFuncSetAttribute((const void*)fwd_megakernel, hipFuncAttributeMaxDynamicSharedMemorySize, LDS_BYTES) != hipSuccess) { fprintf(stderr, "kernel_launch: hipFuncSetAttribute failed\n"); grid = -1; return; }
        if (hipOccupancyMaxActiveBlocksPerMultiprocessor(&per_cu, (const void*)fwd_megakernel, NTHREADS, LDS_BYTES) != hipSuccess || per_cu < 1) { fprintf(stderr, "kernel_launch: occupancy query failed (%d)\n", per_cu); per_cu = 1; }
        (void)hipGetLastError();
        grid = cus * per_cu;
        if (grid > 256) grid = 256;
    }
    if (grid < 0) return;
    Args a{};
    for (int i = 0; i < 19; ++i) a.in[i] = (const float*)d_in[i];
    a.out = (float*)d_out; a.ws = (unsigned char*)d_ws;
#if MK_PER_PHASE
    for (int p = 0; p < N_PHASES; ++p) {
        a.ph_lo = p; a.ph_hi = p + 1;
        void* kargs[] = {&a};
        hipError_t e = hipLaunchCooperativeKernel((const void*)fwd_megakernel, dim3(grid), dim3(NTHREADS), kargs, LDS_BYTES, stream);
        if (e != hipSuccess) { fprintf(stderr, "kernel_launch: cooperative launch %d failed: %s\n", p, hipGetErrorString(e)); break; }
    }
#else
    a.ph_lo = 0; a.ph_hi = N_PHASES;
    void* kargs[] = {&a};
    hipError_t e = hipLaunchCooperativeKernel((const void*)fwd_megakernel, dim3(grid), dim3(NTHREADS), kargs, LDS_BYTES, stream);
    if (e != hipSuccess) fprintf(stderr, "kernel_launch: cooperative launch failed: %s (grid %d)\n", hipGetErrorString(e), grid);
#endif
}
```

```cpp
#include <hip/hip_runtime.h>
#include <hip/hip_cooperative_groups.h>
#include <cstdio>
#include <cstdint>
namespace cg = cooperative_groups;

#ifndef MK_WINDOW
#define MK_WINDOW 1
#endif
#ifndef MK_PROBE
#define MK_PROBE 0
#endif
#ifndef MK_PROBE_A
#define MK_PROBE_A (1 << 7)
#endif
#ifndef MK_PROBE_B
#define MK_PROBE_B ((1 << 3) | (1 << 5) | (1 << 6) | (1 << 8) | (1 << 9) | (1 << 10))
#endif
#ifndef MK_DUP
#define MK_DUP 1
#endif
#ifndef MK_DUP_ATT
#define MK_DUP_ATT 1
#endif
#ifndef MK_DUP_MISC
#define MK_DUP_MISC 0
#endif
#ifndef MK_DUP_RES
#define MK_DUP_RES 0
#endif
#ifndef MK_PER_PHASE
#define MK_PER_PHASE 0
#endif

__device__ __forceinline__ int mk_tid() { int t = threadIdx.x; asm volatile("" : "+v"(t)); return t; }

template <int M> __device__ __forceinline__ float xor_lt32(float v) { return __int_as_float(__builtin_amdgcn_ds_swizzle(__float_as_int(v), (M << 10) | 0x1f)); }
__device__ __forceinline__ float sum_x32(float v) { auto rr = __builtin_amdgcn_permlane32_swap(__float_as_uint(v), __float_as_uint(v), false, false); return __uint_as_float(rr[0]) + __uint_as_float(rr[1]); }

namespace pg8 {
#define PG8_LAS __attribute__((address_space(3)))
typedef unsigned short bf16_t;
typedef short bf16x8 __attribute__((ext_vector_type(8)));
typedef float f32x4 __attribute__((ext_vector_type(4)));
typedef unsigned u32x4 __attribute__((ext_vector_type(4)));
constexpr int BM = 256, BK = 64, HALF = 128, HTB = HALF * BK * 2  , STAGE_BYTES = 8 * HTB, NXCD = 8, WGM = 8;

__host__ __device__ __forceinline__ int lds_byte(int r, int c) { const int st = (r >> 4) * 2 + (c >> 5), rr = r & 15, cc = c & 31, ob = rr * 64 + cc * 2; return st * 1024 + (ob ^ (((ob >> 9) & 1) << 5)); }
__host__ __device__ __forceinline__ void stage_rc(int b, int& R, int& C) { const int st = b / 1024, sb = b % 1024, swz = sb ^ (((sb >> 9) & 1) << 5); R = (st >> 1) * 16 + swz / 64; C = (st & 1) * 32 + (swz % 64) / 2; }
__host__ __device__ __forceinline__ int perm32(int rho) { const int n = rho >> 4, i = rho & 15; return 8 * (i >> 2) + 4 * n + (i & 3); }

struct Unit { int pm, pn; };
struct Gemm { const bf16_t* A; const bf16_t* Bt; int M, N, K; };

struct StaticOrder {
    int nM, nN, nwg, G, c;
    __host__ __device__ void init(int M, int N, int G_, int c_) { nM = M / BM; nN = N / BM; nwg = nM * nN; G = G_; c = c_; }
    __host__ __device__ bool next(int i, Unit& u) const {
        const long L = (long)i * G + c; if (L >= nwg) return false;
        int wgid = (int)L; { const int q = nwg / NXCD, r = nwg % NXCD, xcd = wgid % NXCD, off = wgid / NXCD; wgid = (xcd < r ? xcd * (q + 1) : r * (q + 1) + (xcd - r) * q) + off; }
        const int nig = WGM * nN, gid = wgid / nig, fm = gid * WGM, gsz = (nM - fm) < WGM ? (nM - fm) : WGM;
        u.pm = fm + ((wgid % nig) % gsz); u.pn = (wgid % nig) / gsz; return true;
    }
    __device__ __forceinline__ void a_ready(const Unit&) const {}
    __device__ __forceinline__ void done(const Unit&) const {}
};

__device__ __forceinline__ unsigned cvt_pk_bf16(float lo, float hi) { unsigned r; asm volatile("v_cvt_pk_bf16_f32 %0, %1, %2" : "=v"(r) : "v"(lo), "v"(hi)); return r; }
typedef float f32x2 __attribute__((ext_vector_type(2)));
template <int MODE> struct EpiProj {
    static constexpr bool PERM = true, AFTER_DRAIN = false;
    bf16_t* O; int ldc; const float* rowsq; size_t split_stride; float scale0; unsigned* nrm; int logS; PG8_LAS float* rl;
    __device__ __forceinline__ void operator()(const f32x4 (&acc)[2][2][4][2], const Unit& u, int wr, int wc, int fr, int fq) const {
        const int row0 = u.pm * BM + wr * 64 + fr; int colt = u.pn * BM; bf16_t* base = O; float sc = 1.f; int t = 0;
        if (MODE == 1) { t = colt >> 10; base += (size_t)t * split_stride; colt &= 1023; if (t == 0) sc = scale0; }
        const int col0 = colt + wc * 32 + 8 * fq;
        float nmx[2] = {0.f, 0.f};
        { const int t = (wr * 4 + wc) * 64 + fq * 16 + fr;
          const f32x4* rp = (const f32x4*)(rowsq + (size_t)(u.pm * BM + (t >> 1)) * 16) + (t & 1) * 2; const f32x4 a0 = rp[0], a1 = rp[1];
          float s = ((a0[0] + a0[1]) + (a0[2] + a0[3])) + ((a1[0] + a1[1]) + (a1[2] + a1[3]));
          s += xor_lt32<1>(s);
          if ((t & 1) == 0) rl[t >> 1] = __builtin_amdgcn_rsqf(s * (1.0f / 1024.0f) + 1e-6f);
          asm volatile("s_waitcnt lgkmcnt(0)" ::: "memory"); __builtin_amdgcn_s_barrier(); asm volatile("" ::: "memory"); }
#pragma unroll
        for (int ai = 0; ai < 2; ++ai)
#pragma unroll
            for (int m = 0; m < 4; ++m) {
                const int row = row0 + ai * HALF + m * 16;
                const float rs = rl[wr * 64 + fr + ai * HALF + m * 16] * sc;
                bf16_t* rowp = base + (size_t)row * ldc + col0;
#pragma unroll
                for (int bj = 0; bj < 2; ++bj) {
                    f32x4 v0 = acc[ai][bj][m][0] * rs, v1 = acc[ai][bj][m][1] * rs;
                    if (MODE == 2) {
#pragma unroll
                        for (int e = 0; e < 4; ++e) { const float a = fmaxf(v0[e], 0.f), b = fmaxf(v1[e], 0.f); v0[e] = a * a; v1[e] = b * b; }
                    }
                    if (MODE == 1) {
                        float s = (v0[0] * v0[0] + v0[1] * v0[1]) + (v0[2] * v0[2] + v0[3] * v0[3]) + (v1[0] * v1[0] + v1[1] * v1[1]) + (v1[2] * v1[2] + v1[3] * v1[3]);
                        s += xor_lt32<16>(s); s = sum_x32(s);
                        nmx[bj] = fmaxf(nmx[bj], s);
                    }
                    u32x4 w; w.x = cvt_pk_bf16(v0[0], v0[1]); w.y = cvt_pk_bf16(v0[2], v0[3]); w.z = cvt_pk_bf16(v1[0], v1[1]); w.w = cvt_pk_bf16(v1[2], v1[3]);
                    *(u32x4*)(rowp + bj * HALF) = w;
                }
            }
        if (MODE == 1) {
            if (t < 2) {
                const int b = (u.pm * BM) >> logS;
#pragma unroll
                for (int bj = 0; bj < 2; ++bj) {
                    float v = nmx[bj];
                    v = fmaxf(v, xor_lt32<1>(v)); v = fmaxf(v, xor_lt32<2>(v)); v = fmaxf(v, xor_lt32<4>(v)); v = fmaxf(v, xor_lt32<8>(v));
                    const int map = (colt >> 6) + 2 * bj + (wc >> 1), half = wc & 1;
                    if (fr == 0 && fq == 0) atomicMax(nrm + (((t * 2 + b) * 16 + map) * 2 + half), __float_as_uint(v));
                }
            }
        }
    }
};
struct EpiRes {
    static constexpr bool PERM = false, AFTER_DRAIN = false;
    float* x; bf16_t* xb; float* rowsq; int dry;
    __device__ __forceinline__ void operator()(const f32x4 (&acc)[2][2][4][2], const Unit& u, int wr, int wc, int fr, int fq) const {
        typedef unsigned u32x2v __attribute__((ext_vector_type(2)));
        const int col0 = u.pn * BM + wc * 32 + 4 * fq;
#pragma unroll
        for (int ai = 0; ai < 2; ++ai)
#pragma unroll
            for (int m = 0; m < 4; ++m) {
                const int row = u.pm * BM + ai * HALF + wr * 64 + m * 16 + fr; const size_t off = (size_t)row * 1024 + col0;
                float ss = 0.f;
#pragma unroll
                for (int bj = 0; bj < 2; ++bj)
#pragma unroll
                    for (int n = 0; n < 2; ++n) {
                        const f32x4 xo = *(const f32x4*)(x + off + bj * HALF + n * 16);
                        const f32x4 xn = xo + acc[ai][bj][m][n];
                        *(f32x4*)(x + off + bj * HALF + n * 16) = dry ? xo : xn;
                        ss += (xn[0] * xn[0] + xn[1] * xn[1]) + (xn[2] * xn[2] + xn[3] * xn[3]);
                        u32x2v w; w.x = cvt_pk_bf16(xn[0], xn[1]); w.y = cvt_pk_bf16(xn[2], xn[3]);
                        if (xb) *(u32x2v*)(xb + off + bj * HALF + n * 16) = w;
                    }
                ss += xor_lt32<16>(ss); ss = sum_x32(ss);
                if (fq == 0) rowsq[(size_t)row * 16 + u.pn * 4 + wc] = ss;
            }
    }
};

struct EpiNull {
    static constexpr bool PERM = false, AFTER_DRAIN = false;
    __device__ __forceinline__ void operator()(const f32x4 (&acc)[2][2][4][2], const Unit& u, int wr, int wc, int fr, int fq) const {
#pragma unroll
        for (int ai = 0; ai < 2; ++ai)
#pragma unroll
            for (int bj = 0; bj < 2; ++bj)
#pragma unroll
                for (int m = 0; m < 4; ++m)
#pragma unroll
                    for (int n = 0; n < 2; ++n) asm volatile("" :: "v"(acc[ai][bj][m][n]));
    }
};

template <class Epi, class Sched, bool ALIGN_EPI = false, bool SP2 = false>
__device__ __forceinline__ void gemm_phase(PG8_LAS unsigned char* lds, const Gemm g, const Sched& S, const Epi& E) {
    const int tid = mk_tid(), wid = __builtin_amdgcn_readfirstlane(tid >> 6), lane = tid & 63, wr = wid >> 2, wc = wid & 3, fr = lane & 15, fq = lane >> 4;
    const int K = g.K, nt = K / BK;
    unsigned voffA[2], voffB[2];
#pragma unroll
    for (int i = 0; i < 2; ++i) { int R, C; stage_rc(tid * 16 + i * 8192, R, C); const int Rb = Epi::PERM ? ((R & ~31) + perm32(R & 31)) : R;
        voffA[i] = (unsigned)(R * K + C) * 2u; voffB[i] = (unsigned)(Rb * K + C) * 2u; }
    const size_t kstep = (size_t)(BK * 2);
    const size_t hstep = (size_t)HALF * K * 2;
    const size_t tstep = 2 * hstep;
    const unsigned ldsw = (unsigned)wid * 1024u;
    const int aoff = lds_byte(wr * 64 + fr, fq * 8), boff = lds_byte(wc * 32 + fr, fq * 8);
#define PG8_SA(b, h) (((b) * 2 + (h)) * HTB)
#define PG8_SB(b, h) ((4 + (b) * 2 + (h)) * HTB)
#define PG8_STAGE(bufoff, gbase, voff) do { _Pragma("unroll") for (int _i = 0; _i < 2; ++_i) \
        __builtin_amdgcn_global_load_lds((const unsigned*)((const char*)(gbase) + (voff)[_i]), (PG8_LAS unsigned*)(lds + (bufoff) + ldsw + _i * 8192), 16, 0, 0); } while (0)
#define PG8_LDA(dst, b, h) do { _Pragma("unroll") for (int m = 0; m < 4; ++m) _Pragma("unroll") for (int k = 0; k < 2; ++k) dst[m][k] = *(const PG8_LAS bf16x8*)(lds + PG8_SA(b, h) + aoff + m * 2048 + k * 1024); } while (0)
#define PG8_LDB(dst, b, h) do { _Pragma("unroll") for (int n = 0; n < 2; ++n) _Pragma("unroll") for (int k = 0; k < 2; ++k) dst[n][k] = *(const PG8_LAS bf16x8*)(lds + PG8_SB(b, h) + boff + n * 2048 + k * 1024); } while (0)
#define PG8_MMA(ai, bj, At, Bt) do { __builtin_amdgcn_s_setprio(1); _Pragma("unroll") for (int m = 0; m < 4; ++m) _Pragma("unroll") for (int n = 0; n < 2; ++n) _Pragma("unroll") for (int k = 0; k < 2; ++k) \
        acc[ai][bj][m][n] = __builtin_amdgcn_mfma_f32_16x16x32_bf16(Bt[n][k], At[m][k], acc[ai][bj][m][n], 0, 0, 0); __builtin_amdgcn_s_setprio(0); } while (0)
#define PG8_WAIT_V(n) asm volatile("s_waitcnt vmcnt(" #n ")" ::: "memory")
#define PG8_WAIT_L(n) asm volatile("s_waitcnt lgkmcnt(" #n ")" ::: "memory")
#define PG8_BAR __builtin_amdgcn_s_barrier()
#define PG8_SCHED __builtin_amdgcn_sched_barrier(0)
    Unit cur, nxt; int ui = 0;
    if (!S.next(0, cur)) return;
    f32x4 acc[2][2][4][2];
#pragma unroll
    for (int a = 0; a < 2; ++a)
#pragma unroll
        for (int b = 0; b < 2; ++b)
#pragma unroll
            for (int m = 0; m < 4; ++m)
#pragma unroll
                for (int n = 0; n < 2; ++n) acc[a][b][m][n] = (f32x4){0.f, 0.f, 0.f, 0.f};
    bf16x8 At[4][2], B0[2][2], B1[2][2];
    const char* cA = (const char*)g.A + (size_t)cur.pm * tstep; const char* cB = (const char*)g.Bt + (size_t)cur.pn * tstep;
    S.a_ready(cur);
    if constexpr (SP2) {
        PG8_STAGE(PG8_SB(0, 0), cB, voffB); PG8_STAGE(PG8_SB(0, 1), cB + hstep, voffB); PG8_STAGE(PG8_SA(0, 0), cA, voffA); PG8_STAGE(PG8_SA(0, 1), cA + hstep, voffA);
        if (wr == 1) PG8_BAR;
        PG8_WAIT_V(2); PG8_BAR;
        PG8_STAGE(PG8_SB(1, 0), cB + kstep, voffB); PG8_STAGE(PG8_SA(1, 0), cA + kstep, voffA); PG8_STAGE(PG8_SB(1, 1), cB + hstep + kstep, voffB);
        PG8_WAIT_V(6); PG8_BAR;
    } else {
        PG8_STAGE(PG8_SB(0, 0), cB, voffB); PG8_STAGE(PG8_SA(0, 0), cA, voffA); PG8_STAGE(PG8_SB(0, 1), cB + hstep, voffB); PG8_STAGE(PG8_SA(0, 1), cA + hstep, voffA);
        if (wr == 1) PG8_BAR;
        PG8_WAIT_V(4); PG8_BAR;
        PG8_STAGE(PG8_SB(1, 0), cB + kstep, voffB); PG8_STAGE(PG8_SA(1, 0), cA + kstep, voffA); PG8_STAGE(PG8_SB(1, 1), cB + hstep + kstep, voffB);
        PG8_WAIT_V(6); PG8_BAR;
    }
    for (;;) {
        const bool has_next = S.next(ui + 1, nxt);
        const char* nA = has_next ? (const char*)g.A + (size_t)nxt.pm * tstep : cA; const char* nB = has_next ? (const char*)g.Bt + (size_t)nxt.pn * tstep : cB;
        for (int t = 0; t < nt; t += 2) {
            const bool last = (t == nt - 2);
            const char* a1 = cA + (size_t)(t + 1) * kstep;
            const char* a2 = last ? nA : cA + (size_t)(t + 2) * kstep; const char* b2 = last ? nB : cB + (size_t)(t + 2) * kstep;
            const char* a3 = a2 + kstep; const char* b3 = b2 + kstep;
            if (last && has_next) S.a_ready(nxt);
            if constexpr (SP2) {
            PG8_LDB(B0, 0, 0); PG8_LDB(B1, 0, 1); PG8_SCHED; PG8_LDA(At, 0, 0); PG8_STAGE(PG8_SA(1, 1), a1 + hstep, voffA);
            PG8_WAIT_V(8); PG8_WAIT_L(0); PG8_BAR; PG8_MMA(0, 0, At, B0); PG8_MMA(0, 1, At, B1); PG8_BAR; PG8_SCHED;
            PG8_LDA(At, 0, 1); PG8_STAGE(PG8_SB(0, 0), b2, voffB); PG8_STAGE(PG8_SB(0, 1), b2 + hstep, voffB); PG8_STAGE(PG8_SA(0, 0), a2, voffA);
            PG8_WAIT_V(8); PG8_WAIT_L(0); PG8_BAR; PG8_MMA(1, 0, At, B0); PG8_MMA(1, 1, At, B1); PG8_BAR; PG8_SCHED;
            PG8_LDB(B0, 1, 0); PG8_LDB(B1, 1, 1); PG8_SCHED; PG8_LDA(At, 1, 0); PG8_STAGE(PG8_SA(0, 1), a2 + hstep, voffA);
            PG8_WAIT_V(8); PG8_WAIT_L(0); PG8_BAR; PG8_MMA(0, 0, At, B0); PG8_MMA(0, 1, At, B1); PG8_BAR; PG8_SCHED;
            PG8_LDA(At, 1, 1); PG8_STAGE(PG8_SB(1, 0), b3, voffB); PG8_STAGE(PG8_SB(1, 1), b3 + hstep, voffB); PG8_STAGE(PG8_SA(1, 0), a3, voffA);
            PG8_WAIT_V(8); PG8_WAIT_L(0); PG8_BAR; PG8_MMA(1, 0, At, B0); PG8_MMA(1, 1, At, B1); PG8_BAR; PG8_SCHED;
            } else {
            PG8_LDB(B0, 0, 0); PG8_SCHED; PG8_LDA(At, 0, 0); PG8_STAGE(PG8_SA(1, 1), a1 + hstep, voffA);
            PG8_WAIT_L(8); PG8_BAR; PG8_WAIT_L(0); PG8_MMA(0, 0, At, B0); PG8_BAR; PG8_SCHED;
            PG8_LDB(B1, 0, 1); PG8_STAGE(PG8_SB(0, 0), b2, voffB);
            PG8_BAR; PG8_WAIT_L(0); PG8_MMA(0, 1, At, B1); PG8_BAR;
            PG8_LDA(At, 0, 1); PG8_STAGE(PG8_SA(0, 0), a2, voffA);
            PG8_BAR; PG8_WAIT_L(0); PG8_MMA(1, 0, At, B0); PG8_BAR; PG8_SCHED;
            PG8_STAGE(PG8_SB(0, 1), b2 + hstep, voffB);
            PG8_WAIT_V(6); PG8_BAR; PG8_MMA(1, 1, At, B1); PG8_BAR;
            PG8_LDB(B0, 1, 0); PG8_SCHED; PG8_LDA(At, 1, 0); PG8_STAGE(PG8_SA(0, 1), a2 + hstep, voffA);
            PG8_WAIT_L(8); PG8_BAR; PG8_WAIT_L(0); PG8_MMA(0, 0, At, B0); PG8_BAR; PG8_SCHED;
            PG8_LDB(B1, 1, 1); PG8_STAGE(PG8_SB(1, 0), b3, voffB);
            PG8_BAR; PG8_WAIT_L(0); PG8_MMA(0, 1, At, B1); PG8_BAR;
            PG8_LDA(At, 1, 1); PG8_STAGE(PG8_SA(1, 0), a3, voffA);
            PG8_BAR; PG8_WAIT_L(0); PG8_MMA(1, 0, At, B0); PG8_BAR; PG8_SCHED;
            PG8_STAGE(PG8_SB(1, 1), b3 + hstep, voffB);
            PG8_WAIT_V(6); PG8_BAR; PG8_MMA(1, 1, At, B1); PG8_BAR;
            }
        }
        if constexpr (ALIGN_EPI) { if (wr == 0) PG8_BAR; }
        if constexpr (!Epi::AFTER_DRAIN) { E(acc, cur, wr, wc, fr, fq); S.done(cur); }
        if (!has_next) break;
#pragma unroll
        for (int a = 0; a < 2; ++a)
#pragma unroll
            for (int b = 0; b < 2; ++b)
#pragma unroll
                for (int m = 0; m < 4; ++m)
#pragma unroll
                    for (int n = 0; n < 2; ++n) acc[a][b][m][n] = (f32x4){0.f, 0.f, 0.f, 0.f};
        cur = nxt; cA = nA; cB = nB; ++ui;
        if constexpr (ALIGN_EPI) { if (wr == 1) PG8_BAR; }
    }
    PG8_WAIT_V(0);
    if constexpr (!ALIGN_EPI) { if (wr == 0) PG8_BAR; }
    PG8_BAR;
    if constexpr (Epi::AFTER_DRAIN) { E.fused(acc, cur, wr, wc, fr, fq, lds, wid, lane); S.done(cur); }
#undef PG8_SA
#undef PG8_SB
#undef PG8_STAGE
#undef PG8_LDA
#undef PG8_LDB
#undef PG8_MMA
#undef PG8_WAIT_V
#undef PG8_WAIT_L
#undef PG8_BAR
#undef PG8_SCHED
}
}

namespace att {
typedef unsigned short bf16_t;
using bf16x8 = __attribute__((ext_vector_type(8))) short;
using s16x4  = __attribute__((ext_vector_type(4))) short;
using f32x16 = __attribute__((ext_vector_type(16))) float;
using u32x4  = __attribute__((ext_vector_type(4))) unsigned;
constexpr int NW = 8, QBLK = 32, KVBLK = 64, LD = 1024;
constexpr int SHM_V = KVBLK * 128 * 2, SHM_K = KVBLK * 64 * 2;
constexpr int NSLOT = 3;
constexpr int OFF_V = 0, OFF_K = NSLOT * SHM_V, OFF_WS = OFF_K + NSLOT * SHM_K, OFF_UNIT = OFF_WS + NW * 64 * 4, LDS_BYTES = OFF_UNIT + 128;
constexpr int SDEPTH = 1;
constexpr float THR2 = 16.f;
#define KSWZ(row, colB) ((row) * 128 + ((colB) ^ ((((row) >> 1) & 7) << 4)))
#define SBAR() __builtin_amdgcn_sched_barrier(0)
#define SGB_MFMA_VALU(N, V) do { _Pragma("unroll") for (int _g = 0; _g < (N); ++_g) { __builtin_amdgcn_sched_group_barrier(0x008, 1, 0); __builtin_amdgcn_sched_group_barrier(0x400, (V), 0); } } while (0)
__device__ __forceinline__ int crow(int r, int hi) { return (r & 3) + 8 * (r >> 2) + 4 * hi; }
__device__ __forceinline__ unsigned cvtpk(float lo, float hi) { unsigned r; asm volatile("v_cvt_pk_bf16_f32 %0, %1, %2" : "=v"(r) : "v"(lo), "v"(hi)); return r; }

__device__ __forceinline__ void split3(float a, unsigned& h, unsigned& l, unsigned& ll) {
  h = cvtpk(a, 0.f) & 0xffffu; const float r1 = a - __uint_as_float(h << 16);
  l = cvtpk(r1, 0.f) & 0xffffu; const float r2 = r1 - __uint_as_float(l << 16);
  ll = cvtpk(r2, 0.f) & 0xffffu;
}
__device__ __forceinline__ void tile_ctl(int rel, float dq, float m_reg, float nc2, float smax, int hi, bf16x8& qx, int& mode, bool& skip) {
  mode = (rel <= -64) ? 1 : (rel >= 32) ? 2 : 0;
  const float dmin = (mode == 1) ? (float)(-rel - 63) : (float)(rel - 31);
  skip = (mode != 0) && (smax + nc2 * dmin <= THR2);
  const float A = (mode == 1 ? nc2 * dq : -nc2 * dq) - m_reg;
  unsigned ah, al, all_; split3(A, ah, al, all_);
  const unsigned sg = (mode == 1) ? 0x3F80u : 0xBF80u;
  u32x4 w = {ah | (al << 16), all_ | (sg << 16), sg | (sg << 16), 0u};
  if (hi != 0 || mode == 0) w = u32x4{0u, 0u, 0u, 0u};
  qx = *reinterpret_cast<bf16x8*>(&w);
}
__device__ __forceinline__ void partialSM(f32x16& p0, f32x16& p1, float& m_reg, float& alpha, int mode, bool skip, float dqh, float nc2) {
  if (mode == 0) {
    const float dq1 = dqh - 32.f;
#pragma unroll
    for (int r = 0; r < 16; ++r) p0[r] = fmaf(__builtin_fabsf(dqh - (float)((r & 3) + 8 * (r >> 2))), nc2, p0[r]) - m_reg;
#pragma unroll
    for (int r = 0; r < 16; ++r) p1[r] = fmaf(__builtin_fabsf(dq1 - (float)((r & 3) + 8 * (r >> 2))), nc2, p1[r]) - m_reg;
  }
  alpha = 1.f;
  if (!skip) {
    float pmax = p0[0];
#pragma unroll
    for (int r = 1; r < 16; ++r) pmax = fmaxf(pmax, p0[r]);
#pragma unroll
    for (int r = 0; r < 16; ++r) pmax = fmaxf(pmax, p1[r]);
    { auto rr = __builtin_amdgcn_permlane32_swap(__float_as_uint(pmax), __float_as_uint(pmax), false, false);
      pmax = fmaxf(__uint_as_float(rr[0]), __uint_as_float(rr[1])); }
    if (__builtin_expect(!__all(pmax <= THR2), 0)) {
      const float dl = fmaxf(pmax, 0.f); m_reg += dl; alpha = __builtin_amdgcn_exp2f(-dl);
#pragma unroll
      for (int r = 0; r < 16; ++r) p0[r] -= dl;
#pragma unroll
      for (int r = 0; r < 16; ++r) p1[r] -= dl;
    }
  }
}
__device__ __forceinline__ void expP0(f32x16& p0) {
#pragma unroll
  for (int r = 0; r < 16; ++r) p0[r] = __builtin_amdgcn_exp2f(p0[r]);
}
__device__ __forceinline__ void finishSM(f32x16& p0, f32x16& p1, float alpha, float& l_reg, bf16x8& pa0, bf16x8& pa1, bf16x8& pa2, bf16x8& pa3) {
#pragma unroll
  for (int r = 0; r < 16; ++r) p1[r] = __builtin_amdgcn_exp2f(p1[r]);
  float ps = 0;
#pragma unroll
  for (int r = 0; r < 16; ++r) ps += p0[r];
#pragma unroll
  for (int r = 0; r < 16; ++r) ps += p1[r];
  { auto rr = __builtin_amdgcn_permlane32_swap(__float_as_uint(ps), __float_as_uint(ps), false, false);
    ps = __uint_as_float(rr[0]) + __uint_as_float(rr[1]); }
  l_reg = l_reg * alpha + ps;
#define PK4(P, BASE, OUT) do { unsigned a0 = cvtpk(P[BASE + 0], P[BASE + 1]), a1 = cvtpk(P[BASE + 2], P[BASE + 3]);   \
    unsigned b0 = cvtpk(P[BASE + 4], P[BASE + 5]), b1 = cvtpk(P[BASE + 6], P[BASE + 7]);                              \
    auto r0 = __builtin_amdgcn_permlane32_swap(a0, b0, false, false); auto r1 = __builtin_amdgcn_permlane32_swap(a1, b1, false, false); \
    u32x4 w = {r0[0], r1[0], r0[1], r1[1]}; OUT = *reinterpret_cast<bf16x8*>(&w); } while (0)
  PK4(p0, 0, pa0); PK4(p0, 8, pa1); PK4(p1, 0, pa2); PK4(p1, 8, pa3);
#undef PK4
}
__device__ __forceinline__ void qkt(f32x16& p0, f32x16& p1, const char* Ks, const bf16x8* qr, int r32, int hi, bf16x8 kx0, bf16x8 kx1, bf16x8 qx) {
  p0 = __builtin_amdgcn_mfma_f32_32x32x16_bf16(kx0, qx, f32x16{}, 0, 0, 0); p1 = __builtin_amdgcn_mfma_f32_32x32x16_bf16(kx1, qx, f32x16{}, 0, 0, 0);
#pragma unroll
  for (int d0 = 0; d0 < 4; ++d0) { const int cb = d0 * 32 + hi * 16;
    bf16x8 b0 = *reinterpret_cast<const bf16x8*>(Ks + KSWZ(r32, cb));
    bf16x8 b1 = *reinterpret_cast<const bf16x8*>(Ks + KSWZ(32 + r32, cb));
    p0 = __builtin_amdgcn_mfma_f32_32x32x16_bf16(b0, qr[d0], p0, 0, 0, 0);
    p1 = __builtin_amdgcn_mfma_f32_32x32x16_bf16(b1, qr[d0], p1, 0, 0, 0); }
}
__device__ __forceinline__ int v_st(int k, int c) { const int kk = (k & ~0xC) | ((k & 4) << 1) | ((k & 8) >> 1); return ((kk >> 3) * 4 + (c >> 5)) * 512 + ((kk & 7) * 32 + (c & 31)) * 2; }
__device__ __forceinline__ int v_rd_base(int lane) { return ((lane & 3) << 3) | (((lane >> 2) & 3) << 6) | (((lane >> 4) & 1) << 5) | (((lane >> 5) & 1) << 8); }
constexpr int v_rd_off(int d0, int ks, int half) { return d0 * 512 + ks * 4096 + half * 2048; }
template <int OFF> __device__ __forceinline__ s16x4 tr_read(int vb) {
  s16x4 r; asm volatile("ds_read_b64_tr_b16 %0, %1 offset:%2" : "=&v"(r) : "v"(vb), "i"(OFF) : "memory"); return r;
}
#define PV_RDK(KS, L, H) do { L[0] = tr_read<v_rd_off(0, KS, 0)>(vb); H[0] = tr_read<v_rd_off(0, KS, 1)>(vb); L[1] = tr_read<v_rd_off(1, KS, 0)>(vb); H[1] = tr_read<v_rd_off(1, KS, 1)>(vb); \
    L[2] = tr_read<v_rd_off(2, KS, 0)>(vb); H[2] = tr_read<v_rd_off(2, KS, 1)>(vb); L[3] = tr_read<v_rd_off(3, KS, 0)>(vb); H[3] = tr_read<v_rd_off(3, KS, 1)>(vb); } while (0)
#define PV_RD2(KS, D0, L, H) do { L[D0] = tr_read<v_rd_off(D0, KS, 0)>(vb); H[D0] = tr_read<v_rd_off(D0, KS, 1)>(vb); } while (0)
#define PV_WAIT(N, L, H) asm volatile("s_waitcnt lgkmcnt(" #N ")" : "+v"(L[0]), "+v"(H[0]), "+v"(L[1]), "+v"(H[1]), "+v"(L[2]), "+v"(H[2]), "+v"(L[3]), "+v"(H[3]))
#define PV_PK(L, H, D0) (bf16x8){L[D0][0], L[D0][1], L[D0][2], L[D0][3], H[D0][0], H[D0][1], H[D0][2], H[D0][3]}
#define PV_MF(D0, PA, L, H, R) do { o[D0] = __builtin_amdgcn_mfma_f32_32x32x16_bf16(PA, PV_PK(L, H, D0), o[D0], 0, 0, 0); \
    if (EXPS) { px[R] = __builtin_amdgcn_exp2f(px[R]); asm volatile("" : "+v"(px)); } SBAR(); } while (0)
template <bool EXPS> __device__ __forceinline__ void pv_d0(f32x16* o, int vb, bf16x8 pa0, bf16x8 pa1, bf16x8 pa2, bf16x8 pa3, f32x16& px) {
  s16x4 la[4], ha[4], lb[4], hb[4];
  SBAR(); PV_RDK(0, la, ha); SBAR();
  PV_RD2(1, 0, lb, hb); PV_WAIT(2, la, ha);  PV_MF(0, pa0, la, ha, 0);
  PV_RD2(1, 1, lb, hb);                       PV_MF(1, pa0, la, ha, 1);
  PV_RD2(1, 2, lb, hb);                       PV_MF(2, pa0, la, ha, 2);
  PV_RD2(1, 3, lb, hb);                       PV_MF(3, pa0, la, ha, 3);
  PV_RD2(2, 0, la, ha); PV_WAIT(2, lb, hb);  PV_MF(0, pa1, lb, hb, 4);
  PV_RD2(2, 1, la, ha);                       PV_MF(1, pa1, lb, hb, 5);
  PV_RD2(2, 2, la, ha);                       PV_MF(2, pa1, lb, hb, 6);
  PV_RD2(2, 3, la, ha);                       PV_MF(3, pa1, lb, hb, 7);
  PV_RD2(3, 0, lb, hb); PV_WAIT(2, la, ha);  PV_MF(0, pa2, la, ha, 8);
  PV_RD2(3, 1, lb, hb);                       PV_MF(1, pa2, la, ha, 9);
  PV_RD2(3, 2, lb, hb);                       PV_MF(2, pa2, la, ha, 10);
  PV_RD2(3, 3, lb, hb);                       PV_MF(3, pa2, la, ha, 11);
                        PV_WAIT(0, lb, hb);  PV_MF(0, pa3, lb, hb, 12);
                                              PV_MF(1, pa3, lb, hb, 13);
                                              PV_MF(2, pa3, lb, hb, 14);
                                              PV_MF(3, pa3, lb, hb, 15);
}

__device__ __forceinline__ void attn_pass(const bf16_t* __restrict__ Qw, const bf16_t* __restrict__ Kh, const bf16_t* __restrict__ Vh,
                                          int NT, float dqbase, int rel0, float nc2, float smax, f32x16 (&o)[4], char* lds) {
  const int tid = mk_tid(), wid = tid >> 6, lane = tid & 63, r32 = lane & 31, hi = lane >> 5;
  char* V_lds = lds + OFF_V; char* K_lds = lds + OFF_K;
  float* ws = (float*)(lds + OFF_WS) + wid * 64; float* li_l = ws; float* al_l = ws + 32;
  float m_reg = 0.f, l_reg = 0; bf16x8 qr[4];
#pragma unroll
  for (int d = 0; d < 4; ++d) o[d] = f32x16{};
#pragma unroll
  for (int d0 = 0; d0 < 4; ++d0) qr[d0] = *reinterpret_cast<const bf16x8*>(Qw + d0 * 16);
  const float dqh0 = dqbase - (float)(4 * hi);
  bf16x8 kx0, kx1;
  { unsigned bh, bl, bll; u32x4 w;
    split3(-nc2 * (float)r32, bh, bl, bll); w = u32x4{0x3F803F80u, 0x3F80u | (bh << 16), bl | (bll << 16), 0u}; if (hi) w = u32x4{0u, 0u, 0u, 0u}; kx0 = *reinterpret_cast<bf16x8*>(&w);
    split3(-nc2 * (float)(32 + r32), bh, bl, bll); w = u32x4{0x3F803F80u, 0x3F80u | (bh << 16), bl | (bll << 16), 0u}; if (hi) w = u32x4{0u, 0u, 0u, 0u}; kx1 = *reinterpret_cast<bf16x8*>(&w); }
  bf16x8 qx; int mdA, mdB; bool skA, skB;
#define CTL(j, MD, SK) tile_ctl(rel0 + (j) * KVBLK, dqbase - (float)((j) * KVBLK), m_reg, nc2, smax, hi, qx, MD, SK)
  const int sr = tid >> 4, sc = (tid & 15) * 8, vst0 = v_st(sr, sc), vst1 = v_st(32 + sr, sc);
  const int krow = tid >> 3, kcol = (tid & 7) * 8, kst = KSWZ(krow, kcol * 2);
  const int vb0 = (int)(uintptr_t)V_lds + v_rd_base(lane);
  struct { bf16x8 vs0, vs1, ks0; } sg;
#define SLOAD(k0) do { sg.vs0 = *reinterpret_cast<const bf16x8*>(&Vh[(long)((k0) + sr) * LD + sc]); sg.vs1 = *reinterpret_cast<const bf16x8*>(&Vh[(long)((k0) + 32 + sr) * LD + sc]); \
    sg.ks0 = *reinterpret_cast<const bf16x8*>(&Kh[(long)((k0) + krow) * LD + kcol]); } while (0)
#define SWRITE(b) do { *(bf16x8*)(V_lds + (b) * SHM_V + vst0) = sg.vs0; *(bf16x8*)(V_lds + (b) * SHM_V + vst1) = sg.vs1; *(bf16x8*)(K_lds + (b) * SHM_K + kst) = sg.ks0; } while (0)
#define SWAIT() asm volatile("s_waitcnt vmcnt(0)" ::: "memory")
#define RESC(a) do { if (__any((a) < 1.f)) { if (hi == 0) al_l[r32] = (a); asm volatile("s_waitcnt lgkmcnt(0)" ::: "memory"); \
    _Pragma("unroll") for (int d = 0; d < 4; ++d) _Pragma("unroll") for (int r = 0; r < 16; ++r) o[d][r] *= al_l[crow(r, hi)]; } } while (0)
  f32x16 pA0, pA1, pB0, pB1; float alA, alB; bf16x8 pa0, pa1, pa2, pa3;
  int b_prev = 0, b_cur = 1, b_next = 2;
#define ROT() do { const int t_ = b_prev; b_prev = b_cur; b_cur = b_next; b_next = t_; } while (0)
#define STEP(j, X0, X1, Y0, Y1, MDX, SKX, ALX, ALY, WR, LD_) do { SBAR(); \
    if (WR) { SWAIT(); SWRITE(b_next); } if (LD_) SLOAD(((j) + 2) * KVBLK); SBAR(); \
    CTL(j, MDX, SKX); qkt(X0, X1, K_lds + b_cur * SHM_K, qr, r32, hi, kx0, kx1, qx); \
    finishSM(Y0, Y1, ALY, l_reg, pa0, pa1, pa2, pa3); SBAR(); \
    partialSM(X0, X1, m_reg, ALX, MDX, SKX, dqh0 - (float)((j) * KVBLK), nc2); SBAR(); \
    pv_d0<true>(o, vb0 + b_prev * SHM_V, pa0, pa1, pa2, pa3, X0); \
    RESC(ALX); __syncthreads(); } while (0)
  __syncthreads();
  SLOAD(0); SWAIT(); SWRITE(0); SLOAD(KVBLK); __syncthreads();
  SWAIT(); SWRITE(1); if (2 < NT) SLOAD(2 * KVBLK);
  CTL(0, mdA, skA); qkt(pA0, pA1, K_lds, qr, r32, hi, kx0, kx1, qx); partialSM(pA0, pA1, m_reg, alA, mdA, skA, dqh0, nc2); expP0(pA0);
  __syncthreads();
  for (int j = 1; j + 1 < NT; j += 2) {
    STEP(j, pB0, pB1, pA0, pA1, mdB, skB, alB, alA, true, true); ROT();
    STEP(j + 1, pA0, pA1, pB0, pB1, mdA, skA, alA, alB, true, (j + 3 < NT)); ROT();
  }
  STEP(NT - 1, pB0, pB1, pA0, pA1, mdB, skB, alB, alA, false, false); ROT();
  finishSM(pB0, pB1, alB, l_reg, pa0, pa1, pa2, pa3); SBAR();
  pv_d0<false>(o, vb0 + b_prev * SHM_V, pa0, pa1, pa2, pa3, pB0);
  if (hi == 0) li_l[r32] = l_reg; asm volatile("s_waitcnt lgkmcnt(0)" ::: "memory");
#pragma unroll
  for (int r = 0; r < 16; ++r) { const float rli = __builtin_amdgcn_rcpf(li_l[crow(r, hi)]);
#pragma unroll
    for (int d0 = 0; d0 < 4; ++d0) o[d0][r] *= rli; }
#undef CTL
#undef STEP
#undef ROT
#undef SLOAD
#undef SWRITE
#undef SWAIT
#undef RESC
}
}

typedef unsigned short bf16;
typedef unsigned v4u __attribute__((ext_vector_type(4)));
typedef unsigned v2u __attribute__((ext_vector_type(2)));
typedef float f32x4 __attribute__((ext_vector_type(4)));
#define LAS __attribute__((address_space(3)))
constexpr int NWAVES = 8, NTHREADS = 512;
constexpr int D = 1024, FF = 4096, MG = 16384, MTOT = 32768;
constexpr int DEPTH = 4;
constexpr float QSCALE = 0.125f * 1.4426950408889634f;
constexpr size_t MiB = 1u << 20;
constexpr size_t WS_CTL = 0, WS_ZERO_END = 64 * 1024;
constexpr size_t WS_WMI = 2 * MiB, WS_WMO = 10 * MiB, WS_WQKV = 14 * MiB, WS_WAO = 26 * MiB, WS_W1 = 30 * MiB, WS_W2 = 62 * MiB;
constexpr size_t WS_XB = 94 * MiB, WS_BIG = 126 * MiB, WS_ROWSQ = 254 * MiB, WS_END = WS_ROWSQ + 9 * (size_t)MG * 64;
static_assert(WS_ZERO_END <= WS_WMI, "ws map");
constexpr int CW_ATTCTR = 0;
constexpr int CW_ARR = 8192;
constexpr int CW_BAR = 4096;
constexpr int CW_NRM = 1024;

struct Args {
    const float* in[19]; float* out; unsigned char* ws; int ph_lo, ph_hi;
};

__device__ __forceinline__ unsigned f2bf(float f) { unsigned u = __builtin_bit_cast(unsigned, f); return (u + 0x7fffu + ((u >> 16) & 1u)) >> 16; }
__device__ __forceinline__ unsigned pk2(float lo, float hi) { return f2bf(lo) | (f2bf(hi) << 16); }
__device__ __forceinline__ float bflo(unsigned w) { return __uint_as_float(w << 16); }
__device__ __forceinline__ float bfhi(unsigned w) { return __uint_as_float(w & 0xffff0000u); }
__device__ __forceinline__ float wave_sum(float v) {
    v += xor_lt32<1>(v); v += xor_lt32<2>(v); v += xor_lt32<4>(v); v += xor_lt32<8>(v); v += xor_lt32<16>(v);
    return sum_x32(v);
}

__device__ __forceinline__ void transpose_item(const float* W, int ldw, int N, const float* gs, bf16* WT, int ldk, int koff, LAS float* scr, int item, int lane) {
    const int nblk = N / 32, kb = item / nblk, nb = item % nblk, k0 = 64 * kb, n0 = 32 * nb;
#pragma unroll
    for (int i = 0; i < 8; ++i) { const int kk = 8 * i + (lane >> 3), c4 = (lane & 7) * 4;
        f32x4 v = *(const f32x4*)(W + (size_t)(k0 + kk) * ldw + n0 + c4); if (gs) v = v * gs[k0 + kk];
        scr[kk * 33 + c4] = v[0]; scr[kk * 33 + c4 + 1] = v[1]; scr[kk * 33 + c4 + 2] = v[2]; scr[kk * 33 + c4 + 3] = v[3]; }
    asm volatile("s_waitcnt lgkmcnt(0)" ::: "memory");
    const int c = lane & 7;
#pragma unroll
    for (int j = 0; j < 4; ++j) { const int n = (lane >> 3) + 8 * j; const LAS float* s = scr + (8 * c) * 33 + n;
        v4u o; o.x = pk2(s[0 * 33], s[1 * 33]); o.y = pk2(s[2 * 33], s[3 * 33]); o.z = pk2(s[4 * 33], s[5 * 33]); o.w = pk2(s[6 * 33], s[7 * 33]);
        *(v4u*)(WT + (size_t)(n0 + n) * ldk + koff + k0 + 8 * c) = o; }
    asm volatile("s_waitcnt lgkmcnt(0)" ::: "memory");
}

__device__ __forceinline__ void phase_prologue(const Args& a, LAS unsigned char* lds) {
    const int tid = mk_tid(), lane = tid & 63, wave = tid >> 6;
    const int gt = blockIdx.x * NTHREADS + tid, NGT = gridDim.x * NTHREADS;
    const int gw = blockIdx.x * NWAVES + wave, NGW = gridDim.x * NWAVES;
    { v4u z = {0u, 0u, 0u, 0u}; v4u* p = (v4u*)(a.ws + WS_CTL); for (int i = gt; i < (int)(WS_ZERO_END / 16); i += NGT) p[i] = z; }
    LAS float* scr = (LAS float*)(lds + wave * 16384);
    const float* norm1_g = a.in[2]; const float* norm2_g = a.in[3];
    constexpr int I_MI = 16 * 64, I_MO = 8 * 32, I_QKV = 16 * 96, I_AO = 16 * 32, I_W1 = 16 * 128, I_W2 = 64 * 32;
    constexpr int T_MI = 2 * I_MI, T_MO = T_MI + 2 * I_MO, T_QKV = T_MO + 2 * I_QKV, T_AO = T_QKV + 2 * I_AO, T_W1 = T_AO + 4 * I_W1, T_W2 = T_W1 + 4 * I_W2;
    for (int it = gw; it < T_W2; it += NGW) {
        if (it < T_MI) { const int j = it / I_MI, r = it % I_MI;
            transpose_item(a.in[5] + (size_t)j * D * 2048, 2048, 2048, norm1_g + (2 * j) * D, (bf16*)(a.ws + WS_WMI) + (size_t)j * 2048 * D, D, 0, scr, r, lane); }
        else if (it < T_MO) { const int q = it - T_MI, j = q / I_MO, r = q % I_MO;
            transpose_item(a.in[9] + (size_t)j * D * D + (size_t)512 * D, D, D, nullptr, (bf16*)(a.ws + WS_WMO) + (size_t)j * D * D, D, 512, scr, r, lane); }
        else if (it < T_QKV) { const int q = it - T_MO, j = q / I_QKV, r = q % I_QKV;
            transpose_item(a.in[10] + (size_t)j * D * 3072, 3072, 3072, norm1_g + (2 * j + 1) * D, (bf16*)(a.ws + WS_WQKV) + (size_t)j * 3072 * D, D, 0, scr, r, lane); }
        else if (it < T_AO) { const int q = it - T_QKV, j = q / I_AO, r = q % I_AO;
            transpose_item(a.in[11] + (size_t)j * D * D, D, D, nullptr, (bf16*)(a.ws + WS_WAO) + (size_t)j * D * D, D, 0, scr, r, lane); }
        else if (it < T_W1) { const int q = it - T_AO, i = q / I_W1, r = q % I_W1;
            transpose_item(a.in[17] + (size_t)i * D * FF, FF, FF, norm2_g + i * D, (bf16*)(a.ws + WS_W1) + (size_t)i * FF * D, D, 0, scr, r, lane); }
        else { const int q = it - T_W1, i = q / I_W2, r = q % I_W2;
            transpose_item(a.in[18] + (size_t)i * FF * D, D, D, nullptr, (bf16*)(a.ws + WS_W2) + (size_t)i * D * FF, FF, 0, scr, r, lane); }
    }
    for (int it = gw; it < 2 * 4 * 16 * 16; it += NGW) {
        const int cb = it & 15, nb = (it >> 4) & 15, g = (it >> 8) & 3, j = it >> 10;
        const float* pw = a.in[6] + ((size_t)(j * 4 + g) * 128 + cb * 8) * 128;
        const float* ps = a.in[7] + j * 512 + g * 128;
        const float* mo = a.in[9] + (size_t)j * D * D + (size_t)(g * 128) * D + nb * 64 + lane;
        float acc[8];
#pragma unroll
        for (int c = 0; c < 8; ++c) acc[c] = 0.f;
#pragma unroll 8
        for (int d = 0; d < 128; ++d) {
            const float m = mo[(size_t)d * D] * ps[d];
#pragma unroll
            for (int c = 0; c < 8; ++c) acc[c] = fmaf(pw[c * 128 + d], m, acc[c]);
        }
        v4u o; o.x = pk2(acc[0], acc[1]); o.y = pk2(acc[2], acc[3]); o.z = pk2(acc[4], acc[5]); o.w = pk2(acc[6], acc[7]);
        *(v4u*)((bf16*)(a.ws + WS_WMO) + (size_t)j * D * D + (size_t)(nb * 64 + lane) * D + g * 128 + cb * 8) = o;
    }
}

__device__ __forceinline__ void phase_prep(const Args& a, int g) {
    const int tid = mk_tid(), lane = tid & 63, gw = blockIdx.x * NWAVES + (tid >> 6), NGW = gridDim.x * NWAVES;
    const float* xin = g ? a.in[1] : a.in[0]; float* xo = a.out + (size_t)g * MG * D; bf16* xb = (bf16*)(a.ws + WS_XB); float* rsq = (float*)(a.ws + WS_ROWSQ);
    for (int m = gw; m < MG; m += NGW) {
        const f32x4* xr = (const f32x4*)(xin + (size_t)m * D) + lane; f32x4* orow = (f32x4*)(xo + (size_t)m * D) + lane; v2u* brow = (v2u*)(xb + (size_t)m * D) + lane;
        float s = 0.f;
#pragma unroll
        for (int j = 0; j < 4; ++j) { const f32x4 v = xr[64 * j]; orow[64 * j] = v; s += (v[0] * v[0] + v[1] * v[1]) + (v[2] * v[2] + v[3] * v[3]);
            v2u w; w.x = pk2(v[0], v[1]); w.y = pk2(v[2], v[3]); brow[64 * j] = w; }
        s = wave_sum(s);
        if (lane < 16) rsq[(size_t)m * 16 + lane] = lane == 0 ? s : 0.f;
    }
}
__device__ __forceinline__ void phase_final(const Args& a, int g) {
    const int tid = mk_tid(), lane = tid & 63, gw = blockIdx.x * NWAVES + (tid >> 6), NGW = gridDim.x * NWAVES;
    float* xo = a.out + (size_t)g * MG * D; const float* rsq = (const float*)(a.ws + WS_ROWSQ) + (size_t)8 * MG * 16; const f32x4* fg = (const f32x4*)a.in[4] + lane;
    for (int m = gw; m < MG; m += NGW) {
        float rsum;
        { const f32x4* rp = (const f32x4*)(rsq + (size_t)m * 16); const f32x4 a0 = rp[0], a1 = rp[1], a2 = rp[2], a3 = rp[3];
          rsum = (((a0[0] + a0[1]) + (a0[2] + a0[3])) + ((a1[0] + a1[1]) + (a1[2] + a1[3]))) + (((a2[0] + a2[1]) + (a2[2] + a2[3])) + ((a3[0] + a3[1]) + (a3[2] + a3[3]))); }
        const float rs = __builtin_amdgcn_rsqf(rsum * (1.0f / 1024.0f) + 1e-6f);
        f32x4* orow = (f32x4*)(xo + (size_t)m * D) + lane;
#pragma unroll
        for (int j = 0; j < 4; ++j) { f32x4 v = orow[64 * j]; const f32x4 gg = fg[64 * j]; v = v * rs * gg; orow[64 * j] = v; }
    }
}

__device__ __forceinline__ void unpack8(const v4u w, float (&f)[8]) {
    f[0] = bflo(w.x); f[1] = bfhi(w.x); f[2] = bflo(w.y); f[3] = bfhi(w.y); f[4] = bflo(w.z); f[5] = bfhi(w.z); f[6] = bflo(w.w); f[7] = bfhi(w.w);
}
__device__ __forceinline__ void phase_stencil(const Args& a, int g, int j) {
    const int S = g ? 16384 : 8192;
    const bf16* P = (const bf16*)(a.ws + WS_BIG); bf16* A2 = (bf16*)(a.ws + WS_BIG + 64 * MiB);
    const int tid = mk_tid(), chunk = tid & 127, tb = tid >> 7;
    for (int tile = blockIdx.x; tile < MG / 64; tile += gridDim.x) {
        const int row0 = tile * 64 + tb * 16;
        const int b0 = row0 & ~(S - 1), t0 = row0 & (S - 1);
        if (chunk < 64) {
            const int c0 = chunk * 8, hw = 1 << (chunk >> 4);
            const bf16* U = P + (size_t)b0 * 2048 + c0;
            float sum[8];
#pragma unroll
            for (int e = 0; e < 8; ++e) sum[e] = 0.f;
            { const int lo = max(t0 - hw, 0), hi = min(t0 + hw, S);
              for (int t = lo; t < hi; ++t) { float f[8]; unpack8(*(const v4u*)(U + (size_t)t * 2048), f);
#pragma unroll
                  for (int e = 0; e < 8; ++e) sum[e] += f[e]; } }
            for (int i = 0; i < 16; ++i) {
                const int t = t0 + i; const int lo = max(t - hw, 0), hi = min(t + hw, S);
                const float rc = 1.0f / (float)(hi - lo);
                float f[8]; unpack8(*(const v4u*)(U + (size_t)t * 2048), f);
                v4u o; o.x = pk2(sum[0] * rc - f[0], sum[1] * rc - f[1]); o.y = pk2(sum[2] * rc - f[2], sum[3] * rc - f[3]);
                o.z = pk2(sum[4] * rc - f[4], sum[5] * rc - f[5]); o.w = pk2(sum[6] * rc - f[6], sum[7] * rc - f[7]);
                *(v4u*)(A2 + (size_t)(b0 + t) * 1024 + c0) = o;
                if (t + hw < S) { float n[8]; unpack8(*(const v4u*)(U + (size_t)(t + hw) * 2048), n);
#pragma unroll
                    for (int e = 0; e < 8; ++e) sum[e] += n[e]; }
                if (t - hw >= 0) { float n[8]; unpack8(*(const v4u*)(U + (size_t)(t - hw) * 2048), n);
#pragma unroll
                    for (int e = 0; e < 8; ++e) sum[e] -= n[e]; }
            }
        } else {
            const int c0 = (chunk - 64) * 8;
            const bf16* Hc = P + (size_t)b0 * 2048 + 512 + c0; const bf16* Gb = Hc + 512; const bf16* Gc = Hc + 1024;
            const float* cw = a.in[8] + (size_t)j * 3 * 512 + c0;
            float w0[8], w1[8], w2[8];
#pragma unroll
            for (int e = 0; e < 8; ++e) { w0[e] = cw[e]; w1[e] = cw[512 + e]; w2[e] = cw[1024 + e]; }
            float zp[8], zc[8];
            if (t0 > 0) { float hh[8], cc[8]; unpack8(*(const v4u*)(Hc + (size_t)(t0 - 1) * 2048), hh); unpack8(*(const v4u*)(Gc + (size_t)(t0 - 1) * 2048), cc);
#pragma unroll
                for (int e = 0; e < 8; ++e) zp[e] = hh[e] * cc[e]; }
            else {
#pragma unroll
                for (int e = 0; e < 8; ++e) zp[e] = 0.f; }
            { float hh[8], cc[8]; unpack8(*(const v4u*)(Hc + (size_t)t0 * 2048), hh); unpack8(*(const v4u*)(Gc + (size_t)t0 * 2048), cc);
#pragma unroll
              for (int e = 0; e < 8; ++e) zc[e] = hh[e] * cc[e]; }
            for (int i = 0; i < 16; ++i) {
                const int t = t0 + i; float zn[8];
                if (t + 1 < S) { float hh[8], cc[8]; unpack8(*(const v4u*)(Hc + (size_t)(t + 1) * 2048), hh); unpack8(*(const v4u*)(Gc + (size_t)(t + 1) * 2048), cc);
#pragma unroll
                    for (int e = 0; e < 8; ++e) zn[e] = hh[e] * cc[e]; }
                else {
#pragma unroll
                    for (int e = 0; e < 8; ++e) zn[e] = 0.f; }
                float gb[8], r[8]; unpack8(*(const v4u*)(Gb + (size_t)t * 2048), gb);
#pragma unroll
                for (int e = 0; e < 8; ++e) r[e] = gb[e] * (w0[e] * zp[e] + w1[e] * zc[e] + w2[e] * zn[e]);
                v4u o; o.x = pk2(r[0], r[1]); o.y = pk2(r[2], r[3]); o.z = pk2(r[4], r[5]); o.w = pk2(r[6], r[7]);
                *(v4u*)(A2 + (size_t)(b0 + t) * 1024 + 512 + c0) = o;
#pragma unroll
                for (int e = 0; e < 8; ++e) { zp[e] = zc[e]; zc[e] = zn[e]; }
            }
        }
    }
}

__device__ __forceinline__ void phase_attention(const Args& a, int g, int layer, char* lds) {
    using namespace att;
    const int S = g ? 16384 : 8192, logS = g ? 14 : 13; const int j = layer >> 1;
    const bf16* Qb = (const bf16*)(a.ws + WS_BIG); const bf16* Kb = Qb + (size_t)MG * 1024; const bf16* Vb = Kb + (size_t)MG * 1024; bf16* Ob = (bf16*)(a.ws + WS_BIG);
    unsigned* ctr = (unsigned*)(a.ws + WS_CTL) + CW_ATTCTR + 64 * (g * 2 + j);
    unsigned* arr = (unsigned*)(a.ws + WS_CTL) + CW_ARR + 1024 * (g * 2 + j);
    const unsigned* nrm = (const unsigned*)(a.ws + WS_CTL) + CW_NRM + 256 * (g * 2 + j);
    volatile unsigned* s_unit = (volatile unsigned*)(lds + OFF_UNIT);
    const float lambda_init = (layer == 1) ? 0.35550906759096926f : 0.5560582041556405f;
    float lam;
    { const float* q1 = a.in[12] + j * 64; const float* k1 = a.in[13] + j * 64; const float* q2 = a.in[14] + j * 64; const float* k2 = a.in[15] + j * 64;
      const int lane = mk_tid() & 63; float s1 = q1[lane] * k1[lane], s2 = q2[lane] * k2[lane]; s1 = wave_sum(s1); s2 = wave_sum(s2); lam = __expf(s1) - __expf(s2) + lambda_init; }
    const float* subg = a.in[16] + j * 128;
    for (;;) {
        const int tid = mk_tid(), wid = tid >> 6, lane = tid & 63, r32 = lane & 31, hi = lane >> 5;
        __syncthreads();
        if (tid == 0) s_unit[0] = atomicAdd(ctr, 1u);
        __syncthreads();
        const int tk = (int)s_unit[0];
        if (tk >= 1024 * MK_DUP_ATT) break;
        const int u = tk / MK_DUP_ATT; const bool dup = (tk % MK_DUP_ATT) != 0;
        const int h = 7 - (u >> 7), qbi = (u >> 1) & 63, pass = u & 1, uid = u >> 1;
        const int b = (qbi * 256) >> logS, q0 = (qbi * 256) & (S - 1);
        const size_t rowbase = (size_t)b * S;
        const float slope2 = __builtin_amdgcn_exp2f(-(float)(h + 1)) * 1.4426950408889634f;
        const int qpos = q0 + wid * QBLK + r32;
        f32x16 o[4];
        {
            const int map = 2 * h + pass;
            int klo = 0, khi = S; float smax;
            { const unsigned* nq = nrm + ((0 * 2 + b) * 16 + map) * 2; const unsigned* nk = nrm + ((1 * 2 + b) * 16 + map) * 2;
              const float qn2 = __uint_as_float(__hip_atomic_load(nq, __ATOMIC_RELAXED, __HIP_MEMORY_SCOPE_AGENT)) + __uint_as_float(__hip_atomic_load(nq + 1, __ATOMIC_RELAXED, __HIP_MEMORY_SCOPE_AGENT));
              const float kn2 = __uint_as_float(__hip_atomic_load(nk, __ATOMIC_RELAXED, __HIP_MEMORY_SCOPE_AGENT)) + __uint_as_float(__hip_atomic_load(nk + 1, __ATOMIC_RELAXED, __HIP_MEMORY_SCOPE_AGENT));
              smax = sqrtf(qn2 * kn2) * 1.02f;
#if MK_WINDOW
              float sown;
              { const bf16* qp = Qb + (rowbase + q0 + wid * QBLK + r32) * 1024 + map * 64 + hi * 32; const bf16* kp = Kb + (rowbase + q0 + wid * QBLK + r32) * 1024 + map * 64 + hi * 32;
                float acc = 0.f, qq = 0.f;
#pragma unroll
                for (int c = 0; c < 4; ++c) { const v4u qa = *(const v4u*)(qp + c * 8), ka = *(const v4u*)(kp + c * 8);
                    acc += bflo(qa.x) * bflo(ka.x) + bfhi(qa.x) * bfhi(ka.x) + bflo(qa.y) * bflo(ka.y) + bfhi(qa.y) * bfhi(ka.y)
                         + bflo(qa.z) * bflo(ka.z) + bfhi(qa.z) * bfhi(ka.z) + bflo(qa.w) * bflo(ka.w) + bfhi(qa.w) * bfhi(ka.w);
                    qq += bflo(qa.x) * bflo(qa.x) + bfhi(qa.x) * bfhi(qa.x) + bflo(qa.y) * bflo(qa.y) + bfhi(qa.y) * bfhi(qa.y)
                        + bflo(qa.z) * bflo(qa.z) + bfhi(qa.z) * bfhi(qa.z) + bflo(qa.w) * bflo(qa.w) + bfhi(qa.w) * bfhi(qa.w); }
                acc = sum_x32(acc); qq = sum_x32(qq);
                acc = fminf(acc, xor_lt32<1>(acc)); acc = fminf(acc, xor_lt32<2>(acc)); acc = fminf(acc, xor_lt32<4>(acc)); acc = fminf(acc, xor_lt32<8>(acc)); acc = fminf(acc, xor_lt32<16>(acc));
                qq = fmaxf(qq, xor_lt32<1>(qq)); qq = fmaxf(qq, xor_lt32<2>(qq)); qq = fmaxf(qq, xor_lt32<4>(qq)); qq = fmaxf(qq, xor_lt32<8>(qq)); qq = fmaxf(qq, xor_lt32<16>(qq));
                float* wmin = (float*)(lds + OFF_UNIT) + 8;
                if (lane == 0) { wmin[wid] = acc; wmin[8 + wid] = qq; }
                __syncthreads();
                sown = fminf(fminf(fminf(wmin[0], wmin[1]), fminf(wmin[2], wmin[3])), fminf(fminf(wmin[4], wmin[5]), fminf(wmin[6], wmin[7])));
                sown = fminf(sown, 0.f) - 0.25f;
                const float qu2 = fmaxf(fmaxf(fmaxf(wmin[8], wmin[9]), fmaxf(wmin[10], wmin[11])), fmaxf(fmaxf(wmin[12], wmin[13]), fmaxf(wmin[14], wmin[15])));
                smax = fminf(smax, sqrtf(qu2 * kn2) * 1.02f);
              }
              const float wf = (smax - sown + 24.f) / slope2;
              const int wi = (wf < (float)S) ? (int)wf + 1 : S;
              klo = max(q0 - wi, 0) & ~127; khi = min((q0 + 256 + wi + 127) & ~127, S);
#endif
            }
            const int NT = (khi - klo) >> 6;
            const bf16* Qw = Qb + (rowbase + q0 + wid * QBLK + r32) * 1024 + map * 64 + hi * 8;
            const bf16* Kh = Kb + (rowbase + klo) * 1024 + map * 64;
            const bf16* Vh = Vb + (rowbase + klo) * 1024 + h * 128;
            attn_pass(Qw, Kh, Vh, NT, (float)(qpos - klo), klo - (q0 + __builtin_amdgcn_readfirstlane(wid) * QBLK), -slope2, smax, o, lds);
        }
        if (dup) continue;
        const int t2 = mk_tid(); const int r32b = t2 & 31, hib = (t2 >> 5) & 1, widb = t2 >> 6;
        if (t2 == 0) s_unit[1] = atomicAdd(arr + 2 * uid, 1u);
        __syncthreads();
        const unsigned first = s_unit[1];
        f32x4* sp = (f32x4*)(uid < 256 ? (float*)(a.ws + WS_XB) + (size_t)uid * 32768 : (float*)(a.ws + WS_BIG + 96 * MiB) + (size_t)(uid - 256) * 32768) + t2;
        if (first == 0u) {
#pragma unroll
            for (int d0 = 0; d0 < 4; ++d0)
#pragma unroll
                for (int q = 0; q < 4; ++q) {
                    const f32x4 w = {o[d0][4 * q], o[d0][4 * q + 1], o[d0][4 * q + 2], o[d0][4 * q + 3]};
                    asm volatile("global_store_dwordx4 %0, %1, off sc1" :: "v"(sp + (d0 * 4 + q) * 512), "v"(w) : "memory");
                }
            asm volatile("s_waitcnt vmcnt(0)" ::: "memory");
            __syncthreads();
            if (t2 == 0) __hip_atomic_store(arr + 2 * uid + 1, 1u, __ATOMIC_RELAXED, __HIP_MEMORY_SCOPE_AGENT);
            continue;
        }
        if (t2 == 0) { unsigned spn = 0; while (__hip_atomic_load(arr + 2 * uid + 1, __ATOMIC_RELAXED, __HIP_MEMORY_SCOPE_AGENT) == 0u) { __builtin_amdgcn_s_sleep(2); if (++spn > (1u << 24)) break; } }
        __syncthreads();
        float ssq[16];
#pragma unroll
        for (int r = 0; r < 16; ++r) ssq[r] = 0.f;
        f32x4 w[16];
#pragma unroll
        for (int i = 0; i < 16; ++i) asm volatile("global_load_dwordx4 %0, %1, off sc1" : "=v"(w[i]) : "v"(sp + i * 512) : "memory");
        asm volatile("s_waitcnt vmcnt(0)" : "+v"(w[0]), "+v"(w[1]), "+v"(w[2]), "+v"(w[3]), "+v"(w[4]), "+v"(w[5]), "+v"(w[6]), "+v"(w[7]),
                                             "+v"(w[8]), "+v"(w[9]), "+v"(w[10]), "+v"(w[11]), "+v"(w[12]), "+v"(w[13]), "+v"(w[14]), "+v"(w[15]) :: "memory");
#pragma unroll
        for (int d0 = 0; d0 < 4; ++d0)
#pragma unroll
            for (int q = 0; q < 4; ++q) {
#pragma unroll
                for (int e = 0; e < 4; ++e) { const int r = 4 * q + e; const float t = w[d0 * 4 + q][e]; const float v = pass ? (t - lam * o[d0][r]) : (o[d0][r] - lam * t);
                    o[d0][r] = v; ssq[r] = fmaf(v, v, ssq[r]); } }
#pragma unroll
        for (int r = 0; r < 16; ++r) {
            float s = ssq[r];
            s += xor_lt32<1>(s); s += xor_lt32<2>(s); s += xor_lt32<4>(s); s += xor_lt32<8>(s); s += xor_lt32<16>(s);
            ssq[r] = __builtin_amdgcn_rsqf(s * (1.0f / 128.0f) + 1e-5f) * (1.0f - lambda_init);
        }
        bf16* Ow = Ob + (rowbase + q0 + widb * QBLK + 4 * hib) * 1024 + h * 128 + r32b;
#pragma unroll
        for (int d0 = 0; d0 < 4; ++d0) { const float gg = subg[d0 * 32 + r32b];
#pragma unroll
            for (int r = 0; r < 16; ++r) Ow[(size_t)crow(r, 0) * 1024 + d0 * 32] = (bf16)f2bf(o[d0][r] * ssq[r] * gg); }
    }
}


#define XB_TMO      128
#define XB_XCNT(j)  (256  + 64 * (j))
#define XB_XSUB(j)  (1280 + 64 * (j))
#define XB_XGEN(j)  (2304 + 64 * (j))
#define XB_TOP      3328
#define XB_TOPGEN   3392
#define XCD_BAR_WORDS 3456
#define XB_SPIN_CAP (1u << 22)
__device__ __forceinline__ unsigned xb_ld(unsigned* p)              { return __hip_atomic_load(p, __ATOMIC_RELAXED, __HIP_MEMORY_SCOPE_AGENT); }
__device__ __forceinline__ unsigned xb_add(unsigned* p, unsigned v) { return __hip_atomic_fetch_add(p, v, __ATOMIC_RELAXED, __HIP_MEMORY_SCOPE_AGENT); }
__device__ __forceinline__ unsigned xb_xcc_id() { return (unsigned)__builtin_amdgcn_s_getreg((3 << 11) | 20) & 0xFu; }
#define XB_SPIN(cond, bar) do { unsigned _sp = 0; while (cond) { __builtin_amdgcn_s_sleep(1); \
    if ((++_sp & 255u) == 0u) { if (xb_ld(&(bar)[XB_TMO])) break; if (_sp > XB_SPIN_CAP) { atomicAdd(&(bar)[XB_TMO], 1u); break; } } } } while (0)
struct XcdBarrier { unsigned* bar; unsigned x; volatile LAS unsigned* st; };
__device__ __forceinline__ XcdBarrier xcd_barrier_post(unsigned* bar, volatile LAS unsigned* st) {
    XcdBarrier b; b.bar = bar; b.x = xb_xcc_id(); b.st = st;
    if (mk_tid() == 0) (void)xb_add(&bar[XB_XCNT(b.x)], 1u);
    return b;
}
__device__ __forceinline__ void xcd_barrier_complete(unsigned* bar, unsigned x, unsigned& nloc, unsigned& nx) {
    const unsigned G = gridDim.x * gridDim.y * gridDim.z;
    unsigned sum, cnt, mine, sp = 0u;
    for (;;) {
        sum = 0u; cnt = 0u; mine = 0u;
#pragma unroll
        for (unsigned j = 0; j < 16; ++j) { const unsigned c = xb_ld(&bar[XB_XCNT(j)]); sum += c; cnt += (c > 0u) ? 1u : 0u; mine = (j == x) ? c : mine; }
        if (sum == G) break;
        __builtin_amdgcn_s_sleep(1);
        if ((++sp & 255u) == 0u) { if (xb_ld(&bar[XB_TMO])) break; if (sp > XB_SPIN_CAP) { atomicAdd(&bar[XB_TMO], 1u); break; } }
    }
    nloc = mine > 0u ? mine : 1u; nx = cnt > 0u ? cnt : 1u;
}
__device__ __forceinline__ void xcd_barrier(const XcdBarrier& b) {
    asm volatile("s_waitcnt vmcnt(0)" ::: "memory");
    __syncthreads();
    if (mk_tid() == 0) {
        unsigned* bar = b.bar;
        __builtin_amdgcn_s_waitcnt(0);
        unsigned nloc = b.st[0], nx = b.st[1];
        if (nloc == 0u) { xcd_barrier_complete(bar, b.x, nloc, nx); b.st[0] = nloc; b.st[1] = nx; }
        const unsigned old = xb_add(&bar[XB_XSUB(b.x)], 1u);
        const unsigned gen = old / nloc;
        if (old + 1u == (gen + 1u) * nloc) {
            __builtin_amdgcn_fence(__ATOMIC_RELEASE, "agent");
            asm volatile("s_waitcnt vmcnt(0)" ::: "memory");
            const unsigned og = xb_add(&bar[XB_TOP], 1u);
            const unsigned tg = og / nx;
            if (og + 1u == (tg + 1u) * nx) xb_add(&bar[XB_TOPGEN], 1u);
            else XB_SPIN(xb_ld(&bar[XB_TOPGEN]) == tg, bar);
            __builtin_amdgcn_fence(__ATOMIC_ACQUIRE, "agent");
            xb_add(&bar[XB_XGEN(b.x)], 1u);
            asm volatile("s_waitcnt vmcnt(0)" ::: "memory");
        } else {
            XB_SPIN(xb_ld(&bar[XB_XGEN(b.x)]) == gen, bar);
            __builtin_amdgcn_fence(__ATOMIC_ACQUIRE, "agent");
            asm volatile("s_waitcnt vmcnt(0)" ::: "memory");
        }
    }
    __syncthreads();
}

constexpr int LDS_BYTES = 147456;
constexpr int N_PHASES = 1 + 2 * (4 * 5 + 1);
#ifndef MK_MASK
#define MK_MASK 0xFFFF
#endif
#define EN(k) ((MK_MASK >> (k)) & 1)

__global__ void __launch_bounds__(NTHREADS, 2) fwd_megakernel(Args args) {
    extern __shared__ __attribute__((aligned(16))) unsigned char lds[];
    cg::grid_group grid = cg::this_grid();
    const int lo = args.ph_lo, hi = args.ph_hi;
    int ph = 0;
#define RUN() (ph >= lo && ph < hi)
#if MK_PROBE
    unsigned long long t_last = __builtin_amdgcn_s_memrealtime(), t_a = 0, t_b = 0;
#define SEAMK(k) do { if (ph >= lo && ph + 1 < hi) grid.sync(); ++ph; { const unsigned long long t_now = __builtin_amdgcn_s_memrealtime(); \
        if ((MK_PROBE_A >> (k)) & 1) t_a += t_now - t_last; if ((MK_PROBE_B >> (k)) & 1) t_b += t_now - t_last; t_last = t_now; } } while (0)
#else
#define SEAMK(k) do { if (ph >= lo && ph + 1 < hi) { if (ph == 0) { grid.sync(); xbar = xcd_barrier_post((unsigned*)(ws + WS_CTL) + CW_BAR, xst); } else xcd_barrier(xbar); } ++ph; } while (0)
#endif
#define SEAM() SEAMK(0)
    unsigned char* ws = args.ws;
    volatile LAS unsigned* xst = (volatile LAS unsigned*)((LAS unsigned char*)lds + 131072 + 256);
    if (mk_tid() == 0) { xst[0] = 0u; xst[1] = 0u; }
    __syncthreads();
    XcdBarrier xbar; xbar.bar = (unsigned*)(ws + WS_CTL) + CW_BAR; xbar.x = 0; xbar.st = xst;
    PG8_LAS unsigned char* glds = (PG8_LAS unsigned char*)lds;
    const int G = gridDim.x, c = blockIdx.x;

    if (EN(0) && RUN()) { _Pragma("unroll 1") for (int rep = 0; rep < 1 + (MK_DUP_MISC & 1); ++rep) { phase_prologue(args, (LAS unsigned char*)lds); __syncthreads(); }
                          phase_prep(args, 0); }
    SEAMK(1);
#pragma unroll 1
    for (int g = 0; g < 2; ++g) {
        float* xg = args.out + (size_t)g * MG * D; bf16* XB = (bf16*)(ws + WS_XB);
        float* rsq_base = (float*)(ws + WS_ROWSQ);
#pragma unroll 1
        for (int i = 0; i < DEPTH; ++i) {
            const int j = i >> 1;
            float* rsq_n1 = rsq_base + (size_t)(2 * i) * MG * 16; float* rsq_n2 = rsq_base + (size_t)(2 * i + 1) * MG * 16; float* rsq_nx = rsq_base + (size_t)(2 * i + 2) * MG * 16;
            if ((i & 1) == 0) {
                if (EN(2) && RUN()) {
                    pg8::Gemm gm{XB, (const bf16*)(ws + WS_WMI) + (size_t)j * 2048 * D, MG, 2048, D}; pg8::StaticOrder S; S.init(MG, 2048, G, c);
                    pg8::EpiProj<0> E{(bf16*)(ws + WS_BIG), 2048, rsq_n1, 0, 1.f, nullptr, 0, (PG8_LAS float*)(glds + 131072 + 1024)};
                    _Pragma("unroll 1") for (int rep = 0; rep < MK_DUP; ++rep) pg8::gemm_phase<pg8::EpiProj<0>, pg8::StaticOrder, true, true>(glds, gm, S, E);
                }
                SEAMK(3);
                if (EN(3) && RUN()) { _Pragma("unroll 1") for (int rep = 0; rep < 1 + ((MK_DUP_MISC >> 2) & 1); ++rep) phase_stencil(args, g, j); }
                SEAMK(4);
                if (EN(4) && RUN()) {
                    pg8::Gemm gm{(const bf16*)(ws + WS_BIG + 64 * MiB), (const bf16*)(ws + WS_WMO) + (size_t)j * D * D, MG, D, D}; pg8::StaticOrder S; S.init(MG, D, G, c);
                    pg8::EpiRes E{xg, XB, rsq_n2, 0};
                    if (MK_DUP_RES == 1) { pg8::EpiNull E0; pg8::gemm_phase<pg8::EpiNull, pg8::StaticOrder, true, true>(glds, gm, S, E0); }
                    if (MK_DUP_RES == 2) { pg8::EpiRes E0 = E; E0.dry = 1; pg8::gemm_phase<pg8::EpiRes, pg8::StaticOrder, true, true>(glds, gm, S, E0); }
                    pg8::gemm_phase<pg8::EpiRes, pg8::StaticOrder, true, true>(glds, gm, S, E);
                }
                SEAMK(5);
            } else {
                if (EN(5) && RUN()) {
                    pg8::Gemm gm{XB, (const bf16*)(ws + WS_WQKV) + (size_t)j * 3072 * D, MG, 3072, D}; pg8::StaticOrder S; S.init(MG, 3072, G, c);
                    pg8::EpiProj<1> E{(bf16*)(ws + WS_BIG), 1024, rsq_n1, (size_t)MG * 1024, QSCALE, (unsigned*)(ws + WS_CTL) + CW_NRM + 256 * (g * 2 + j), g ? 14 : 13, (PG8_LAS float*)(glds + 131072 + 1024)};
                    _Pragma("unroll 1") for (int rep = 0; rep < MK_DUP; ++rep) pg8::gemm_phase<pg8::EpiProj<1>, pg8::StaticOrder, true, true>(glds, gm, S, E);
                }
                SEAMK(6);
                if (EN(6) && RUN()) phase_attention(args, g, i, (char*)lds);
                SEAMK(7);
                if (EN(7) && RUN()) {
                    pg8::Gemm gm{(const bf16*)(ws + WS_BIG), (const bf16*)(ws + WS_WAO) + (size_t)j * D * D, MG, D, D}; pg8::StaticOrder S; S.init(MG, D, G, c);
                    pg8::EpiRes E{xg, XB, rsq_n2, 0};
                    if (MK_DUP_RES == 1) { pg8::EpiNull E0; pg8::gemm_phase<pg8::EpiNull, pg8::StaticOrder, true, true>(glds, gm, S, E0); }
                    if (MK_DUP_RES == 2) { pg8::EpiRes E0 = E; E0.dry = 1; pg8::gemm_phase<pg8::EpiRes, pg8::StaticOrder, true, true>(glds, gm, S, E0); }
                    pg8::gemm_phase<pg8::EpiRes, pg8::StaticOrder, true, true>(glds, gm, S, E);
                }
                SEAMK(8);
            }
            if (EN(8) && RUN()) {
                pg8::Gemm gm{XB, (const bf16*)(ws + WS_W1) + (size_t)i * FF * D, MG, FF, D}; pg8::StaticOrder S; S.init(MG, FF, G, c);
                pg8::EpiProj<2> E{(bf16*)(ws + WS_BIG), FF, rsq_n2, 0, 1.f, nullptr, 0, (PG8_LAS float*)(glds + 131072 + 1024)};
                _Pragma("unroll 1") for (int rep = 0; rep < MK_DUP; ++rep) pg8::gemm_phase<pg8::EpiProj<2>, pg8::StaticOrder, true, true>(glds, gm, S, E);
            }
            SEAMK(9);
            if (EN(9) && RUN()) {
                pg8::Gemm gm{(const bf16*)(ws + WS_BIG), (const bf16*)(ws + WS_W2) + (size_t)i * D * FF, MG, D, FF}; pg8::StaticOrder S; S.init(MG, D, G, c);
                pg8::EpiRes E{xg, (i == DEPTH - 1) ? nullptr : XB, rsq_nx, 0};
                if (MK_DUP_RES == 1) { pg8::EpiNull E0; pg8::gemm_phase<pg8::EpiNull, pg8::StaticOrder, true, true>(glds, gm, S, E0); }
                    if (MK_DUP_RES == 2) { pg8::EpiRes E0 = E; E0.dry = 1; pg8::gemm_phase<pg8::EpiRes, pg8::StaticOrder, true, true>(glds, gm, S, E0); }
                    pg8::gemm_phase<pg8::EpiRes, pg8::StaticOrder, true, true>(glds, gm, S, E);
            }
            SEAMK(10);
        }
        if (EN(10) && RUN()) { phase_final(args, g); if (g == 0) phase_prep(args, 1); }
        SEAMK(11);
    }
#if MK_PROBE
    if (blockIdx.x == 0 && (mk_tid() >> 6) == 0) {
        const float da = (float)t_a * 1e-5f / 1.5f, db = (float)t_b * 1e-5f;
        for (int g = 0; g < 2; ++g) { float* r0 = args.out + (size_t)g * MG * D; const int lane = mk_tid() & 63;
            for (int q = 0; q < 16; ++q) r0[q * 64 + lane] += da;
            if (lane == 0) r0[(size_t)2048 * D] += db; }
    }
#endif
#undef RUN
#undef SEAM
}

extern "C" void kernel_launch(void* const* d_in, const int* in_sizes, int n_in, void* d_out, int out_size, void* d_ws, size_t ws_size, hipStream_t stream) {
    static int grid = 0;
    if (grid == 0) {
        if (n_in != 19 || in_sizes[0] != MG * D || in_sizes[1] != MG * D || out_size != MTOT * D || ws_size < WS_END) {
            fprintf(stderr, "kernel_launch: unexpected shapes: n_in %d in0 %d in1 %d out %d ws %zu (need %zu); nothing launched\n", n_in, n_in > 0 ? in_sizes[0] : -1, n_in > 1 ? in_sizes[1] : -1, out_size, ws_size, (size_t)WS_END);
            grid = -1; return; }
        int dev = 0, cus = 0, per_cu = 0;
        hipGetDevice(&dev);
        hipDeviceGetAttribute(&cus, hipDeviceAttributeMultiprocessorCount, dev);
        if (hipFuncSetAttribute((const void*)fwd_megakernel, hipFuncAttributeMaxDynamicSharedMemorySize, LDS_BYTES) != hipSuccess) { fprintf(stderr, "kernel_launch: hipFuncSetAttribute failed\n"); grid = -1; return; }
        if (hipOccupancyMaxActiveBlocksPerMultiprocessor(&per_cu, (const void*)fwd_megakernel, NTHREADS, LDS_BYTES) != hipSuccess || per_cu < 1) { fprintf(stderr, "kernel_launch: occupancy query failed (%d)\n", per_cu); per_cu = 1; }
        (void)hipGetLastError();
        grid = cus * per_cu;
        if (grid > 256) grid = 256;
    }
    if (grid < 0) return;
    Args a{};
    for (int i = 0; i < 19; ++i) a.in[i] = (const float*)d_in[i];
    a.out = (float*)d_out; a.ws = (unsigned char*)d_ws;
#if MK_PER_PHASE
    for (int p = 0; p < N_PHASES; ++p) {
        a.ph_lo = p; a.ph_hi = p + 1;
        void* kargs[] = {&a};
        hipError_t e = hipLaunchCooperativeKernel((const void*)fwd_megakernel, dim3(grid), dim3(NTHREADS), kargs, LDS_BYTES, stream);
        if (e != hipSuccess) { fprintf(stderr, "kernel_launch: cooperative launch %d failed: %s\n", p, hipGetErrorString(e)); break; }
    }
#else
    a.ph_lo = 0; a.ph_hi = N_PHASES;
    void* kargs[] = {&a};
    hipError_t e = hipLaunchCooperativeKernel((const void*)fwd_megakernel, dim3(grid), dim3(NTHREADS), kargs, LDS_BYTES, stream);
    if (e != hipSuccess) fprintf(stderr, "kernel_launch: cooperative launch failed: %s (grid %d)\n", hipGetErrorString(e), grid);
#endif
}
```

```cpp
#include <hip/hip_runtime.h>
#include <hip/hip_cooperative_groups.h>
#include <cstdio>
#include <cstdint>
namespace cg = cooperative_groups;

#ifndef MK_WINDOW
#define MK_WINDOW 1
#endif
#ifndef MK_PROBE
#define MK_PROBE 0
#endif
#ifndef MK_PROBE_A
#define MK_PROBE_A (1 << 7)
#endif
#ifndef MK_PROBE_B
#define MK_PROBE_B ((1 << 3) | (1 << 5) | (1 << 6) | (1 << 8) | (1 << 9) | (1 << 10))
#endif
#ifndef MK_DUP
#define MK_DUP 1
#endif
#ifndef MK_DUP_ATT
#define MK_DUP_ATT 1
#endif
#ifndef MK_DUP_MISC
#define MK_DUP_MISC 0
#endif
#ifndef MK_DUP_RES
#define MK_DUP_RES 0
#endif
#ifndef MK_PER_PHASE
#define MK_PER_PHASE 0
#endif

__device__ __forceinline__ int mk_tid() { int t = threadIdx.x; asm volatile("" : "+v"(t)); return t; }

template <int M> __device__ __forceinline__ float xor_lt32(float v) { return __int_as_float(__builtin_amdgcn_ds_swizzle(__float_as_int(v), (M << 10) | 0x1f)); }
__device__ __forceinline__ float sum_x32(float v) { auto rr = __builtin_amdgcn_permlane32_swap(__float_as_uint(v), __float_as_uint(v), false, false); return __uint_as_float(rr[0]) + __uint_as_float(rr[1]); }

namespace pg8 {
#define PG8_LAS __attribute__((address_space(3)))
typedef unsigned short bf16_t;
typedef short bf16x8 __attribute__((ext_vector_type(8)));
typedef float f32x4 __attribute__((ext_vector_type(4)));
typedef unsigned u32x4 __attribute__((ext_vector_type(4)));
constexpr int BM = 256, BK = 64, HALF = 128, HTB = HALF * BK * 2  , STAGE_BYTES = 8 * HTB, NXCD = 8, WGM = 8;

__host__ __device__ __forceinline__ int lds_byte(int r, int c) { const int st = (r >> 4) * 2 + (c >> 5), rr = r & 15, cc = c & 31, ob = rr * 64 + cc * 2; return st * 1024 + (ob ^ (((ob >> 9) & 1) << 5)); }
__host__ __device__ __forceinline__ void stage_rc(int b, int& R, int& C) { const int st = b / 1024, sb = b % 1024, swz = sb ^ (((sb >> 9) & 1) << 5); R = (st >> 1) * 16 + swz / 64; C = (st & 1) * 32 + (swz % 64) / 2; }
__host__ __device__ __forceinline__ int perm32(int rho) { const int n = rho >> 4, i = rho & 15; return 8 * (i >> 2) + 4 * n + (i & 3); }

struct Unit { int pm, pn; };
struct Gemm { const bf16_t* A; const bf16_t* Bt; int M, N, K; };

struct StaticOrder {
    int nM, nN, nwg, G, c;
    __host__ __device__ void init(int M, int N, int G_, int c_) { nM = M / BM; nN = N / BM; nwg = nM * nN; G = G_; c = c_; }
    __host__ __device__ bool next(int i, Unit& u) const {
        const long L = (long)i * G + c; if (L >= nwg) return false;
        int wgid = (int)L; { const int q = nwg / NXCD, r = nwg % NXCD, xcd = wgid % NXCD, off = wgid / NXCD; wgid = (xcd < r ? xcd * (q + 1) : r * (q + 1) + (xcd - r) * q) + off; }
        const int nig = WGM * nN, gid = wgid / nig, fm = gid * WGM, gsz = (nM - fm) < WGM ? (nM - fm) : WGM;
        u.pm = fm + ((wgid % nig) % gsz); u.pn = (wgid % nig) / gsz; return true;
    }
    __device__ __forceinline__ void a_ready(const Unit&) const {}
    __device__ __forceinline__ void done(const Unit&) const {}
};

__device__ __forceinline__ unsigned cvt_pk_bf16(float lo, float hi) { unsigned r; asm volatile("v_cvt_pk_bf16_f32 %0, %1, %2" : "=v"(r) : "v"(lo), "v"(hi)); return r; }
typedef float f32x2 __attribute__((ext_vector_type(2)));
template <int MODE> struct EpiProj {
    static constexpr bool PERM = true, AFTER_DRAIN = false;
    bf16_t* O; int ldc; const float* rowsq; size_t split_stride; float scale0; unsigned* nrm; int logS; PG8_LAS float* rl;
    __device__ __forceinline__ void operator()(const f32x4 (&acc)[2][2][4][2], const Unit& u, int wr, int wc, int fr, int fq) const {
        const int row0 = u.pm * BM + wr * 64 + fr; int colt = u.pn * BM; bf16_t* base = O; float sc = 1.f; int t = 0;
        if (MODE == 1) { t = colt >> 10; base += (size_t)t * split_stride; colt &= 1023; if (t == 0) sc = scale0; }
        const int col0 = colt + wc * 32 + 8 * fq;
        float nmx[2] = {0.f, 0.f};
        { const int t = (wr * 4 + wc) * 64 + fq * 16 + fr;
          const f32x4* rp = (const f32x4*)(rowsq + (size_t)(u.pm * BM + (t >> 1)) * 16) + (t & 1) * 2; const f32x4 a0 = rp[0], a1 = rp[1];
          float s = ((a0[0] + a0[1]) + (a0[2] + a0[3])) + ((a1[0] + a1[1]) + (a1[2] + a1[3]));
          s += xor_lt32<1>(s);
          if ((t & 1) == 0) rl[t >> 1] = __builtin_amdgcn_rsqf(s * (1.0f / 1024.0f) + 1e-6f);
          asm volatile("s_waitcnt lgkmcnt(0)" ::: "memory"); __builtin_amdgcn_s_barrier(); asm volatile("" ::: "memory"); }
#pragma unroll
        for (int ai = 0; ai < 2; ++ai)
#pragma unroll
            for (int m = 0; m < 4; ++m) {
                const int row = row0 + ai * HALF + m * 16;
                const float rs = rl[wr * 64 + fr + ai * HALF + m * 16] * sc;
                bf16_t* rowp = base + (size_t)row * ldc + col0;
#pragma unroll
                for (int bj = 0; bj < 2; ++bj) {
                    f32x4 v0 = acc[ai][bj][m][0] * rs, v1 = acc[ai][bj][m][1] * rs;
                    if (MODE == 2) {
#pragma unroll
                        for (int e = 0; e < 4; ++e) { const float a = fmaxf(v0[e], 0.f), b = fmaxf(v1[e], 0.f); v0[e] = a * a; v1[e] = b * b; }
                    }
                    if (MODE == 1) {
                        float s = (v0[0] * v0[0] + v0[1] * v0[1]) + (v0[2] * v0[2] + v0[3] * v0[3]) + (v1[0] * v1[0] + v1[1] * v1[1]) + (v1[2] * v1[2] + v1[3] * v1[3]);
                        s += xor_lt32<16>(s); s = sum_x32(s);
                        nmx[bj] = fmaxf(nmx[bj], s);
                    }
                    u32x4 w; w.x = cvt_pk_bf16(v0[0], v0[1]); w.y = cvt_pk_bf16(v0[2], v0[3]); w.z = cvt_pk_bf16(v1[0], v1[1]); w.w = cvt_pk_bf16(v1[2], v1[3]);
                    *(u32x4*)(rowp + bj * HALF) = w;
                }
            }
        if (MODE == 1) {
            if (t < 2) {
                const int b = (u.pm * BM) >> logS;
#pragma unroll
                for (int bj = 0; bj < 2; ++bj) {
                    float v = nmx[bj];
                    v = fmaxf(v, xor_lt32<1>(v)); v = fmaxf(v, xor_lt32<2>(v)); v = fmaxf(v, xor_lt32<4>(v)); v = fmaxf(v, xor_lt32<8>(v));
                    const int map = (colt >> 6) + 2 * bj + (wc >> 1), half = wc & 1;
                    if (fr == 0 && fq == 0) atomicMax(nrm + (((t * 2 + b) * 16 + map) * 2 + half), __float_as_uint(v));
                }
            }
        }
    }
};
struct EpiRes {
    static constexpr bool PERM = false, AFTER_DRAIN = false;
    float* x; bf16_t* xb; float* rowsq; int dry;
    __device__ __forceinline__ void operator()(const f32x4 (&acc)[2][2][4][2], const Unit& u, int wr, int wc, int fr, int fq) const {
        typedef unsigned u32x2v __attribute__((ext_vector_type(2)));
        const int col0 = u.pn * BM + wc * 32 + 4 * fq;
#pragma unroll
        for (int ai = 0; ai < 2; ++ai)
#pragma unroll
            for (int m = 0; m < 4; ++m) {
                const int row = u.pm * BM + ai * HALF + wr * 64 + m * 16 + fr; const size_t off = (size_t)row * 1024 + col0;
                float ss = 0.f;
#pragma unroll
                for (int bj = 0; bj < 2; ++bj)
#pragma unroll
                    for (int n = 0; n < 2; ++n) {
                        const f32x4 xo = *(const f32x4*)(x + off + bj * HALF + n * 16);
                        const f32x4 xn = xo + acc[ai][bj][m][n];
                        *(f32x4*)(x + off + bj * HALF + n * 16) = dry ? xo : xn;
                        ss += (xn[0] * xn[0] + xn[1] * xn[1]) + (xn[2] * xn[2] + xn[3] * xn[3]);
                        u32x2v w; w.x = cvt_pk_bf16(xn[0], xn[1]); w.y = cvt_pk_bf16(xn[2], xn[3]);
                        if (xb) *(u32x2v*)(xb + off + bj * HALF + n * 16) = w;
                    }
                ss += xor_lt32<16>(ss); ss = sum_x32(ss);
                if (fq == 0) rowsq[(size_t)row * 16 + u.pn * 4 + wc] = ss;
            }
    }
};

struct EpiNull {
    static constexpr bool PERM = false, AFTER_DRAIN = false;
    __device__ __forceinline__ void operator()(const f32x4 (&acc)[2][2][4][2], const Unit& u, int wr, int wc, int fr, int fq) const {
#pragma unroll
        for (int ai = 0; ai < 2; ++ai)
#pragma unroll
            for (int bj = 0; bj < 2; ++bj)
#pragma unroll
                for (int m = 0; m < 4; ++m)
#pragma unroll
                    for (int n = 0; n < 2; ++n) asm volatile("" :: "v"(acc[ai][bj][m][n]));
    }
};

template <class Epi, class Sched, bool ALIGN_EPI = false, bool SP2 = false>
__device__ __forceinline__ void gemm_phase(PG8_LAS unsigned char* lds, const Gemm g, const Sched& S, const Epi& E) {
    const int tid = mk_tid(), wid = __builtin_amdgcn_readfirstlane(tid >> 6), lane = tid & 63, wr = wid >> 2, wc = wid & 3, fr = lane & 15, fq = lane >> 4;
    const int K = g.K, nt = K / BK;
    unsigned voffA[2], voffB[2];
#pragma unroll
    for (int i = 0; i < 2; ++i) { int R, C; stage_rc(tid * 16 + i * 8192, R, C); const int Rb = Epi::PERM ? ((R & ~31) + perm32(R & 31)) : R;
        voffA[i] = (unsigned)(R * K + C) * 2u; voffB[i] = (unsigned)(Rb * K + C) * 2u; }
    const size_t kstep = (size_t)(BK * 2);
    const size_t hstep = (size_t)HALF * K * 2;
    const size_t tstep = 2 * hstep;
    const unsigned ldsw = (unsigned)wid * 1024u;
    const int aoff = lds_byte(wr * 64 + fr, fq * 8), boff = lds_byte(wc * 32 + fr, fq * 8);
#define PG8_SA(b, h) (((b) * 2 + (h)) * HTB)
#define PG8_SB(b, h) ((4 + (b) * 2 + (h)) * HTB)
#define PG8_STAGE(bufoff, gbase, voff) do { _Pragma("unroll") for (int _i = 0; _i < 2; ++_i) \
        __builtin_amdgcn_global_load_lds((const unsigned*)((const char*)(gbase) + (voff)[_i]), (PG8_LAS unsigned*)(lds + (bufoff) + ldsw + _i * 8192), 16, 0, 0); } while (0)
#define PG8_LDA(dst, b, h) do { _Pragma("unroll") for (int m = 0; m < 4; ++m) _Pragma("unroll") for (int k = 0; k < 2; ++k) dst[m][k] = *(const PG8_LAS bf16x8*)(lds + PG8_SA(b, h) + aoff + m * 2048 + k * 1024); } while (0)
#define PG8_LDB(dst, b, h) do { _Pragma("unroll") for (int n = 0; n < 2; ++n) _Pragma("unroll") for (int k = 0; k < 2; ++k) dst[n][k] = *(const PG8_LAS bf16x8*)(lds + PG8_SB(b, h) + boff + n * 2048 + k * 1024); } while (0)
#define PG8_MMA(ai, bj, At, Bt) do { __builtin_amdgcn_s_setprio(1); _Pragma("unroll") for (int m = 0; m < 4; ++m) _Pragma("unroll") for (int n = 0; n < 2; ++n) _Pragma("unroll") for (int k = 0; k < 2; ++k) \
        acc[ai][bj][m][n] = __builtin_amdgcn_mfma_f32_16x16x32_bf16(Bt[n][k], At[m][k], acc[ai][bj][m][n], 0, 0, 0); __builtin_amdgcn_s_setprio(0); } while (0)
#define PG8_WAIT_V(n) asm volatile("s_waitcnt vmcnt(" #n ")" ::: "memory")
#define PG8_WAIT_L(n) asm volatile("s_waitcnt lgkmcnt(" #n ")" ::: "memory")
#define PG8_BAR __builtin_amdgcn_s_barrier()
#define PG8_SCHED __builtin_amdgcn_sched_barrier(0)
    Unit cur, nxt; int ui = 0;
    if (!S.next(0, cur)) return;
    f32x4 acc[2][2][4][2];
#pragma unroll
    for (int a = 0; a < 2; ++a)
#pragma unroll
        for (int b = 0; b < 2; ++b)
#pragma unroll
            for (int m = 0; m < 4; ++m)
#pragma unroll
                for (int n = 0; n < 2; ++n) acc[a][b][m][n] = (f32x4){0.f, 0.f, 0.f, 0.f};
    bf16x8 At[4][2], B0[2][2], B1[2][2];
    const char* cA = (const char*)g.A + (size_t)cur.pm * tstep; const char* cB = (const char*)g.Bt + (size_t)cur.pn * tstep;
    S.a_ready(cur);
    if constexpr (SP2) {
        PG8_STAGE(PG8_SB(0, 0), cB, voffB); PG8_STAGE(PG8_SB(0, 1), cB + hstep, voffB); PG8_STAGE(PG8_SA(0, 0), cA, voffA); PG8_STAGE(PG8_SA(0, 1), cA + hstep, voffA);
        if (wr == 1) PG8_BAR;
        PG8_WAIT_V(2); PG8_BAR;
        PG8_STAGE(PG8_SB(1, 0), cB + kstep, voffB); PG8_STAGE(PG8_SA(1, 0), cA + kstep, voffA); PG8_STAGE(PG8_SB(1, 1), cB + hstep + kstep, voffB);
        PG8_WAIT_V(6); PG8_BAR;
    } else {
        PG8_STAGE(PG8_SB(0, 0), cB, voffB); PG8_STAGE(PG8_SA(0, 0), cA, voffA); PG8_STAGE(PG8_SB(0, 1), cB + hstep, voffB); PG8_STAGE(PG8_SA(0, 1), cA + hstep, voffA);
        if (wr == 1) PG8_BAR;
        PG8_WAIT_V(4); PG8_BAR;
        PG8_STAGE(PG8_SB(1, 0), cB + kstep, voffB); PG8_STAGE(PG8_SA(1, 0), cA + kstep, voffA); PG8_STAGE(PG8_SB(1, 1), cB + hstep + kstep, voffB);
        PG8_WAIT_V(6); PG8_BAR;
    }
    for (;;) {
        const bool has_next = S.next(ui + 1, nxt);
        const char* nA = has_next ? (const char*)g.A + (size_t)nxt.pm * tstep : cA; const char* nB = has_next ? (const char*)g.Bt + (size_t)nxt.pn * tstep : cB;
        for (int t = 0; t < nt; t += 2) {
            const bool last = (t == nt - 2);
            const char* a1 = cA + (size_t)(t + 1) * kstep;
            const char* a2 = last ? nA : cA + (size_t)(t + 2) * kstep; const char* b2 = last ? nB : cB + (size_t)(t + 2) * kstep;
            const char* a3 = a2 + kstep; const char* b3 = b2 + kstep;
            if (last && has_next) S.a_ready(nxt);
            if constexpr (SP2) {
            PG8_LDB(B0, 0, 0); PG8_LDB(B1, 0, 1); PG8_SCHED; PG8_LDA(At, 0, 0); PG8_STAGE(PG8_SA(1, 1), a1 + hstep, voffA);
            PG8_WAIT_V(8); PG8_WAIT_L(0); PG8_BAR; PG8_MMA(0, 0, At, B0); PG8_MMA(0, 1, At, B1); PG8_BAR; PG8_SCHED;
            PG8_LDA(At, 0, 1); PG8_STAGE(PG8_SB(0, 0), b2, voffB); PG8_STAGE(PG8_SB(0, 1), b2 + hstep, voffB); PG8_STAGE(PG8_SA(0, 0), a2, voffA);
            PG8_WAIT_V(8); PG8_WAIT_L(0); PG8_BAR; PG8_MMA(1, 0, At, B0); PG8_MMA(1, 1, At, B1); PG8_BAR; PG8_SCHED;
            PG8_LDB(B0, 1, 0); PG8_LDB(B1, 1, 1); PG8_SCHED; PG8_LDA(At, 1, 0); PG8_STAGE(PG8_SA(0, 1), a2 + hstep, voffA);
            PG8_WAIT_V(8); PG8_WAIT_L(0); PG8_BAR; PG8_MMA(0, 0, At, B0); PG8_MMA(0, 1, At, B1); PG8_BAR; PG8_SCHED;
            PG8_LDA(At, 1, 1); PG8_STAGE(PG8_SB(1, 0), b3, voffB); PG8_STAGE(PG8_SB(1, 1), b3 + hstep, voffB); PG8_STAGE(PG8_SA(1, 0), a3, voffA);
            PG8_WAIT_V(8); PG8_WAIT_L(0); PG8_BAR; PG8_MMA(1, 0, At, B0); PG8_MMA(1, 1, At, B1); PG8_BAR; PG8_SCHED;
            } else {
            PG8_LDB(B0, 0, 0); PG8_SCHED; PG8_LDA(At, 0, 0); PG8_STAGE(PG8_SA(1, 1), a1 + hstep, voffA);
            PG8_WAIT_L(8); PG8_BAR; PG8_WAIT_L(0); PG8_MMA(0, 0, At, B0); PG8_BAR; PG8_SCHED;
            PG8_LDB(B1, 0, 1); PG8_STAGE(PG8_SB(0, 0), b2, voffB);
            PG8_BAR; PG8_WAIT_L(0); PG8_MMA(0, 1, At, B1); PG8_BAR;
            PG8_LDA(At, 0, 1); PG8_STAGE(PG8_SA(0, 0), a2, voffA);
            PG8_BAR; PG8_WAIT_L(0); PG8_MMA(1, 0, At, B0); PG8_BAR; PG8_SCHED;
            PG8_STAGE(PG8_SB(0, 1), b2 + hstep, voffB);
            PG8_WAIT_V(6); PG8_BAR; PG8_MMA(1, 1, At, B1); PG8_BAR;
            PG8_LDB(B0, 1, 0); PG8_SCHED; PG8_LDA(At, 1, 0); PG8_STAGE(PG8_SA(0, 1), a2 + hstep, voffA);
            PG8_WAIT_L(8); PG8_BAR; PG8_WAIT_L(0); PG8_MMA(0, 0, At, B0); PG8_BAR; PG8_SCHED;
            PG8_LDB(B1, 1, 1); PG8_STAGE(PG8_SB(1, 0), b3, voffB);
            PG8_BAR; PG8_WAIT_L(0); PG8_MMA(0, 1, At, B1); PG8_BAR;
            PG8_LDA(At, 1, 1); PG8_STAGE(PG8_SA(1, 0), a3, voffA);
            PG8_BAR; PG8_WAIT_L(0); PG8_MMA(1, 0, At, B0); PG8_BAR; PG8_SCHED;
            PG8_STAGE(PG8_SB(1, 1), b3 + hstep, voffB);
            PG8_WAIT_V(6); PG8_BAR; PG8_MMA(1, 1, At, B1); PG8_BAR;
            }
        }
        if constexpr (ALIGN_EPI) { if (wr == 0) PG8_BAR; }
        if constexpr (!Epi::AFTER_DRAIN) { E(acc, cur, wr, wc, fr, fq); S.done(cur); }
        if (!has_next) break;
#pragma unroll
        for (int a = 0; a < 2; ++a)
#pragma unroll
            for (int b = 0; b < 2; ++b)
#pragma unroll
                for (int m = 0; m < 4; ++m)
#pragma unroll
                    for (int n = 0; n < 2; ++n) acc[a][b][m][n] = (f32x4){0.f, 0.f, 0.f, 0.f};
        cur = nxt; cA = nA; cB = nB; ++ui;
        if constexpr (ALIGN_EPI) { if (wr == 1) PG8_BAR; }
    }
    PG8_WAIT_V(0);
    if constexpr (!ALIGN_EPI) { if (wr == 0) PG8_BAR; }
    PG8_BAR;
    if constexpr (Epi::AFTER_DRAIN) { E.fused(acc, cur, wr, wc, fr, fq, lds, wid, lane); S.done(cur); }
#undef PG8_SA
#undef PG8_SB
#undef PG8_STAGE
#undef PG8_LDA
#undef PG8_LDB
#undef PG8_MMA
#undef PG8_WAIT_V
#undef PG8_WAIT_L
#undef PG8_BAR
#undef PG8_SCHED
}
}

namespace att {
typedef unsigned short bf16_t;
using bf16x8 = __attribute__((ext_vector_type(8))) short;
using s16x4  = __attribute__((ext_vector_type(4))) short;
using f32x16 = __attribute__((ext_vector_type(16))) float;
using u32x4  = __attribute__((ext_vector_type(4))) unsigned;
constexpr int NW = 8, QBLK = 32, KVBLK = 64, LD = 1024;
constexpr int SHM_V = KVBLK * 128 * 2, SHM_K = KVBLK * 64 * 2;
constexpr int NSLOT = 3;
constexpr int OFF_V = 0, OFF_K = NSLOT * SHM_V, OFF_WS = OFF_K + NSLOT * SHM_K, OFF_UNIT = OFF_WS + NW * 64 * 4, LDS_BYTES = OFF_UNIT + 128;
constexpr int SDEPTH = 1;
constexpr float THR2 = 16.f;
#define KSWZ(row, colB) ((row) * 128 + ((colB) ^ ((((row) >> 1) & 7) << 4)))
#define SBAR() __builtin_amdgcn_sched_barrier(0)
#define SGB_MFMA_VALU(N, V) do { _Pragma("unroll") for (int _g = 0; _g < (N); ++_g) { __builtin_amdgcn_sched_group_barrier(0x008, 1, 0); __builtin_amdgcn_sched_group_barrier(0x400, (V), 0); } } while (0)
__device__ __forceinline__ int crow(int r, int hi) { return (r & 3) + 8 * (r >> 2) + 4 * hi; }
__device__ __forceinline__ unsigned cvtpk(float lo, float hi) { unsigned r; asm volatile("v_cvt_pk_bf16_f32 %0, %1, %2" : "=v"(r) : "v"(lo), "v"(hi)); return r; }

__device__ __forceinline__ void split3(float a, unsigned& h, unsigned& l, unsigned& ll) {
  h = cvtpk(a, 0.f) & 0xffffu; const float r1 = a - __uint_as_float(h << 16);
  l = cvtpk(r1, 0.f) & 0xffffu; const float r2 = r1 - __uint_as_float(l << 16);
  ll = cvtpk(r2, 0.f) & 0xffffu;
}
__device__ __forceinline__ void tile_ctl(int rel, float dq, float m_reg, float nc2, float smax, int hi, bf16x8& qx, int& mode, bool& skip) {
  mode = (rel <= -64) ? 1 : (rel >= 32) ? 2 : 0;
  const float dmin = (mode == 1) ? (float)(-rel - 63) : (float)(rel - 31);
  skip = (mode != 0) && (smax + nc2 * dmin <= THR2);
  const float A = (mode == 1 ? nc2 * dq : -nc2 * dq) - m_reg;
  unsigned ah, al, all_; split3(A, ah, al, all_);
  const unsigned sg = (mode == 1) ? 0x3F80u : 0xBF80u;
  u32x4 w = {ah | (al << 16), all_ | (sg << 16), sg | (sg << 16), 0u};
  if (hi != 0 || mode == 0) w = u32x4{0u, 0u, 0u, 0u};
  qx = *reinterpret_cast<bf16x8*>(&w);
}
__device__ __forceinline__ void partialSM(f32x16& p0, f32x16& p1, float& m_reg, float& alpha, int mode, bool skip, float dqh, float nc2) {
  if (mode == 0) {
    const float dq1 = dqh - 32.f;
#pragma unroll
    for (int r = 0; r < 16; ++r) p0[r] = fmaf(__builtin_fabsf(dqh - (float)((r & 3) + 8 * (r >> 2))), nc2, p0[r]) - m_reg;
#pragma unroll
    for (int r = 0; r < 16; ++r) p1[r] = fmaf(__builtin_fabsf(dq1 - (float)((r & 3) + 8 * (r >> 2))), nc2, p1[r]) - m_reg;
  }
  alpha = 1.f;
  if (!skip) {
    float pmax = p0[0];
#pragma unroll
    for (int r = 1; r < 16; ++r) pmax = fmaxf(pmax, p0[r]);
#pragma unroll
    for (int r = 0; r < 16; ++r) pmax = fmaxf(pmax, p1[r]);
    { auto rr = __builtin_amdgcn_permlane32_swap(__float_as_uint(pmax), __float_as_uint(pmax), false, false);
      pmax = fmaxf(__uint_as_float(rr[0]), __uint_as_float(rr[1])); }
    if (__builtin_expect(!__all(pmax <= THR2), 0)) {
      const float dl = fmaxf(pmax, 0.f); m_reg += dl; alpha = __builtin_amdgcn_exp2f(-dl);
#pragma unroll
      for (int r = 0; r < 16; ++r) p0[r] -= dl;
#pragma unroll
      for (int r = 0; r < 16; ++r) p1[r] -= dl;
    }
  }
}
__device__ __forceinline__ void expP0(f32x16& p0) {
#pragma unroll
  for (int r = 0; r < 16; ++r) p0[r] = __builtin_amdgcn_exp2f(p0[r]);
}
__device__ __forceinline__ void finishSM(f32x16& p0, f32x16& p1, float alpha, float& l_reg, bf16x8& pa0, bf16x8& pa1, bf16x8& pa2, bf16x8& pa3) {
#pragma unroll
  for (int r = 0; r < 16; ++r) p1[r] = __builtin_amdgcn_exp2f(p1[r]);
  float ps = 0;
#pragma unroll
  for (int r = 0; r < 16; ++r) ps += p0[r];
#pragma unroll
  for (int r = 0; r < 16; ++r) ps += p1[r];
  { auto rr = __builtin_amdgcn_permlane32_swap(__float_as_uint(ps), __float_as_uint(ps), false, false);
    ps = __uint_as_float(rr[0]) + __uint_as_float(rr[1]); }
  l_reg = l_reg * alpha + ps;
#define PK4(P, BASE, OUT) do { unsigned a0 = cvtpk(P[BASE + 0], P[BASE + 1]), a1 = cvtpk(P[BASE + 2], P[BASE + 3]);   \
    unsigned b0 = cvtpk(P[BASE + 4], P[BASE + 5]), b1 = cvtpk(P[BASE + 6], P[BASE + 7]);                              \
    auto r0 = __builtin_amdgcn_permlane32_swap(a0, b0, false, false); auto r1 = __builtin_amdgcn_permlane32_swap(a1, b1, false, false); \
    u32x4 w = {r0[0], r1[0], r0[1], r1[1]}; OUT = *reinterpret_cast<bf16x8*>(&w); } while (0)
  PK4(p0, 0, pa0); PK4(p0, 8, pa1); PK4(p1, 0, pa2); PK4(p1, 8, pa3);
#undef PK4
}
__device__ __forceinline__ void qkt(f32x16& p0, f32x16& p1, const char* Ks, const bf16x8* qr, int r32, int hi, bf16x8 kx0, bf16x8 kx1, bf16x8 qx) {
  p0 = __builtin_amdgcn_mfma_f32_32x32x16_bf16(kx0, qx, f32x16{}, 0, 0, 0); p1 = __builtin_amdgcn_mfma_f32_32x32x16_bf16(kx1, qx, f32x16{}, 0, 0, 0);
#pragma unroll
  for (int d0 = 0; d0 < 4; ++d0) { const int cb = d0 * 32 + hi * 16;
    bf16x8 b0 = *reinterpret_cast<const bf16x8*>(Ks + KSWZ(r32, cb));
    bf16x8 b1 = *reinterpret_cast<const bf16x8*>(Ks + KSWZ(32 + r32, cb));
    p0 = __builtin_amdgcn_mfma_f32_32x32x16_bf16(b0, qr[d0], p0, 0, 0, 0);
    p1 = __builtin_amdgcn_mfma_f32_32x32x16_bf16(b1, qr[d0], p1, 0, 0, 0); }
}
__device__ __forceinline__ int v_st(int k, int c) { const int kk = (k & ~0xC) | ((k & 4) << 1) | ((k & 8) >> 1); return ((kk >> 3) * 4 + (c >> 5)) * 512 + ((kk & 7) * 32 + (c & 31)) * 2; }
__device__ __forceinline__ int v_rd_base(int lane) { return ((lane & 3) << 3) | (((lane >> 2) & 3) << 6) | (((lane >> 4) & 1) << 5) | (((lane >> 5) & 1) << 8); }
constexpr int v_rd_off(int d0, int ks, int half) { return d0 * 512 + ks * 4096 + half * 2048; }
template <int OFF> __device__ __forceinline__ s16x4 tr_read(int vb) {
  s16x4 r; asm volatile("ds_read_b64_tr_b16 %0, %1 offset:%2" : "=&v"(r) : "v"(vb), "i"(OFF) : "memory"); return r;
}
#define PV_RDK(KS, L, H) do { L[0] = tr_read<v_rd_off(0, KS, 0)>(vb); H[0] = tr_read<v_rd_off(0, KS, 1)>(vb); L[1] = tr_read<v_rd_off(1, KS, 0)>(vb); H[1] = tr_read<v_rd_off(1, KS, 1)>(vb); \
    L[2] = tr_read<v_rd_off(2, KS, 0)>(vb); H[2] = tr_read<v_rd_off(2, KS, 1)>(vb); L[3] = tr_read<v_rd_off(3, KS, 0)>(vb); H[3] = tr_read<v_rd_off(3, KS, 1)>(vb); } while (0)
#define PV_RD2(KS, D0, L, H) do { L[D0] = tr_read<v_rd_off(D0, KS, 0)>(vb); H[D0] = tr_read<v_rd_off(D0, KS, 1)>(vb); } while (0)
#define PV_WAIT(N, L, H) asm volatile("s_waitcnt lgkmcnt(" #N ")" : "+v"(L[0]), "+v"(H[0]), "+v"(L[1]), "+v"(H[1]), "+v"(L[2]), "+v"(H[2]), "+v"(L[3]), "+v"(H[3]))
#define PV_PK(L, H, D0) (bf16x8){L[D0][0], L[D0][1], L[D0][2], L[D0][3], H[D0][0], H[D0][1], H[D0][2], H[D0][3]}
#define PV_MF(D0, PA, L, H, R) do { o[D0] = __builtin_amdgcn_mfma_f32_32x32x16_bf16(PA, PV_PK(L, H, D0), o[D0], 0, 0, 0); \
    if (EXPS) { px[R] = __builtin_amdgcn_exp2f(px[R]); asm volatile("" : "+v"(px)); } SBAR(); } while (0)
template <bool EXPS> __device__ __forceinline__ void pv_d0(f32x16* o, int vb, bf16x8 pa0, bf16x8 pa1, bf16x8 pa2, bf16x8 pa3, f32x16& px) {
  s16x4 la[4], ha[4], lb[4], hb[4];
  SBAR(); PV_RDK(0, la, ha); SBAR();
  PV_RD2(1, 0, lb, hb); PV_WAIT(2, la, ha);  PV_MF(0, pa0, la, ha, 0);
  PV_RD2(1, 1, lb, hb);                       PV_MF(1, pa0, la, ha, 1);
  PV_RD2(1, 2, lb, hb);                       PV_MF(2, pa0, la, ha, 2);
  PV_RD2(1, 3, lb, hb);                       PV_MF(3, pa0, la, ha, 3);
  PV_RD2(2, 0, la, ha); PV_WAIT(2, lb, hb);  PV_MF(0, pa1, lb, hb, 4);
  PV_RD2(2, 1, la, ha);                       PV_MF(1, pa1, lb, hb, 5);
  PV_RD2(2, 2, la, ha);                       PV_MF(2, pa1, lb, hb, 6);
  PV_RD2(2, 3, la, ha);                       PV_MF(3, pa1, lb, hb, 7);
  PV_RD2(3, 0, lb, hb); PV_WAIT(2, la, ha);  PV_MF(0, pa2, la, ha, 8);
  PV_RD2(3, 1, lb, hb);                       PV_MF(1, pa2, la, ha, 9);
  PV_RD2(3, 2, lb, hb);                       PV_MF(2, pa2, la, ha, 10);
  PV_RD2(3, 3, lb, hb);                       PV_MF(3, pa2, la, ha, 11);
                        PV_WAIT(0, lb, hb);  PV_MF(0, pa3, lb, hb, 12);
                                              PV_MF(1, pa3, lb, hb, 13);
                                              PV_MF(2, pa3, lb, hb, 14);
                                              PV_MF(3, pa3, lb, hb, 15);
}

__device__ __forceinline__ void attn_pass(const bf16_t* __restrict__ Qw, const bf16_t* __restrict__ Kh, const bf16_t* __restrict__ Vh,
                                          int NT, float dqbase, int rel0, float nc2, float smax, f32x16 (&o)[4], char* lds) {
  const int tid = mk_tid(), wid = tid >> 6, lane = tid & 63, r32 = lane & 31, hi = lane >> 5;
  char* V_lds = lds + OFF_V; char* K_lds = lds + OFF_K;
  float* ws = (float*)(lds + OFF_WS) + wid * 64; float* li_l = ws; float* al_l = ws + 32;
  float m_reg = 0.f, l_reg = 0; bf16x8 qr[4];
#pragma unroll
  for (int d = 0; d < 4; ++d) o[d] = f32x16{};
#pragma unroll
  for (int d0 = 0; d0 < 4; ++d0) qr[d0] = *reinterpret_cast<const bf16x8*>(Qw + d0 * 16);
  const float dqh0 = dqbase - (float)(4 * hi);
  bf16x8 kx0, kx1;
  { unsigned bh, bl, bll; u32x4 w;
    split3(-nc2 * (float)r32, bh, bl, bll); w = u32x4{0x3F803F80u, 0x3F80u | (bh << 16), bl | (bll << 16), 0u}; if (hi) w = u32x4{0u, 0u, 0u, 0u}; kx0 = *reinterpret_cast<bf16x8*>(&w);
    split3(-nc2 * (float)(32 + r32), bh, bl, bll); w = u32x4{0x3F803F80u, 0x3F80u | (bh << 16), bl | (bll << 16), 0u}; if (hi) w = u32x4{0u, 0u, 0u, 0u}; kx1 = *reinterpret_cast<bf16x8*>(&w); }
  bf16x8 qx; int mdA, mdB; bool skA, skB;
#define CTL(j, MD, SK) tile_ctl(rel0 + (j) * KVBLK, dqbase - (float)((j) * KVBLK), m_reg, nc2, smax, hi, qx, MD, SK)
  const int sr = tid >> 4, sc = (tid & 15) * 8, vst0 = v_st(sr, sc), vst1 = v_st(32 + sr, sc);
  const int krow = tid >> 3, kcol = (tid & 7) * 8, kst = KSWZ(krow, kcol * 2);
  const int vb0 = (int)(uintptr_t)V_lds + v_rd_base(lane);
  struct { bf16x8 vs0, vs1, ks0; } sg;
#define SLOAD(k0) do { sg.vs0 = *reinterpret_cast<const bf16x8*>(&Vh[(long)((k0) + sr) * LD + sc]); sg.vs1 = *reinterpret_cast<const bf16x8*>(&Vh[(long)((k0) + 32 + sr) * LD + sc]); \
    sg.ks0 = *reinterpret_cast<const bf16x8*>(&Kh[(long)((k0) + krow) * LD + kcol]); } while (0)
#define SWRITE(b) do { *(bf16x8*)(V_lds + (b) * SHM_V + vst0) = sg.vs0; *(bf16x8*)(V_lds + (b) * SHM_V + vst1) = sg.vs1; *(bf16x8*)(K_lds + (b) * SHM_K + kst) = sg.ks0; } while (0)
#define SWAIT() asm volatile("s_waitcnt vmcnt(0)" ::: "memory")
#define RESC(a) do { if (__any((a) < 1.f)) { if (hi == 0) al_l[r32] = (a); asm volatile("s_waitcnt lgkmcnt(0)" ::: "memory"); \
    _Pragma("unroll") for (int d = 0; d < 4; ++d) _Pragma("unroll") for (int r = 0; r < 16; ++r) o[d][r] *= al_l[crow(r, hi)]; } } while (0)
  f32x16 pA0, pA1, pB0, pB1; float alA, alB; bf16x8 pa0, pa1, pa2, pa3;
  int b_prev = 0, b_cur = 1, b_next = 2;
#define ROT() do { const int t_ = b_prev; b_prev = b_cur; b_cur = b_next; b_next = t_; } while (0)
#define STEP(j, X0, X1, Y0, Y1, MDX, SKX, ALX, ALY, WR, LD_) do { SBAR(); \
    if (WR) { SWAIT(); SWRITE(b_next); } if (LD_) SLOAD(((j) + 2) * KVBLK); SBAR(); \
    CTL(j, MDX, SKX); qkt(X0, X1, K_lds + b_cur * SHM_K, qr, r32, hi, kx0, kx1, qx); \
    finishSM(Y0, Y1, ALY, l_reg, pa0, pa1, pa2, pa3); SBAR(); \
    partialSM(X0, X1, m_reg, ALX, MDX, SKX, dqh0 - (float)((j) * KVBLK), nc2); SBAR(); \
    pv_d0<true>(o, vb0 + b_prev * SHM_V, pa0, pa1, pa2, pa3, X0); \
    RESC(ALX); __syncthreads(); } while (0)
  __syncthreads();
  SLOAD(0); SWAIT(); SWRITE(0); SLOAD(KVBLK); __syncthreads();
  SWAIT(); SWRITE(1); if (2 < NT) SLOAD(2 * KVBLK);
  CTL(0, mdA, skA); qkt(pA0, pA1, K_lds, qr, r32, hi, kx0, kx1, qx); partialSM(pA0, pA1, m_reg, alA, mdA, skA, dqh0, nc2); expP0(pA0);
  __syncthreads();
  for (int j = 1; j + 1 < NT; j += 2) {
    STEP(j, pB0, pB1, pA0, pA1, mdB, skB, alB, alA, true, true); ROT();
    STEP(j + 1, pA0, pA1, pB0, pB1, mdA, skA, alA, alB, true, (j + 3 < NT)); ROT();
  }
  STEP(NT - 1, pB0, pB1, pA0, pA1, mdB, skB, alB, alA, false, false); ROT();
  finishSM(pB0, pB1, alB, l_reg, pa0, pa1, pa2, pa3); SBAR();
  pv_d0<false>(o, vb0 + b_prev * SHM_V, pa0, pa1, pa2, pa3, pB0);
  if (hi == 0) li_l[r32] = l_reg; asm volatile("s_waitcnt lgkmcnt(0)" ::: "memory");
#pragma unroll
  for (int r = 0; r < 16; ++r) { const float rli = __builtin_amdgcn_rcpf(li_l[crow(r, hi)]);
#pragma unroll
    for (int d0 = 0; d0 < 4; ++d0) o[d0][r] *= rli; }
#undef CTL
#undef STEP
#undef ROT
#undef SLOAD
#undef SWRITE
#undef SWAIT
#undef RESC
}
}

typedef unsigned short bf16;
typedef unsigned v4u __attribute__((ext_vector_type(4)));
typedef unsigned v2u __attribute__((ext_vector_type(2)));
typedef float f32x4 __attribute__((ext_vector_type(4)));
#define LAS __attribute__((address_space(3)))
constexpr int NWAVES = 8, NTHREADS = 512;
constexpr int D = 1024, FF = 4096, MG = 16384, MTOT = 32768;
constexpr int DEPTH = 4;
constexpr float QSCALE = 0.125f * 1.4426950408889634f;
constexpr size_t MiB = 1u << 20;
constexpr size_t WS_CTL = 0, WS_ZERO_END = 64 * 1024;
constexpr size_t WS_WMI = 2 * MiB, WS_WMO = 10 * MiB, WS_WQKV = 14 * MiB, WS_WAO = 26 * MiB, WS_W1 = 30 * MiB, WS_W2 = 62 * MiB;
constexpr size_t WS_XB = 94 * MiB, WS_BIG = 126 * MiB, WS_ROWSQ = 254 * MiB, WS_END = WS_ROWSQ + 9 * (size_t)MG * 64;
static_assert(WS_ZERO_END <= WS_WMI, "ws map");
constexpr int CW_ATTCTR = 0;
constexpr int CW_ARR = 8192;
constexpr int CW_BAR = 4096;
constexpr int CW_NRM = 1024;

struct Args {
    const float* in[19]; float* out; unsigned char* ws; int ph_lo, ph_hi;
};

__device__ __forceinline__ unsigned f2bf(float f) { unsigned u = __builtin_bit_cast(unsigned, f); return (u + 0x7fffu + ((u >> 16) & 1u)) >> 16; }
__device__ __forceinline__ unsigned pk2(float lo, float hi) { return f2bf(lo) | (f2bf(hi) << 16); }
__device__ __forceinline__ float bflo(unsigned w) { return __uint_as_float(w << 16); }
__device__ __forceinline__ float bfhi(unsigned w) { return __uint_as_float(w & 0xffff0000u); }
__device__ __forceinline__ float wave_sum(float v) {
    v += xor_lt32<1>(v); v += xor_lt32<2>(v); v += xor_lt32<4>(v); v += xor_lt32<8>(v); v += xor_lt32<16>(v);
    return sum_x32(v);
}

__device__ __forceinline__ void transpose_item(const float* W, int ldw, int N, const float* gs, bf16* WT, int ldk, int koff, LAS float* scr, int item, int lane) {
    const int nblk = N / 32, kb = item / nblk, nb = item % nblk, k0 = 64 * kb, n0 = 32 * nb;
#pragma unroll
    for (int i = 0; i < 8; ++i) { const int kk = 8 * i + (lane >> 3), c4 = (lane & 7) * 4;
        f32x4 v = *(const f32x4*)(W + (size_t)(k0 + kk) * ldw + n0 + c4); if (gs) v = v * gs[k0 + kk];
        scr[kk * 33 + c4] = v[0]; scr[kk * 33 + c4 + 1] = v[1]; scr[kk * 33 + c4 + 2] = v[2]; scr[kk * 33 + c4 + 3] = v[3]; }
    asm volatile("s_waitcnt lgkmcnt(0)" ::: "memory");
    const int c = lane & 7;
#pragma unroll
    for (int j = 0; j < 4; ++j) { const int n = (lane >> 3) + 8 * j; const LAS float* s = scr + (8 * c) * 33 + n;
        v4u o; o.x = pk2(s[0 * 33], s[1 * 33]); o.y = pk2(s[2 * 33], s[3 * 33]); o.z = pk2(s[4 * 33], s[5 * 33]); o.w = pk2(s[6 * 33], s[7 * 33]);
        *(v4u*)(WT + (size_t)(n0 + n) * ldk + koff + k0 + 8 * c) = o; }
    asm volatile("s_waitcnt lgkmcnt(0)" ::: "memory");
}

__device__ __forceinline__ void phase_prologue(const Args& a, LAS unsigned char* lds) {
    const int tid = mk_tid(), lane = tid & 63, wave = tid >> 6;
    const int gt = blockIdx.x * NTHREADS + tid, NGT = gridDim.x * NTHREADS;
    const int gw = blockIdx.x * NWAVES + wave, NGW = gridDim.x * NWAVES;
    { v4u z = {0u, 0u, 0u, 0u}; v4u* p = (v4u*)(a.ws + WS_CTL); for (int i = gt; i < (int)(WS_ZERO_END / 16); i += NGT) p[i] = z; }
    LAS float* scr = (LAS float*)(lds + wave * 16384);
    const float* norm1_g = a.in[2]; const float* norm2_g = a.in[3];
    constexpr int I_MI = 16 * 64, I_MO = 8 * 32, I_QKV = 16 * 96, I_AO = 16 * 32, I_W1 = 16 * 128, I_W2 = 64 * 32;
    constexpr int T_MI = 2 * I_MI, T_MO = T_MI + 2 * I_MO, T_QKV = T_MO + 2 * I_QKV, T_AO = T_QKV + 2 * I_AO, T_W1 = T_AO + 4 * I_W1, T_W2 = T_W1 + 4 * I_W2;
    for (int it = gw; it < T_W2; it += NGW) {
        if (it < T_MI) { const int j = it / I_MI, r = it % I_MI;
            transpose_item(a.in[5] + (size_t)j * D * 2048, 2048, 2048, norm1_g + (2 * j) * D, (bf16*)(a.ws + WS_WMI) + (size_t)j * 2048 * D, D, 0, scr, r, lane); }
        else if (it < T_MO) { const int q = it - T_MI, j = q / I_MO, r = q % I_MO;
            transpose_item(a.in[9] + (size_t)j * D * D + (size_t)512 * D, D, D, nullptr, (bf16*)(a.ws + WS_WMO) + (size_t)j * D * D, D, 512, scr, r, lane); }
        else if (it < T_QKV) { const int q = it - T_MO, j = q / I_QKV, r = q % I_QKV;
            transpose_item(a.in[10] + (size_t)j * D * 3072, 3072, 3072, norm1_g + (2 * j + 1) * D, (bf16*)(a.ws + WS_WQKV) + (size_t)j * 3072 * D, D, 0, scr, r, lane); }
        else if (it < T_AO) { const int q = it - T_QKV, j = q / I_AO, r = q % I_AO;
            transpose_item(a.in[11] + (size_t)j * D * D, D, D, nullptr, (bf16*)(a.ws + WS_WAO) + (size_t)j * D * D, D, 0, scr, r, lane); }
        else if (it < T_W1) { const int q = it - T_AO, i = q / I_W1, r = q % I_W1;
            transpose_item(a.in[17] + (size_t)i * D * FF, FF, FF, norm2_g + i * D, (bf16*)(a.ws + WS_W1) + (size_t)i * FF * D, D, 0, scr, r, lane); }
        else { const int q = it - T_W1, i = q / I_W2, r = q % I_W2;
            transpose_item(a.in[18] + (size_t)i * FF * D, D, D, nullptr, (bf16*)(a.ws + WS_W2) + (size_t)i * D * FF, FF, 0, scr, r, lane); }
    }
    for (int it = gw; it < 2 * 4 * 16 * 16; it += NGW) {
        const int cb = it & 15, nb = (it >> 4) & 15, g = (it >> 8) & 3, j = it >> 10;
        const float* pw = a.in[6] + ((size_t)(j * 4 + g) * 128 + cb * 8) * 128;
        const float* ps = a.in[7] + j * 512 + g * 128;
        const float* mo = a.in[9] + (size_t)j * D * D + (size_t)(g * 128) * D + nb * 64 + lane;
        float acc[8];
#pragma unroll
        for (int c = 0; c < 8; ++c) acc[c] = 0.f;
#pragma unroll 8
        for (int d = 0; d < 128; ++d) {
            const float m = mo[(size_t)d * D] * ps[d];
#pragma unroll
            for (int c = 0; c < 8; ++c) acc[c] = fmaf(pw[c * 128 + d], m, acc[c]);
        }
        v4u o; o.x = pk2(acc[0], acc[1]); o.y = pk2(acc[2], acc[3]); o.z = pk2(acc[4], acc[5]); o.w = pk2(acc[6], acc[7]);
        *(v4u*)((bf16*)(a.ws + WS_WMO) + (size_t)j * D * D + (size_t)(nb * 64 + lane) * D + g * 128 + cb * 8) = o;
    }
}

__device__ __forceinline__ void phase_prep(const Args& a, int g) {
    const int tid = mk_tid(), lane = tid & 63, gw = blockIdx.x * NWAVES + (tid >> 6), NGW = gridDim.x * NWAVES;
    const float* xin = g ? a.in[1] : a.in[0]; float* xo = a.out + (size_t)g * MG * D; bf16* xb = (bf16*)(a.ws + WS_XB); float* rsq = (float*)(a.ws + WS_ROWSQ);
    for (int m = gw; m < MG; m += NGW) {
        const f32x4* xr = (const f32x4*)(xin + (size_t)m * D) + lane; f32x4* orow = (f32x4*)(xo + (size_t)m * D) + lane; v2u* brow = (v2u*)(xb + (size_t)m * D) + lane;
        float s = 0.f;
#pragma unroll
        for (int j = 0; j < 4; ++j) { const f32x4 v = xr[64 * j]; orow[64 * j] = v; s += (v[0] * v[0] + v[1] * v[1]) + (v[2] * v[2] + v[3] * v[3]);
            v2u w; w.x = pk2(v[0], v[1]); w.y = pk2(v[2], v[3]); brow[64 * j] = w; }
        s = wave_sum(s);
        if (lane < 16) rsq[(size_t)m * 16 + lane] = lane == 0 ? s : 0.f;
    }
}
__device__ __forceinline__ void phase_final(const Args& a, int g) {
    const int tid = mk_tid(), lane = tid & 63, gw = blockIdx.x * NWAVES + (tid >> 6), NGW = gridDim.x * NWAVES;
    float* xo = a.out + (size_t)g * MG * D; const float* rsq = (const float*)(a.ws + WS_ROWSQ) + (size_t)8 * MG * 16; const f32x4* fg = (const f32x4*)a.in[4] + lane;
    for (int m = gw; m < MG; m += NGW) {
        float rsum;
        { const f32x4* rp = (const f32x4*)(rsq + (size_t)m * 16); const f32x4 a0 = rp[0], a1 = rp[1], a2 = rp[2], a3 = rp[3];
          rsum = (((a0[0] + a0[1]) + (a0[2] + a0[3])) + ((a1[0] + a1[1]) + (a1[2] + a1[3]))) + (((a2[0] + a2[1]) + (a2[2] + a2[3])) + ((a3[0] + a3[1]) + (a3[2] + a3[3]))); }
        const float rs = __builtin_amdgcn_rsqf(rsum * (1.0f / 1024.0f) + 1e-6f);
        f32x4* orow = (f32x4*)(xo + (size_t)m * D) + lane;
#pragma unroll
        for (int j = 0; j < 4; ++j) { f32x4 v = orow[64 * j]; const f32x4 gg = fg[64 * j]; v = v * rs * gg; orow[64 * j] = v; }
    }
}

__device__ __forceinline__ void unpack8(const v4u w, float (&f)[8]) {
    f[0] = bflo(w.x); f[1] = bfhi(w.x); f[2] = bflo(w.y); f[3] = bfhi(w.y); f[4] = bflo(w.z); f[5] = bfhi(w.z); f[6] = bflo(w.w); f[7] = bfhi(w.w);
}
template <int HW> __device__ __forceinline__ void stencil_pool(const bf16* P, bf16* A2, int b0, int S, int t0, int c0) {
    constexpr int NR = 8 + 2 * HW;
    const char* Ub = (const char*)(P + (size_t)b0 * 2048);
#pragma unroll 1
    for (int half = 0; half < 2; ++half) {
        const int tb0 = t0 + 8 * half;
        v4u raw[NR];
#pragma unroll
        for (int i = 0; i < NR; ++i) { const int t = tb0 - HW + i, tc = min(max(t, 0), S - 1); raw[i] = *(const v4u*)(Ub + (unsigned)(tc * 4096 + c0 * 2)); }
        float sum[8];
#pragma unroll
        for (int e = 0; e < 8; ++e) sum[e] = 0.f;
#pragma unroll
        for (int k = 0; k < 2 * HW; ++k) { const int t = tb0 - HW + k; float f[8]; unpack8(raw[k], f); const float mk = (t >= 0 && t < S) ? 1.f : 0.f;
#pragma unroll
            for (int e = 0; e < 8; ++e) sum[e] = fmaf(f[e], mk, sum[e]); }
#pragma unroll
        for (int i = 0; i < 8; ++i) {
            const int t = tb0 + i; const int lo = max(t - HW, 0), hi = min(t + HW, S);
            const float rc = 1.0f / (float)(hi - lo);
            float f[8]; unpack8(raw[i + HW], f);
            v4u o; o.x = pk2(sum[0] * rc - f[0], sum[1] * rc - f[1]); o.y = pk2(sum[2] * rc - f[2], sum[3] * rc - f[3]);
            o.z = pk2(sum[4] * rc - f[4], sum[5] * rc - f[5]); o.w = pk2(sum[6] * rc - f[6], sum[7] * rc - f[7]);
            *(v4u*)(A2 + (size_t)(b0 + t) * 1024 + c0) = o;
            if (i < 7) {
                float n[8], q[8]; unpack8(raw[i + 2 * HW], n); unpack8(raw[i], q);
                const float ma = (t + HW < S) ? 1.f : 0.f, ms = (t - HW >= 0) ? 1.f : 0.f;
#pragma unroll
                for (int e = 0; e < 8; ++e) sum[e] = fmaf(n[e], ma, sum[e]) - q[e] * ms;
            }
        }
    }
}
__device__ __forceinline__ void stencil_conv(const bf16* P, bf16* A2, const float* cw, int b0, int S, int t0, int c0) {
    const char* Pb = (const char*)(P + (size_t)b0 * 2048);
    float w0[8], w1[8], w2[8];
#pragma unroll
    for (int e = 0; e < 8; ++e) { w0[e] = cw[e]; w1[e] = cw[512 + e]; w2[e] = cw[1024 + e]; }
#pragma unroll 1
    for (int half = 0; half < 2; ++half) {
        const int tb0 = t0 + 8 * half;
        v4u rh[10], rcv[10], rg[8];
#pragma unroll
        for (int i = 0; i < 10; ++i) { const int t = tb0 - 1 + i, tc = min(max(t, 0), S - 1); rh[i] = *(const v4u*)(Pb + (unsigned)(tc * 4096 + (512 + c0) * 2)); rcv[i] = *(const v4u*)(Pb + (unsigned)(tc * 4096 + (1536 + c0) * 2)); }
#pragma unroll
        for (int i = 0; i < 8; ++i) rg[i] = *(const v4u*)(Pb + (unsigned)((tb0 + i) * 4096 + (1024 + c0) * 2));
        float zp[8], zc[8];
        { float hh[8], cc[8]; unpack8(rh[0], hh); unpack8(rcv[0], cc); const float mk = (tb0 - 1 >= 0) ? 1.f : 0.f;
#pragma unroll
          for (int e = 0; e < 8; ++e) zp[e] = hh[e] * cc[e] * mk; }
        { float hh[8], cc[8]; unpack8(rh[1], hh); unpack8(rcv[1], cc);
#pragma unroll
          for (int e = 0; e < 8; ++e) zc[e] = hh[e] * cc[e]; }
#pragma unroll
        for (int i = 0; i < 8; ++i) {
            const int t = tb0 + i; float zn[8];
            { float hh[8], cc[8]; unpack8(rh[i + 2], hh); unpack8(rcv[i + 2], cc); const float mk = (t + 1 < S) ? 1.f : 0.f;
#pragma unroll
              for (int e = 0; e < 8; ++e) zn[e] = hh[e] * cc[e] * mk; }
            float gb[8], r[8]; unpack8(rg[i], gb);
#pragma unroll
            for (int e = 0; e < 8; ++e) r[e] = gb[e] * (w0[e] * zp[e] + w1[e] * zc[e] + w2[e] * zn[e]);
            v4u o; o.x = pk2(r[0], r[1]); o.y = pk2(r[2], r[3]); o.z = pk2(r[4], r[5]); o.w = pk2(r[6], r[7]);
            *(v4u*)(A2 + (size_t)(b0 + t) * 1024 + 512 + c0) = o;
#pragma unroll
            for (int e = 0; e < 8; ++e) { zp[e] = zc[e]; zc[e] = zn[e]; }
        }
    }
}
__device__ __forceinline__ void phase_stencil(const Args& a, int g, int j) {
    const int S = g ? 16384 : 8192;
    const bf16* P = (const bf16*)(a.ws + WS_BIG); bf16* A2 = (bf16*)(a.ws + WS_BIG + 64 * MiB);
    const int tid = mk_tid(), lane = tid & 63, wave = __builtin_amdgcn_readfirstlane(tid >> 6);
    for (int tile = blockIdx.x; tile < MG / 64; tile += gridDim.x) {
        if (wave < 4) {
            const int b0 = (tile * 64) & ~(S - 1), t0 = ((tile * 64) & (S - 1)) + (lane >> 4) * 16, c0 = (wave * 16 + (lane & 15)) * 8;
            if (wave == 0) stencil_pool<1>(P, A2, b0, S, t0, c0);
            else if (wave == 1) stencil_pool<2>(P, A2, b0, S, t0, c0);
            else if (wave == 2) stencil_pool<4>(P, A2, b0, S, t0, c0);
            else stencil_pool<8>(P, A2, b0, S, t0, c0);
        } else {
            const int b0 = (tile * 64) & ~(S - 1), t0 = ((tile * 64) & (S - 1)) + (wave - 4) * 16, c0 = lane * 8;
            stencil_conv(P, A2, a.in[8] + (size_t)j * 3 * 512 + c0, b0, S, t0, c0);
        }
    }
}

__device__ __forceinline__ void phase_attention(const Args& a, int g, int layer, char* lds) {
    using namespace att;
    const int S = g ? 16384 : 8192, logS = g ? 14 : 13; const int j = layer >> 1;
    const bf16* Qb = (const bf16*)(a.ws + WS_BIG); const bf16* Kb = Qb + (size_t)MG * 1024; const bf16* Vb = Kb + (size_t)MG * 1024; bf16* Ob = (bf16*)(a.ws + WS_BIG);
    unsigned* ctr = (unsigned*)(a.ws + WS_CTL) + CW_ATTCTR + 64 * (g * 2 + j);
    unsigned* arr = (unsigned*)(a.ws + WS_CTL) + CW_ARR + 1024 * (g * 2 + j);
    const unsigned* nrm = (const unsigned*)(a.ws + WS_CTL) + CW_NRM + 256 * (g * 2 + j);
    volatile unsigned* s_unit = (volatile unsigned*)(lds + OFF_UNIT);
    const float lambda_init = (layer == 1) ? 0.35550906759096926f : 0.5560582041556405f;
    float lam;
    { const float* q1 = a.in[12] + j * 64; const float* k1 = a.in[13] + j * 64; const float* q2 = a.in[14] + j * 64; const float* k2 = a.in[15] + j * 64;
      const int lane = mk_tid() & 63; float s1 = q1[lane] * k1[lane], s2 = q2[lane] * k2[lane]; s1 = wave_sum(s1); s2 = wave_sum(s2); lam = __expf(s1) - __expf(s2) + lambda_init; }
    const float* subg = a.in[16] + j * 128;
    for (;;) {
        const int tid = mk_tid(), wid = tid >> 6, lane = tid & 63, r32 = lane & 31, hi = lane >> 5;
        __syncthreads();
        if (tid == 0) s_unit[0] = atomicAdd(ctr, 1u);
        __syncthreads();
        const int tk = (int)s_unit[0];
        if (tk >= 1024 * MK_DUP_ATT) break;
        const int u = tk / MK_DUP_ATT; const bool dup = (tk % MK_DUP_ATT) != 0;
        const int h = 7 - (u >> 7), qbi = (u >> 1) & 63, pass = u & 1, uid = u >> 1;
        const int b = (qbi * 256) >> logS, q0 = (qbi * 256) & (S - 1);
        const size_t rowbase = (size_t)b * S;
        const float slope2 = __builtin_amdgcn_exp2f(-(float)(h + 1)) * 1.4426950408889634f;
        const int qpos = q0 + wid * QBLK + r32;
        f32x16 o[4];
        {
            const int map = 2 * h + pass;
            int klo = 0, khi = S; float smax;
            { const unsigned* nq = nrm + ((0 * 2 + b) * 16 + map) * 2; const unsigned* nk = nrm + ((1 * 2 + b) * 16 + map) * 2;
              const float qn2 = __uint_as_float(__hip_atomic_load(nq, __ATOMIC_RELAXED, __HIP_MEMORY_SCOPE_AGENT)) + __uint_as_float(__hip_atomic_load(nq + 1, __ATOMIC_RELAXED, __HIP_MEMORY_SCOPE_AGENT));
              const float kn2 = __uint_as_float(__hip_atomic_load(nk, __ATOMIC_RELAXED, __HIP_MEMORY_SCOPE_AGENT)) + __uint_as_float(__hip_atomic_load(nk + 1, __ATOMIC_RELAXED, __HIP_MEMORY_SCOPE_AGENT));
              smax = sqrtf(qn2 * kn2) * 1.02f;
#if MK_WINDOW
              float sown;
              { const bf16* qp = Qb + (rowbase + q0 + wid * QBLK + r32) * 1024 + map * 64 + hi * 32; const bf16* kp = Kb + (rowbase + q0 + wid * QBLK + r32) * 1024 + map * 64 + hi * 32;
                float acc = 0.f, qq = 0.f;
#pragma unroll
                for (int c = 0; c < 4; ++c) { const v4u qa = *(const v4u*)(qp + c * 8), ka = *(const v4u*)(kp + c * 8);
                    acc += bflo(qa.x) * bflo(ka.x) + bfhi(qa.x) * bfhi(ka.x) + bflo(qa.y) * bflo(ka.y) + bfhi(qa.y) * bfhi(ka.y)
                         + bflo(qa.z) * bflo(ka.z) + bfhi(qa.z) * bfhi(ka.z) + bflo(qa.w) * bflo(ka.w) + bfhi(qa.w) * bfhi(ka.w);
                    qq += bflo(qa.x) * bflo(qa.x) + bfhi(qa.x) * bfhi(qa.x) + bflo(qa.y) * bflo(qa.y) + bfhi(qa.y) * bfhi(qa.y)
                        + bflo(qa.z) * bflo(qa.z) + bfhi(qa.z) * bfhi(qa.z) + bflo(qa.w) * bflo(qa.w) + bfhi(qa.w) * bfhi(qa.w); }
                acc = sum_x32(acc); qq = sum_x32(qq);
                acc = fminf(acc, xor_lt32<1>(acc)); acc = fminf(acc, xor_lt32<2>(acc)); acc = fminf(acc, xor_lt32<4>(acc)); acc = fminf(acc, xor_lt32<8>(acc)); acc = fminf(acc, xor_lt32<16>(acc));
                qq = fmaxf(qq, xor_lt32<1>(qq)); qq = fmaxf(qq, xor_lt32<2>(qq)); qq = fmaxf(qq, xor_lt32<4>(qq)); qq = fmaxf(qq, xor_lt32<8>(qq)); qq = fmaxf(qq, xor_lt32<16>(qq));
                float* wmin = (float*)(lds + OFF_UNIT) + 8;
                if (lane == 0) { wmin[wid] = acc; wmin[8 + wid] = qq; }
                __syncthreads();
                sown = fminf(fminf(fminf(wmin[0], wmin[1]), fminf(wmin[2], wmin[3])), fminf(fminf(wmin[4], wmin[5]), fminf(wmin[6], wmin[7])));
                sown = fminf(sown, 0.f) - 0.25f;
                const float qu2 = fmaxf(fmaxf(fmaxf(wmin[8], wmin[9]), fmaxf(wmin[10], wmin[11])), fmaxf(fmaxf(wmin[12], wmin[13]), fmaxf(wmin[14], wmin[15])));
                smax = fminf(smax, sqrtf(qu2 * kn2) * 1.02f);
              }
              const float wf = (smax - sown + 24.f) / slope2;
              const int wi = (wf < (float)S) ? (int)wf + 1 : S;
              klo = max(q0 - wi, 0) & ~127; khi = min((q0 + 256 + wi + 127) & ~127, S);
#endif
            }
            const int NT = (khi - klo) >> 6;
            const bf16* Qw = Qb + (rowbase + q0 + wid * QBLK + r32) * 1024 + map * 64 + hi * 8;
            const bf16* Kh = Kb + (rowbase + klo) * 1024 + map * 64;
            const bf16* Vh = Vb + (rowbase + klo) * 1024 + h * 128;
            attn_pass(Qw, Kh, Vh, NT, (float)(qpos - klo), klo - (q0 + __builtin_amdgcn_readfirstlane(wid) * QBLK), -slope2, smax, o, lds);
        }
        if (dup) continue;
        const int t2 = mk_tid(); const int r32b = t2 & 31, hib = (t2 >> 5) & 1, widb = t2 >> 6;
        if (t2 == 0) s_unit[1] = atomicAdd(arr + 2 * uid, 1u);
        __syncthreads();
        const unsigned first = s_unit[1];
        f32x4* sp = (f32x4*)(uid < 256 ? (float*)(a.ws + WS_XB) + (size_t)uid * 32768 : (float*)(a.ws + WS_BIG + 96 * MiB) + (size_t)(uid - 256) * 32768) + t2;
        if (first == 0u) {
#pragma unroll
            for (int d0 = 0; d0 < 4; ++d0)
#pragma unroll
                for (int q = 0; q < 4; ++q) {
                    const f32x4 w = {o[d0][4 * q], o[d0][4 * q + 1], o[d0][4 * q + 2], o[d0][4 * q + 3]};
                    asm volatile("global_store_dwordx4 %0, %1, off sc1" :: "v"(sp + (d0 * 4 + q) * 512), "v"(w) : "memory");
                }
            asm volatile("s_waitcnt vmcnt(0)" ::: "memory");
            __syncthreads();
            if (t2 == 0) __hip_atomic_store(arr + 2 * uid + 1, 1u, __ATOMIC_RELAXED, __HIP_MEMORY_SCOPE_AGENT);
            continue;
        }
        if (t2 == 0) { unsigned spn = 0; while (__hip_atomic_load(arr + 2 * uid + 1, __ATOMIC_RELAXED, __HIP_MEMORY_SCOPE_AGENT) == 0u) { __builtin_amdgcn_s_sleep(2); if (++spn > (1u << 24)) break; } }
        __syncthreads();
        float ssq[16];
#pragma unroll
        for (int r = 0; r < 16; ++r) ssq[r] = 0.f;
        f32x4 w[16];
#pragma unroll
        for (int i = 0; i < 16; ++i) asm volatile("global_load_dwordx4 %0, %1, off sc1" : "=v"(w[i]) : "v"(sp + i * 512) : "memory");
        asm volatile("s_waitcnt vmcnt(0)" : "+v"(w[0]), "+v"(w[1]), "+v"(w[2]), "+v"(w[3]), "+v"(w[4]), "+v"(w[5]), "+v"(w[6]), "+v"(w[7]),
                                             "+v"(w[8]), "+v"(w[9]), "+v"(w[10]), "+v"(w[11]), "+v"(w[12]), "+v"(w[13]), "+v"(w[14]), "+v"(w[15]) :: "memory");
#pragma unroll
        for (int d0 = 0; d0 < 4; ++d0)
#pragma unroll
            for (int q = 0; q < 4; ++q) {
#pragma unroll
                for (int e = 0; e < 4; ++e) { const int r = 4 * q + e; const float t = w[d0 * 4 + q][e]; const float v = pass ? (t - lam * o[d0][r]) : (o[d0][r] - lam * t);
                    o[d0][r] = v; ssq[r] = fmaf(v, v, ssq[r]); } }
#pragma unroll
        for (int r = 0; r < 16; ++r) {
            float s = ssq[r];
            s += xor_lt32<1>(s); s += xor_lt32<2>(s); s += xor_lt32<4>(s); s += xor_lt32<8>(s); s += xor_lt32<16>(s);
            ssq[r] = __builtin_amdgcn_rsqf(s * (1.0f / 128.0f) + 1e-5f) * (1.0f - lambda_init);
        }
        bf16* Ow = Ob + (rowbase + q0 + widb * QBLK + 4 * hib) * 1024 + h * 128 + r32b;
#pragma unroll
        for (int d0 = 0; d0 < 4; ++d0) { const float gg = subg[d0 * 32 + r32b];
#pragma unroll
            for (int r = 0; r < 16; ++r) Ow[(size_t)crow(r, 0) * 1024 + d0 * 32] = (bf16)f2bf(o[d0][r] * ssq[r] * gg); }
    }
}


#define XB_TMO      128
#define XB_XCNT(j)  (256  + 64 * (j))
#define XB_XSUB(j)  (1280 + 64 * (j))
#define XB_XGEN(j)  (2304 + 64 * (j))
#define XB_TOP      3328
#define XB_TOPGEN   3392
#define XCD_BAR_WORDS 3456
#define XB_SPIN_CAP (1u << 22)
__device__ __forceinline__ unsigned xb_ld(unsigned* p)              { return __hip_atomic_load(p, __ATOMIC_RELAXED, __HIP_MEMORY_SCOPE_AGENT); }
__device__ __forceinline__ unsigned xb_add(unsigned* p, unsigned v) { return __hip_atomic_fetch_add(p, v, __ATOMIC_RELAXED, __HIP_MEMORY_SCOPE_AGENT); }
__device__ __forceinline__ unsigned xb_xcc_id() { return (unsigned)__builtin_amdgcn_s_getreg((3 << 11) | 20) & 0xFu; }
#define XB_SPIN(cond, bar) do { unsigned _sp = 0; while (cond) { __builtin_amdgcn_s_sleep(1); \
    if ((++_sp & 255u) == 0u) { if (xb_ld(&(bar)[XB_TMO])) break; if (_sp > XB_SPIN_CAP) { atomicAdd(&(bar)[XB_TMO], 1u); break; } } } } while (0)
struct XcdBarrier { unsigned* bar; unsigned x; volatile LAS unsigned* st; };
__device__ __forceinline__ XcdBarrier xcd_barrier_post(unsigned* bar, volatile LAS unsigned* st) {
    XcdBarrier b; b.bar = bar; b.x = xb_xcc_id(); b.st = st;
    if (mk_tid() == 0) (void)xb_add(&bar[XB_XCNT(b.x)], 1u);
    return b;
}
__device__ __forceinline__ void xcd_barrier_complete(unsigned* bar, unsigned x, unsigned& nloc, unsigned& nx) {
    const unsigned G = gridDim.x * gridDim.y * gridDim.z;
    unsigned sum, cnt, mine, sp = 0u;
    for (;;) {
        sum = 0u; cnt = 0u; mine = 0u;
#pragma unroll
        for (unsigned j = 0; j < 16; ++j) { const unsigned c = xb_ld(&bar[XB_XCNT(j)]); sum += c; cnt += (c > 0u) ? 1u : 0u; mine = (j == x) ? c : mine; }
        if (sum == G) break;
        __builtin_amdgcn_s_sleep(1);
        if ((++sp & 255u) == 0u) { if (xb_ld(&bar[XB_TMO])) break; if (sp > XB_SPIN_CAP) { atomicAdd(&bar[XB_TMO], 1u); break; } }
    }
    nloc = mine > 0u ? mine : 1u; nx = cnt > 0u ? cnt : 1u;
}
__device__ __forceinline__ void xcd_barrier(const XcdBarrier& b) {
    asm volatile("s_waitcnt vmcnt(0)" ::: "memory");
    __syncthreads();
    if (mk_tid() == 0) {
        unsigned* bar = b.bar;
        __builtin_amdgcn_s_waitcnt(0);
        unsigned nloc = b.st[0], nx = b.st[1];
        if (nloc == 0u) { xcd_barrier_complete(bar, b.x, nloc, nx); b.st[0] = nloc; b.st[1] = nx; }
        const unsigned old = xb_add(&bar[XB_XSUB(b.x)], 1u);
        const unsigned gen = old / nloc;
        if (old + 1u == (gen + 1u) * nloc) {
            __builtin_amdgcn_fence(__ATOMIC_RELEASE, "agent");
            asm volatile("s_waitcnt vmcnt(0)" ::: "memory");
            const unsigned og = xb_add(&bar[XB_TOP], 1u);
            const unsigned tg = og / nx;
            if (og + 1u == (tg + 1u) * nx) xb_add(&bar[XB_TOPGEN], 1u);
            else XB_SPIN(xb_ld(&bar[XB_TOPGEN]) == tg, bar);
            __builtin_amdgcn_fence(__ATOMIC_ACQUIRE, "agent");
            xb_add(&bar[XB_XGEN(b.x)], 1u);
            asm volatile("s_waitcnt vmcnt(0)" ::: "memory");
        } else {
            XB_SPIN(xb_ld(&bar[XB_XGEN(b.x)]) == gen, bar);
            __builtin_amdgcn_fence(__ATOMIC_ACQUIRE, "agent");
            asm volatile("s_waitcnt vmcnt(0)" ::: "memory");
        }
    }
    __syncthreads();
}

constexpr int LDS_BYTES = 147456;
constexpr int N_PHASES = 1 + 2 * (4 * 5 + 1);
#ifndef MK_MASK
#define MK_MASK 0xFFFF
#endif
#define EN(k) ((MK_MASK >> (k)) & 1)

__global__ void __launch_bounds__(NTHREADS, 2) fwd_megakernel(Args args) {
    extern __shared__ __attribute__((aligned(16))) unsigned char lds[];
    cg::grid_group grid = cg::this_grid();
    const int lo = args.ph_lo, hi = args.ph_hi;
    int ph = 0;
#define RUN() (ph >= lo && ph < hi)
#if MK_PROBE
    unsigned long long t_last = __builtin_amdgcn_s_memrealtime(), t_a = 0, t_b = 0;
#define SEAMK(k) do { if (ph >= lo && ph + 1 < hi) grid.sync(); ++ph; { const unsigned long long t_now = __builtin_amdgcn_s_memrealtime(); \
        if ((MK_PROBE_A >> (k)) & 1) t_a += t_now - t_last; if ((MK_PROBE_B >> (k)) & 1) t_b += t_now - t_last; t_last = t_now; } } while (0)
#else
#define SEAMK(k) do { if (ph >= lo && ph + 1 < hi) { if (ph == 0) { grid.sync(); xbar = xcd_barrier_post((unsigned*)(ws + WS_CTL) + CW_BAR, xst); } else xcd_barrier(xbar); } ++ph; } while (0)
#endif
#define SEAM() SEAMK(0)
    unsigned char* ws = args.ws;
    volatile LAS unsigned* xst = (volatile LAS unsigned*)((LAS unsigned char*)lds + 131072 + 256);
    if (mk_tid() == 0) { xst[0] = 0u; xst[1] = 0u; }
    __syncthreads();
    XcdBarrier xbar; xbar.bar = (unsigned*)(ws + WS_CTL) + CW_BAR; xbar.x = 0; xbar.st = xst;
    PG8_LAS unsigned char* glds = (PG8_LAS unsigned char*)lds;
    const int G = gridDim.x, c = blockIdx.x;

    if (EN(0) && RUN()) { _Pragma("unroll 1") for (int rep = 0; rep < 1 + (MK_DUP_MISC & 1); ++rep) { phase_prologue(args, (LAS unsigned char*)lds); __syncthreads(); }
                          phase_prep(args, 0); }
    SEAMK(1);
#pragma unroll 1
    for (int g = 0; g < 2; ++g) {
        float* xg = args.out + (size_t)g * MG * D; bf16* XB = (bf16*)(ws + WS_XB);
        float* rsq_base = (float*)(ws + WS_ROWSQ);
#pragma unroll 1
        for (int i = 0; i < DEPTH; ++i) {
            const int j = i >> 1;
            float* rsq_n1 = rsq_base + (size_t)(2 * i) * MG * 16; float* rsq_n2 = rsq_base + (size_t)(2 * i + 1) * MG * 16; float* rsq_nx = rsq_base + (size_t)(2 * i + 2) * MG * 16;
            if ((i & 1) == 0) {
                if (EN(2) && RUN()) {
                    pg8::Gemm gm{XB, (const bf16*)(ws + WS_WMI) + (size_t)j * 2048 * D, MG, 2048, D}; pg8::StaticOrder S; S.init(MG, 2048, G, c);
                    pg8::EpiProj<0> E{(bf16*)(ws + WS_BIG), 2048, rsq_n1, 0, 1.f, nullptr, 0, (PG8_LAS float*)(glds + 131072 + 1024)};
                    _Pragma("unroll 1") for (int rep = 0; rep < MK_DUP; ++rep) pg8::gemm_phase<pg8::EpiProj<0>, pg8::StaticOrder, true, true>(glds, gm, S, E);
                }
                SEAMK(3);
                if (EN(3) && RUN()) { _Pragma("unroll 1") for (int rep = 0; rep < 1 + ((MK_DUP_MISC >> 2) & 1); ++rep) phase_stencil(args, g, j); }
                SEAMK(4);
                if (EN(4) && RUN()) {
                    pg8::Gemm gm{(const bf16*)(ws + WS_BIG + 64 * MiB), (const bf16*)(ws + WS_WMO) + (size_t)j * D * D, MG, D, D}; pg8::StaticOrder S; S.init(MG, D, G, c);
                    pg8::EpiRes E{xg, XB, rsq_n2, 0};
                    if (MK_DUP_RES == 1) { pg8::EpiNull E0; pg8::gemm_phase<pg8::EpiNull, pg8::StaticOrder, true, true>(glds, gm, S, E0); }
                    if (MK_DUP_RES == 2) { pg8::EpiRes E0 = E; E0.dry = 1; pg8::gemm_phase<pg8::EpiRes, pg8::StaticOrder, true, true>(glds, gm, S, E0); }
                    pg8::gemm_phase<pg8::EpiRes, pg8::StaticOrder, true, true>(glds, gm, S, E);
                }
                SEAMK(5);
            } else {
                if (EN(5) && RUN()) {
                    pg8::Gemm gm{XB, (const bf16*)(ws + WS_WQKV) + (size_t)j * 3072 * D, MG, 3072, D}; pg8::StaticOrder S; S.init(MG, 3072, G, c);
                    pg8::EpiProj<1> E{(bf16*)(ws + WS_BIG), 1024, rsq_n1, (size_t)MG * 1024, QSCALE, (unsigned*)(ws + WS_CTL) + CW_NRM + 256 * (g * 2 + j), g ? 14 : 13, (PG8_LAS float*)(glds + 131072 + 1024)};
                    _Pragma("unroll 1") for (int rep = 0; rep < MK_DUP; ++rep) pg8::gemm_phase<pg8::EpiProj<1>, pg8::StaticOrder, true, true>(glds, gm, S, E);
                }
                SEAMK(6);
                if (EN(6) && RUN()) phase_attention(args, g, i, (char*)lds);
                SEAMK(7);
                if (EN(7) && RUN()) {
                    pg8::Gemm gm{(const bf16*)(ws + WS_BIG), (const bf16*)(ws + WS_WAO) + (size_t)j * D * D, MG, D, D}; pg8::StaticOrder S; S.init(MG, D, G, c);
                    pg8::EpiRes E{xg, XB, rsq_n2, 0};
                    if (MK_DUP_RES == 1) { pg8::EpiNull E0; pg8::gemm_phase<pg8::EpiNull, pg8::StaticOrder, true, true>(glds, gm, S, E0); }
                    if (MK_DUP_RES == 2) { pg8::EpiRes E0 = E; E0.dry = 1; pg8::gemm_phase<pg8::EpiRes, pg8::StaticOrder, true, true>(glds, gm, S, E0); }
                    pg8::gemm_phase<pg8::EpiRes, pg8::StaticOrder, true, true>(glds, gm, S, E);
                }
                SEAMK(8);
            }
            if (EN(8) && RUN()) {
                pg8::Gemm gm{XB, (const bf16*)(ws + WS_W1) + (size_t)i * FF * D, MG, FF, D}; pg8::StaticOrder S; S.init(MG, FF, G, c);
                pg8::EpiProj<2> E{(bf16*)(ws + WS_BIG), FF, rsq_n2, 0, 1.f, nullptr, 0, (PG8_LAS float*)(glds + 131072 + 1024)};
                _Pragma("unroll 1") for (int rep = 0; rep < MK_DUP; ++rep) pg8::gemm_phase<pg8::EpiProj<2>, pg8::StaticOrder, true, true>(glds, gm, S, E);
            }
            SEAMK(9);
            if (EN(9) && RUN()) {
                pg8::Gemm gm{(const bf16*)(ws + WS_BIG), (const bf16*)(ws + WS_W2) + (size_t)i * D * FF, MG, D, FF}; pg8::StaticOrder S; S.init(MG, D, G, c);
                pg8::EpiRes E{xg, (i == DEPTH - 1) ? nullptr : XB, rsq_nx, 0};
                if (MK_DUP_RES == 1) { pg8::EpiNull E0; pg8::gemm_phase<pg8::EpiNull, pg8::StaticOrder, true, true>(glds, gm, S, E0); }
                    if (MK_DUP_RES == 2) { pg8::EpiRes E0 = E; E0.dry = 1; pg8::gemm_phase<pg8::EpiRes, pg8::StaticOrder, true, true>(glds, gm, S, E0); }
                    pg8::gemm_phase<pg8::EpiRes, pg8::StaticOrder, true, true>(glds, gm, S, E);
            }
            SEAMK(10);
        }
        if (EN(10) && RUN()) { phase_final(args, g); if (g == 0) phase_prep(args, 1); }
        SEAMK(11);
    }
#if MK_PROBE
    if (blockIdx.x == 0 && (mk_tid() >> 6) == 0) {
        const float da = (float)t_a * 1e-5f / 1.5f, db = (float)t_b * 1e-5f;
        for (int g = 0; g < 2; ++g) { float* r0 = args.out + (size_t)g * MG * D; const int lane = mk_tid() & 63;
            for (int q = 0; q < 16; ++q) r0[q * 64 + lane] += da;
            if (lane == 0) r0[(size_t)2048 * D] += db; }
    }
#endif
#undef RUN
#undef SEAM
}

extern "C" void kernel_launch(void* const* d_in, const int* in_sizes, int n_in, void* d_out, int out_size, void* d_ws, size_t ws_size, hipStream_t stream) {
    static int grid = 0;
    if (grid == 0) {
        if (n_in != 19 || in_sizes[0] != MG * D || in_sizes[1] != MG * D || out_size != MTOT * D || ws_size < WS_END) {
            fprintf(stderr, "kernel_launch: unexpected shapes: n_in %d in0 %d in1 %d out %d ws %zu (need %zu); nothing launched\n", n_in, n_in > 0 ? in_sizes[0] : -1, n_in > 1 ? in_sizes[1] : -1, out_size, ws_size, (size_t)WS_END);
            grid = -1; return; }
        int dev = 0, cus = 0, per_cu = 0;
        hipGetDevice(&dev);
        hipDeviceGetAttribute(&cus, hipDeviceAttributeMultiprocessorCount, dev);
        if (hipFuncSetAttribute((const void*)fwd_megakernel, hipFuncAttributeMaxDynamicSharedMemorySize, LDS_BYTES) != hipSuccess) { fprintf(stderr, "kernel_launch: hipFuncSetAttribute failed\n"); grid = -1; return; }
        if (hipOccupancyMaxActiveBlocksPerMultiprocessor(&per_cu, (const void*)fwd_megakernel, NTHREADS, LDS_BYTES) != hipSuccess || per_cu < 1) { fprintf(stderr, "kernel_launch: occupancy query failed (%d)\n", per_cu); per_cu = 1; }
        (void)hipGetLastError();
        grid = cus * per_cu;
        if (grid > 256) grid = 256;
    }
    if (grid < 0) return;
    Args a{};
    for (int i = 0; i < 19; ++i) a.in[i] = (const float*)d_in[i];
    a.out = (float*)d_out; a.ws = (unsigned char*)d_ws;
#if MK_PER_PHASE
    for (int p = 0; p < N_PHASES; ++p) {
        a.ph_lo = p; a.ph_hi = p + 1;
        void* kargs[] = {&a};
        hipError_t e = hipLaunchCooperativeKernel((const void*)fwd_megakernel, dim3(grid), dim3(NTHREADS), kargs, LDS_BYTES, stream);
        if (e != hipSuccess) { fprintf(stderr, "kernel_launch: cooperative launch %d failed: %s\n", p, hipGetErrorString(e)); break; }
    }
#else
    a.ph_lo = 0; a.ph_hi = N_PHASES;
    void* kargs[] = {&a};
    hipError_t e = hipLaunchCooperativeKernel((const void*)fwd_megakernel, dim3(grid), dim3(NTHREADS), kargs, LDS_BYTES, stream);
    if (e != hipSuccess) fprintf(stderr, "kernel_launch: cooperative launch failed: %s (grid %d)\n", hipGetErrorString(e), grid);
#endif
}
```

```cpp
#include <hip/hip_runtime.h>
#include <hip/hip_cooperative_groups.h>
#include <cstdio>
#include <cstdint>
namespace cg = cooperative_groups;

#ifndef MK_WINDOW
#define MK_WINDOW 1
#endif
#ifndef MK_PROBE
#define MK_PROBE 0
#endif
#ifndef MK_PROBE_A
#define MK_PROBE_A (1 << 7)
#endif
#ifndef MK_PROBE_B
#define MK_PROBE_B ((1 << 3) | (1 << 5) | (1 << 6) | (1 << 8) | (1 << 9) | (1 << 10))
#endif
#ifndef MK_DUP
#define MK_DUP 1
#endif
#ifndef MK_DUP_ATT
#define MK_DUP_ATT 1
#endif
#ifndef MK_DUP_MISC
#define MK_DUP_MISC 0
#endif
#ifndef MK_DUP_RES
#define MK_DUP_RES 0
#endif
#ifndef MK_PER_PHASE
#define MK_PER_PHASE 0
#endif

__device__ __forceinline__ int mk_tid() { int t = threadIdx.x; asm volatile("" : "+v"(t)); return t; }

template <int M> __device__ __forceinline__ float xor_lt32(float v) { return __int_as_float(__builtin_amdgcn_ds_swizzle(__float_as_int(v), (M << 10) | 0x1f)); }
__device__ __forceinline__ float sum_x32(float v) { auto rr = __builtin_amdgcn_permlane32_swap(__float_as_uint(v), __float_as_uint(v), false, false); return __uint_as_float(rr[0]) + __uint_as_float(rr[1]); }

namespace pg8 {
#define PG8_LAS __attribute__((address_space(3)))
typedef unsigned short bf16_t;
typedef short bf16x8 __attribute__((ext_vector_type(8)));
typedef float f32x4 __attribute__((ext_vector_type(4)));
typedef unsigned u32x4 __attribute__((ext_vector_type(4)));
constexpr int BM = 256, BK = 64, HALF = 128, HTB = HALF * BK * 2  , STAGE_BYTES = 8 * HTB, NXCD = 8, WGM = 8;

__host__ __device__ __forceinline__ int lds_byte(int r, int c) { const int st = (r >> 4) * 2 + (c >> 5), rr = r & 15, cc = c & 31, ob = rr * 64 + cc * 2; return st * 1024 + (ob ^ (((ob >> 9) & 1) << 5)); }
__host__ __device__ __forceinline__ void stage_rc(int b, int& R, int& C) { const int st = b / 1024, sb = b % 1024, swz = sb ^ (((sb >> 9) & 1) << 5); R = (st >> 1) * 16 + swz / 64; C = (st & 1) * 32 + (swz % 64) / 2; }
__host__ __device__ __forceinline__ int perm32(int rho) { const int n = rho >> 4, i = rho & 15; return 8 * (i >> 2) + 4 * n + (i & 3); }

struct Unit { int pm, pn; };
struct Gemm { const bf16_t* A; const bf16_t* Bt; int M, N, K; };

struct StaticOrder {
    int nM, nN, nwg, G, c;
    __host__ __device__ void init(int M, int N, int G_, int c_) { nM = M / BM; nN = N / BM; nwg = nM * nN; G = G_; c = c_; }
    __host__ __device__ bool next(int i, Unit& u) const {
        const long L = (long)i * G + c; if (L >= nwg) return false;
        int wgid = (int)L; { const int q = nwg / NXCD, r = nwg % NXCD, xcd = wgid % NXCD, off = wgid / NXCD; wgid = (xcd < r ? xcd * (q + 1) : r * (q + 1) + (xcd - r) * q) + off; }
        const int nig = WGM * nN, gid = wgid / nig, fm = gid * WGM, gsz = (nM - fm) < WGM ? (nM - fm) : WGM;
        u.pm = fm + ((wgid % nig) % gsz); u.pn = (wgid % nig) / gsz; return true;
    }
    __device__ __forceinline__ void a_ready(const Unit&) const {}
    __device__ __forceinline__ void done(const Unit&) const {}
};

__device__ __forceinline__ unsigned cvt_pk_bf16(float lo, float hi) { unsigned r; asm volatile("v_cvt_pk_bf16_f32 %0, %1, %2" : "=v"(r) : "v"(lo), "v"(hi)); return r; }
typedef float f32x2 __attribute__((ext_vector_type(2)));
template <int MODE> struct EpiProj {
    static constexpr bool PERM = true, AFTER_DRAIN = false;
    bf16_t* O; int ldc; const float* rowsq; size_t split_stride; float scale0; unsigned* nrm; int logS; PG8_LAS float* rl;
    __device__ __forceinline__ void operator()(const f32x4 (&acc)[2][2][4][2], const Unit& u, int wr, int wc, int fr, int fq) const {
        const int row0 = u.pm * BM + wr * 64 + fr; int colt = u.pn * BM; bf16_t* base = O; float sc = 1.f; int t = 0;
        if (MODE == 1) { t = colt >> 10; base += (size_t)t * split_stride; colt &= 1023; if (t == 0) sc = scale0; }
        const int col0 = colt + wc * 32 + 8 * fq;
        float nmx[2] = {0.f, 0.f};
        { const int t = (wr * 4 + wc) * 64 + fq * 16 + fr;
          const f32x4* rp = (const f32x4*)(rowsq + (size_t)(u.pm * BM + (t >> 1)) * 16) + (t & 1) * 2; const f32x4 a0 = rp[0], a1 = rp[1];
          float s = ((a0[0] + a0[1]) + (a0[2] + a0[3])) + ((a1[0] + a1[1]) + (a1[2] + a1[3]));
          s += xor_lt32<1>(s);
          if ((t & 1) == 0) rl[t >> 1] = __builtin_amdgcn_rsqf(s * (1.0f / 1024.0f) + 1e-6f);
          asm volatile("s_waitcnt lgkmcnt(0)" ::: "memory"); __builtin_amdgcn_s_barrier(); asm volatile("" ::: "memory"); }
#pragma unroll
        for (int ai = 0; ai < 2; ++ai)
#pragma unroll
            for (int m = 0; m < 4; ++m) {
                const int row = row0 + ai * HALF + m * 16;
                const float rs = rl[wr * 64 + fr + ai * HALF + m * 16] * sc;
                bf16_t* rowp = base + (size_t)row * ldc + col0;
#pragma unroll
                for (int bj = 0; bj < 2; ++bj) {
                    f32x4 v0 = acc[ai][bj][m][0] * rs, v1 = acc[ai][bj][m][1] * rs;
                    if (MODE == 2) {
#pragma unroll
                        for (int e = 0; e < 4; ++e) { const float a = fmaxf(v0[e], 0.f), b = fmaxf(v1[e], 0.f); v0[e] = a * a; v1[e] = b * b; }
                    }
                    if (MODE == 1) {
                        float s = (v0[0] * v0[0] + v0[1] * v0[1]) + (v0[2] * v0[2] + v0[3] * v0[3]) + (v1[0] * v1[0] + v1[1] * v1[1]) + (v1[2] * v1[2] + v1[3] * v1[3]);
                        s += xor_lt32<16>(s); s = sum_x32(s);
                        nmx[bj] = fmaxf(nmx[bj], s);
                    }
                    u32x4 w; w.x = cvt_pk_bf16(v0[0], v0[1]); w.y = cvt_pk_bf16(v0[2], v0[3]); w.z = cvt_pk_bf16(v1[0], v1[1]); w.w = cvt_pk_bf16(v1[2], v1[3]);
                    *(u32x4*)(rowp + bj * HALF) = w;
                }
            }
        if (MODE == 1) {
            if (t < 2) {
                const int b = (u.pm * BM) >> logS;
#pragma unroll
                for (int bj = 0; bj < 2; ++bj) {
                    float v = nmx[bj];
                    v = fmaxf(v, xor_lt32<1>(v)); v = fmaxf(v, xor_lt32<2>(v)); v = fmaxf(v, xor_lt32<4>(v)); v = fmaxf(v, xor_lt32<8>(v));
                    const int map = (colt >> 6) + 2 * bj + (wc >> 1), half = wc & 1;
                    if (fr == 0 && fq == 0) atomicMax(nrm + (((t * 2 + b) * 16 + map) * 2 + half), __float_as_uint(v));
                }
            }
        }
    }
};
struct EpiRes {
    static constexpr bool PERM = true, AFTER_DRAIN = false;
    bf16_t* xb; float* rowsq; int dry;
    __device__ __forceinline__ void operator()(const f32x4 (&acc)[2][2][4][2], const Unit& u, int wr, int wc, int fr, int fq) const {
        const int col0 = u.pn * BM + wc * 32 + 8 * fq;
#pragma unroll
        for (int ai = 0; ai < 2; ++ai)
#pragma unroll
            for (int m = 0; m < 4; ++m) {
                const int row = u.pm * BM + ai * HALF + wr * 64 + m * 16 + fr; bf16_t* rowp = xb + (size_t)row * 1024 + col0;
                float ss = 0.f;
#pragma unroll
                for (int bj = 0; bj < 2; ++bj) {
                    const u32x4 w = *(const u32x4*)(rowp + bj * HALF);
                    const f32x4 a0 = acc[ai][bj][m][0], a1 = acc[ai][bj][m][1];
                    u32x4 o;
                    o.x = cvt_pk_bf16(__uint_as_float(w.x << 16) + a0[0], __uint_as_float(w.x & 0xffff0000u) + a0[1]);
                    o.y = cvt_pk_bf16(__uint_as_float(w.y << 16) + a0[2], __uint_as_float(w.y & 0xffff0000u) + a0[3]);
                    o.z = cvt_pk_bf16(__uint_as_float(w.z << 16) + a1[0], __uint_as_float(w.z & 0xffff0000u) + a1[1]);
                    o.w = cvt_pk_bf16(__uint_as_float(w.w << 16) + a1[2], __uint_as_float(w.w & 0xffff0000u) + a1[3]);
                    *(u32x4*)(rowp + bj * HALF) = dry ? w : o;
                    { const float e0 = __uint_as_float(o.x << 16), e1 = __uint_as_float(o.x & 0xffff0000u), e2 = __uint_as_float(o.y << 16), e3 = __uint_as_float(o.y & 0xffff0000u);
                      const float e4 = __uint_as_float(o.z << 16), e5 = __uint_as_float(o.z & 0xffff0000u), e6 = __uint_as_float(o.w << 16), e7 = __uint_as_float(o.w & 0xffff0000u);
                      ss += ((e0 * e0 + e1 * e1) + (e2 * e2 + e3 * e3)) + ((e4 * e4 + e5 * e5) + (e6 * e6 + e7 * e7)); }
                }
                ss += xor_lt32<16>(ss); ss = sum_x32(ss);
                if (fq == 0) rowsq[(size_t)row * 16 + u.pn * 4 + wc] = ss;
            }
    }
};

struct EpiNull {
    static constexpr bool PERM = false, AFTER_DRAIN = false;
    __device__ __forceinline__ void operator()(const f32x4 (&acc)[2][2][4][2], const Unit& u, int wr, int wc, int fr, int fq) const {
#pragma unroll
        for (int ai = 0; ai < 2; ++ai)
#pragma unroll
            for (int bj = 0; bj < 2; ++bj)
#pragma unroll
                for (int m = 0; m < 4; ++m)
#pragma unroll
                    for (int n = 0; n < 2; ++n) asm volatile("" :: "v"(acc[ai][bj][m][n]));
    }
};

template <class Epi, class Sched, bool ALIGN_EPI = false, bool SP2 = false>
__device__ __forceinline__ void gemm_phase(PG8_LAS unsigned char* lds, const Gemm g, const Sched& S, const Epi& E) {
    const int tid = mk_tid(), wid = __builtin_amdgcn_readfirstlane(tid >> 6), lane = tid & 63, wr = wid >> 2, wc = wid & 3, fr = lane & 15, fq = lane >> 4;
    const int K = g.K, nt = K / BK;
    unsigned voffA[2], voffB[2];
#pragma unroll
    for (int i = 0; i < 2; ++i) { int R, C; stage_rc(tid * 16 + i * 8192, R, C); const int Rb = Epi::PERM ? ((R & ~31) + perm32(R & 31)) : R;
        voffA[i] = (unsigned)(R * K + C) * 2u; voffB[i] = (unsigned)(Rb * K + C) * 2u; }
    const size_t kstep = (size_t)(BK * 2);
    const size_t hstep = (size_t)HALF * K * 2;
    const size_t tstep = 2 * hstep;
    const unsigned ldsw = (unsigned)wid * 1024u;
    const int aoff = lds_byte(wr * 64 + fr, fq * 8), boff = lds_byte(wc * 32 + fr, fq * 8);
#define PG8_SA(b, h) (((b) * 2 + (h)) * HTB)
#define PG8_SB(b, h) ((4 + (b) * 2 + (h)) * HTB)
#define PG8_STAGE(bufoff, gbase, voff) do { _Pragma("unroll") for (int _i = 0; _i < 2; ++_i) \
        __builtin_amdgcn_global_load_lds((const unsigned*)((const char*)(gbase) + (voff)[_i]), (PG8_LAS unsigned*)(lds + (bufoff) + ldsw + _i * 8192), 16, 0, 0); } while (0)
#define PG8_LDA(dst, b, h) do { _Pragma("unroll") for (int m = 0; m < 4; ++m) _Pragma("unroll") for (int k = 0; k < 2; ++k) dst[m][k] = *(const PG8_LAS bf16x8*)(lds + PG8_SA(b, h) + aoff + m * 2048 + k * 1024); } while (0)
#define PG8_LDB(dst, b, h) do { _Pragma("unroll") for (int n = 0; n < 2; ++n) _Pragma("unroll") for (int k = 0; k < 2; ++k) dst[n][k] = *(const PG8_LAS bf16x8*)(lds + PG8_SB(b, h) + boff + n * 2048 + k * 1024); } while (0)
#define PG8_MMA(ai, bj, At, Bt) do { __builtin_amdgcn_s_setprio(1); _Pragma("unroll") for (int m = 0; m < 4; ++m) _Pragma("unroll") for (int n = 0; n < 2; ++n) _Pragma("unroll") for (int k = 0; k < 2; ++k) \
        acc[ai][bj][m][n] = __builtin_amdgcn_mfma_f32_16x16x32_bf16(Bt[n][k], At[m][k], acc[ai][bj][m][n], 0, 0, 0); __builtin_amdgcn_s_setprio(0); } while (0)
#define PG8_WAIT_V(n) asm volatile("s_waitcnt vmcnt(" #n ")" ::: "memory")
#define PG8_WAIT_L(n) asm volatile("s_waitcnt lgkmcnt(" #n ")" ::: "memory")
#define PG8_BAR __builtin_amdgcn_s_barrier()
#define PG8_SCHED __builtin_amdgcn_sched_barrier(0)
    Unit cur, nxt; int ui = 0;
    if (!S.next(0, cur)) return;
    f32x4 acc[2][2][4][2];
#pragma unroll
    for (int a = 0; a < 2; ++a)
#pragma unroll
        for (int b = 0; b < 2; ++b)
#pragma unroll
            for (int m = 0; m < 4; ++m)
#pragma unroll
                for (int n = 0; n < 2; ++n) acc[a][b][m][n] = (f32x4){0.f, 0.f, 0.f, 0.f};
    bf16x8 At[4][2], B0[2][2], B1[2][2];
    const char* cA = (const char*)g.A + (size_t)cur.pm * tstep; const char* cB = (const char*)g.Bt + (size_t)cur.pn * tstep;
    S.a_ready(cur);
    if constexpr (SP2) {
        PG8_STAGE(PG8_SB(0, 0), cB, voffB); PG8_STAGE(PG8_SB(0, 1), cB + hstep, voffB); PG8_STAGE(PG8_SA(0, 0), cA, voffA); PG8_STAGE(PG8_SA(0, 1), cA + hstep, voffA);
        if (wr == 1) PG8_BAR;
        PG8_WAIT_V(2); PG8_BAR;
        PG8_STAGE(PG8_SB(1, 0), cB + kstep, voffB); PG8_STAGE(PG8_SA(1, 0), cA + kstep, voffA); PG8_STAGE(PG8_SB(1, 1), cB + hstep + kstep, voffB);
        PG8_WAIT_V(6); PG8_BAR;
    } else {
        PG8_STAGE(PG8_SB(0, 0), cB, voffB); PG8_STAGE(PG8_SA(0, 0), cA, voffA); PG8_STAGE(PG8_SB(0, 1), cB + hstep, voffB); PG8_STAGE(PG8_SA(0, 1), cA + hstep, voffA);
        if (wr == 1) PG8_BAR;
        PG8_WAIT_V(4); PG8_BAR;
        PG8_STAGE(PG8_SB(1, 0), cB + kstep, voffB); PG8_STAGE(PG8_SA(1, 0), cA + kstep, voffA); PG8_STAGE(PG8_SB(1, 1), cB + hstep + kstep, voffB);
        PG8_WAIT_V(6); PG8_BAR;
    }
    for (;;) {
        const bool has_next = S.next(ui + 1, nxt);
        const char* nA = has_next ? (const char*)g.A + (size_t)nxt.pm * tstep : cA; const char* nB = has_next ? (const char*)g.Bt + (size_t)nxt.pn * tstep : cB;
        for (int t = 0; t < nt; t += 2) {
            const bool last = (t == nt - 2);
            const char* a1 = cA + (size_t)(t + 1) * kstep;
            const char* a2 = last ? nA : cA + (size_t)(t + 2) * kstep; const char* b2 = last ? nB : cB + (size_t)(t + 2) * kstep;
            const char* a3 = a2 + kstep; const char* b3 = b2 + kstep;
            if (last && has_next) S.a_ready(nxt);
            if constexpr (SP2) {
            PG8_LDB(B0, 0, 0); PG8_LDB(B1, 0, 1); PG8_SCHED; PG8_LDA(At, 0, 0); PG8_STAGE(PG8_SA(1, 1), a1 + hstep, voffA);
            PG8_WAIT_V(8); PG8_WAIT_L(0); PG8_BAR; PG8_MMA(0, 0, At, B0); PG8_MMA(0, 1, At, B1); PG8_BAR; PG8_SCHED;
            PG8_LDA(At, 0, 1); PG8_STAGE(PG8_SB(0, 0), b2, voffB); PG8_STAGE(PG8_SB(0, 1), b2 + hstep, voffB); PG8_STAGE(PG8_SA(0, 0), a2, voffA);
            PG8_WAIT_V(8); PG8_WAIT_L(0); PG8_BAR; PG8_MMA(1, 0, At, B0); PG8_MMA(1, 1, At, B1); PG8_BAR; PG8_SCHED;
            PG8_LDB(B0, 1, 0); PG8_LDB(B1, 1, 1); PG8_SCHED; PG8_LDA(At, 1, 0); PG8_STAGE(PG8_SA(0, 1), a2 + hstep, voffA);
            PG8_WAIT_V(8); PG8_WAIT_L(0); PG8_BAR; PG8_MMA(0, 0, At, B0); PG8_MMA(0, 1, At, B1); PG8_BAR; PG8_SCHED;
            PG8_LDA(At, 1, 1); PG8_STAGE(PG8_SB(1, 0), b3, voffB); PG8_STAGE(PG8_SB(1, 1), b3 + hstep, voffB); PG8_STAGE(PG8_SA(1, 0), a3, voffA);
            PG8_WAIT_V(8); PG8_WAIT_L(0); PG8_BAR; PG8_MMA(1, 0, At, B0); PG8_MMA(1, 1, At, B1); PG8_BAR; PG8_SCHED;
            } else {
            PG8_LDB(B0, 0, 0); PG8_SCHED; PG8_LDA(At, 0, 0); PG8_STAGE(PG8_SA(1, 1), a1 + hstep, voffA);
            PG8_WAIT_L(8); PG8_BAR; PG8_WAIT_L(0); PG8_MMA(0, 0, At, B0); PG8_BAR; PG8_SCHED;
            PG8_LDB(B1, 0, 1); PG8_STAGE(PG8_SB(0, 0), b2, voffB);
            PG8_BAR; PG8_WAIT_L(0); PG8_MMA(0, 1, At, B1); PG8_BAR;
            PG8_LDA(At, 0, 1); PG8_STAGE(PG8_SA(0, 0), a2, voffA);
            PG8_BAR; PG8_WAIT_L(0); PG8_MMA(1, 0, At, B0); PG8_BAR; PG8_SCHED;
            PG8_STAGE(PG8_SB(0, 1), b2 + hstep, voffB);
            PG8_WAIT_V(6); PG8_BAR; PG8_MMA(1, 1, At, B1); PG8_BAR;
            PG8_LDB(B0, 1, 0); PG8_SCHED; PG8_LDA(At, 1, 0); PG8_STAGE(PG8_SA(0, 1), a2 + hstep, voffA);
            PG8_WAIT_L(8); PG8_BAR; PG8_WAIT_L(0); PG8_MMA(0, 0, At, B0); PG8_BAR; PG8_SCHED;
            PG8_LDB(B1, 1, 1); PG8_STAGE(PG8_SB(1, 0), b3, voffB);
            PG8_BAR; PG8_WAIT_L(0); PG8_MMA(0, 1, At, B1); PG8_BAR;
            PG8_LDA(At, 1, 1); PG8_STAGE(PG8_SA(1, 0), a3, voffA);
            PG8_BAR; PG8_WAIT_L(0); PG8_MMA(1, 0, At, B0); PG8_BAR; PG8_SCHED;
            PG8_STAGE(PG8_SB(1, 1), b3 + hstep, voffB);
            PG8_WAIT_V(6); PG8_BAR; PG8_MMA(1, 1, At, B1); PG8_BAR;
            }
        }
        if constexpr (ALIGN_EPI) { if (wr == 0) PG8_BAR; }
        if constexpr (!Epi::AFTER_DRAIN) { E(acc, cur, wr, wc, fr, fq); S.done(cur); }
        if (!has_next) break;
#pragma unroll
        for (int a = 0; a < 2; ++a)
#pragma unroll
            for (int b = 0; b < 2; ++b)
#pragma unroll
                for (int m = 0; m < 4; ++m)
#pragma unroll
                    for (int n = 0; n < 2; ++n) acc[a][b][m][n] = (f32x4){0.f, 0.f, 0.f, 0.f};
        cur = nxt; cA = nA; cB = nB; ++ui;
        if constexpr (ALIGN_EPI) { if (wr == 1) PG8_BAR; }
    }
    PG8_WAIT_V(0);
    if constexpr (!ALIGN_EPI) { if (wr == 0) PG8_BAR; }
    PG8_BAR;
    if constexpr (Epi::AFTER_DRAIN) { E.fused(acc, cur, wr, wc, fr, fq, lds, wid, lane); S.done(cur); }
#undef PG8_SA
#undef PG8_SB
#undef PG8_STAGE
#undef PG8_LDA
#undef PG8_LDB
#undef PG8_MMA
#undef PG8_WAIT_V
#undef PG8_WAIT_L
#undef PG8_BAR
#undef PG8_SCHED
}
}

namespace att {
typedef unsigned short bf16_t;
using bf16x8 = __attribute__((ext_vector_type(8))) short;
using s16x4  = __attribute__((ext_vector_type(4))) short;
using f32x16 = __attribute__((ext_vector_type(16))) float;
using u32x4  = __attribute__((ext_vector_type(4))) unsigned;
constexpr int NW = 8, QBLK = 32, KVBLK = 64, LD = 1024;
constexpr int SHM_V = KVBLK * 128 * 2, SHM_K = KVBLK * 64 * 2;
constexpr int NSLOT = 3;
constexpr int OFF_V = 0, OFF_K = NSLOT * SHM_V, OFF_WS = OFF_K + NSLOT * SHM_K, OFF_UNIT = OFF_WS + NW * 64 * 4, LDS_BYTES = OFF_UNIT + 128;
constexpr int SDEPTH = 1;
constexpr float THR2 = 16.f;
#define KSWZ(row, colB) ((row) * 128 + ((colB) ^ ((((row) >> 1) & 7) << 4)))
#define SBAR() __builtin_amdgcn_sched_barrier(0)
#define SGB_MFMA_VALU(N, V) do { _Pragma("unroll") for (int _g = 0; _g < (N); ++_g) { __builtin_amdgcn_sched_group_barrier(0x008, 1, 0); __builtin_amdgcn_sched_group_barrier(0x400, (V), 0); } } while (0)
__device__ __forceinline__ int crow(int r, int hi) { return (r & 3) + 8 * (r >> 2) + 4 * hi; }
__device__ __forceinline__ unsigned cvtpk(float lo, float hi) { unsigned r; asm volatile("v_cvt_pk_bf16_f32 %0, %1, %2" : "=v"(r) : "v"(lo), "v"(hi)); return r; }

__device__ __forceinline__ void split3(float a, unsigned& h, unsigned& l, unsigned& ll) {
  h = cvtpk(a, 0.f) & 0xffffu; const float r1 = a - __uint_as_float(h << 16);
  l = cvtpk(r1, 0.f) & 0xffffu; const float r2 = r1 - __uint_as_float(l << 16);
  ll = cvtpk(r2, 0.f) & 0xffffu;
}
__device__ __forceinline__ void tile_ctl(int rel, float dq, float m_reg, float nc2, float smax, int hi, bf16x8& qx, int& mode, bool& skip) {
  mode = (rel <= -64) ? 1 : (rel >= 32) ? 2 : 0;
  const float dmin = (mode == 1) ? (float)(-rel - 63) : (float)(rel - 31);
  skip = (mode != 0) && (smax + nc2 * dmin <= THR2);
  const float A = (mode == 1 ? nc2 * dq : -nc2 * dq) - m_reg;
  unsigned ah, al, all_; split3(A, ah, al, all_);
  const unsigned sg = (mode == 1) ? 0x3F80u : 0xBF80u;
  u32x4 w = {ah | (al << 16), all_ | (sg << 16), sg | (sg << 16), 0u};
  if (hi != 0 || mode == 0) w = u32x4{0u, 0u, 0u, 0u};
  qx = *reinterpret_cast<bf16x8*>(&w);
}
__device__ __forceinline__ void partialSM(f32x16& p0, f32x16& p1, float& m_reg, float& alpha, int mode, bool skip, float dqh, float nc2) {
  if (mode == 0) {
    const float dq1 = dqh - 32.f;
#pragma unroll
    for (int r = 0; r < 16; ++r) p0[r] = fmaf(__builtin_fabsf(dqh - (float)((r & 3) + 8 * (r >> 2))), nc2, p0[r]) - m_reg;
#pragma unroll
    for (int r = 0; r < 16; ++r) p1[r] = fmaf(__builtin_fabsf(dq1 - (float)((r & 3) + 8 * (r >> 2))), nc2, p1[r]) - m_reg;
  }
  alpha = 1.f;
  if (!skip) {
    float pmax = p0[0];
#pragma unroll
    for (int r = 1; r < 16; ++r) pmax = fmaxf(pmax, p0[r]);
#pragma unroll
    for (int r = 0; r < 16; ++r) pmax = fmaxf(pmax, p1[r]);
    { auto rr = __builtin_amdgcn_permlane32_swap(__float_as_uint(pmax), __float_as_uint(pmax), false, false);
      pmax = fmaxf(__uint_as_float(rr[0]), __uint_as_float(rr[1])); }
    if (__builtin_expect(!__all(pmax <= THR2), 0)) {
      const float dl = fmaxf(pmax, 0.f); m_reg += dl; alpha = __builtin_amdgcn_exp2f(-dl);
#pragma unroll
      for (int r = 0; r < 16; ++r) p0[r] -= dl;
#pragma unroll
      for (int r = 0; r < 16; ++r) p1[r] -= dl;
    }
  }
}
__device__ __forceinline__ void expP0(f32x16& p0) {
#pragma unroll
  for (int r = 0; r < 16; ++r) p0[r] = __builtin_amdgcn_exp2f(p0[r]);
}
__device__ __forceinline__ void finishSM(f32x16& p0, f32x16& p1, float alpha, float& l_reg, bf16x8& pa0, bf16x8& pa1, bf16x8& pa2, bf16x8& pa3) {
#pragma unroll
  for (int r = 0; r < 16; ++r) p1[r] = __builtin_amdgcn_exp2f(p1[r]);
  float ps = 0;
#pragma unroll
  for (int r = 0; r < 16; ++r) ps += p0[r];
#pragma unroll
  for (int r = 0; r < 16; ++r) ps += p1[r];
  { auto rr = __builtin_amdgcn_permlane32_swap(__float_as_uint(ps), __float_as_uint(ps), false, false);
    ps = __uint_as_float(rr[0]) + __uint_as_float(rr[1]); }
  l_reg = l_reg * alpha + ps;
#define PK4(P, BASE, OUT) do { unsigned a0 = cvtpk(P[BASE + 0], P[BASE + 1]), a1 = cvtpk(P[BASE + 2], P[BASE + 3]);   \
    unsigned b0 = cvtpk(P[BASE + 4], P[BASE + 5]), b1 = cvtpk(P[BASE + 6], P[BASE + 7]);                              \
    auto r0 = __builtin_amdgcn_permlane32_swap(a0, b0, false, false); auto r1 = __builtin_amdgcn_permlane32_swap(a1, b1, false, false); \
    u32x4 w = {r0[0], r1[0], r0[1], r1[1]}; OUT = *reinterpret_cast<bf16x8*>(&w); } while (0)
  PK4(p0, 0, pa0); PK4(p0, 8, pa1); PK4(p1, 0, pa2); PK4(p1, 8, pa3);
#undef PK4
}
__device__ __forceinline__ void qkt(f32x16& p0, f32x16& p1, const char* Ks, const bf16x8* qr, int r32, int hi, bf16x8 kx0, bf16x8 kx1, bf16x8 qx) {
  p0 = __builtin_amdgcn_mfma_f32_32x32x16_bf16(kx0, qx, f32x16{}, 0, 0, 0); p1 = __builtin_amdgcn_mfma_f32_32x32x16_bf16(kx1, qx, f32x16{}, 0, 0, 0);
#pragma unroll
  for (int d0 = 0; d0 < 4; ++d0) { const int cb = d0 * 32 + hi * 16;
    bf16x8 b0 = *reinterpret_cast<const bf16x8*>(Ks + KSWZ(r32, cb));
    bf16x8 b1 = *reinterpret_cast<const bf16x8*>(Ks + KSWZ(32 + r32, cb));
    p0 = __builtin_amdgcn_mfma_f32_32x32x16_bf16(b0, qr[d0], p0, 0, 0, 0);
    p1 = __builtin_amdgcn_mfma_f32_32x32x16_bf16(b1, qr[d0], p1, 0, 0, 0); }
}
__device__ __forceinline__ int v_st(int k, int c) { const int kk = (k & ~0xC) | ((k & 4) << 1) | ((k & 8) >> 1); return ((kk >> 3) * 4 + (c >> 5)) * 512 + ((kk & 7) * 32 + (c & 31)) * 2; }
__device__ __forceinline__ int v_rd_base(int lane) { return ((lane & 3) << 3) | (((lane >> 2) & 3) << 6) | (((lane >> 4) & 1) << 5) | (((lane >> 5) & 1) << 8); }
constexpr int v_rd_off(int d0, int ks, int half) { return d0 * 512 + ks * 4096 + half * 2048; }
template <int OFF> __device__ __forceinline__ s16x4 tr_read(int vb) {
  s16x4 r; asm volatile("ds_read_b64_tr_b16 %0, %1 offset:%2" : "=&v"(r) : "v"(vb), "i"(OFF) : "memory"); return r;
}
#define PV_RDK(KS, L, H) do { L[0] = tr_read<v_rd_off(0, KS, 0)>(vb); H[0] = tr_read<v_rd_off(0, KS, 1)>(vb); L[1] = tr_read<v_rd_off(1, KS, 0)>(vb); H[1] = tr_read<v_rd_off(1, KS, 1)>(vb); \
    L[2] = tr_read<v_rd_off(2, KS, 0)>(vb); H[2] = tr_read<v_rd_off(2, KS, 1)>(vb); L[3] = tr_read<v_rd_off(3, KS, 0)>(vb); H[3] = tr_read<v_rd_off(3, KS, 1)>(vb); } while (0)
#define PV_RD2(KS, D0, L, H) do { L[D0] = tr_read<v_rd_off(D0, KS, 0)>(vb); H[D0] = tr_read<v_rd_off(D0, KS, 1)>(vb); } while (0)
#define PV_WAIT(N, L, H) asm volatile("s_waitcnt lgkmcnt(" #N ")" : "+v"(L[0]), "+v"(H[0]), "+v"(L[1]), "+v"(H[1]), "+v"(L[2]), "+v"(H[2]), "+v"(L[3]), "+v"(H[3]))
#define PV_PK(L, H, D0) (bf16x8){L[D0][0], L[D0][1], L[D0][2], L[D0][3], H[D0][0], H[D0][1], H[D0][2], H[D0][3]}
#define PV_MF(D0, PA, L, H, R) do { o[D0] = __builtin_amdgcn_mfma_f32_32x32x16_bf16(PA, PV_PK(L, H, D0), o[D0], 0, 0, 0); \
    if (EXPS) { px[R] = __builtin_amdgcn_exp2f(px[R]); asm volatile("" : "+v"(px)); } SBAR(); } while (0)
template <bool EXPS> __device__ __forceinline__ void pv_d0(f32x16* o, int vb, bf16x8 pa0, bf16x8 pa1, bf16x8 pa2, bf16x8 pa3, f32x16& px) {
  s16x4 la[4], ha[4], lb[4], hb[4];
  SBAR(); PV_RDK(0, la, ha); SBAR();
  PV_RD2(1, 0, lb, hb); PV_WAIT(2, la, ha);  PV_MF(0, pa0, la, ha, 0);
  PV_RD2(1, 1, lb, hb);                       PV_MF(1, pa0, la, ha, 1);
  PV_RD2(1, 2, lb, hb);                       PV_MF(2, pa0, la, ha, 2);
  PV_RD2(1, 3, lb, hb);                       PV_MF(3, pa0, la, ha, 3);
  PV_RD2(2, 0, la, ha); PV_WAIT(2, lb, hb);  PV_MF(0, pa1, lb, hb, 4);
  PV_RD2(2, 1, la, ha);                       PV_MF(1, pa1, lb, hb, 5);
  PV_RD2(2, 2, la, ha);                       PV_MF(2, pa1, lb, hb, 6);
  PV_RD2(2, 3, la, ha);                       PV_MF(3, pa1, lb, hb, 7);
  PV_RD2(3, 0, lb, hb); PV_WAIT(2, la, ha);  PV_MF(0, pa2, la, ha, 8);
  PV_RD2(3, 1, lb, hb);                       PV_MF(1, pa2, la, ha, 9);
  PV_RD2(3, 2, lb, hb);                       PV_MF(2, pa2, la, ha, 10);
  PV_RD2(3, 3, lb, hb);                       PV_MF(3, pa2, la, ha, 11);
                        PV_WAIT(0, lb, hb);  PV_MF(0, pa3, lb, hb, 12);
                                              PV_MF(1, pa3, lb, hb, 13);
                                              PV_MF(2, pa3, lb, hb, 14);
                                              PV_MF(3, pa3, lb, hb, 15);
}

__device__ __forceinline__ void attn_pass(const bf16_t* __restrict__ Qw, const bf16_t* __restrict__ Kh, const bf16_t* __restrict__ Vh,
                                          int NT, float dqbase, int rel0, float nc2, float smax, f32x16 (&o)[4], char* lds) {
  const int tid = mk_tid(), wid = tid >> 6, lane = tid & 63, r32 = lane & 31, hi = lane >> 5;
  char* V_lds = lds + OFF_V; char* K_lds = lds + OFF_K;
  float* ws = (float*)(lds + OFF_WS) + wid * 64; float* li_l = ws; float* al_l = ws + 32;
  float m_reg = 0.f, l_reg = 0; bf16x8 qr[4];
#pragma unroll
  for (int d = 0; d < 4; ++d) o[d] = f32x16{};
#pragma unroll
  for (int d0 = 0; d0 < 4; ++d0) qr[d0] = *reinterpret_cast<const bf16x8*>(Qw + d0 * 16);
  const float dqh0 = dqbase - (float)(4 * hi);
  bf16x8 kx0, kx1;
  { unsigned bh, bl, bll; u32x4 w;
    split3(-nc2 * (float)r32, bh, bl, bll); w = u32x4{0x3F803F80u, 0x3F80u | (bh << 16), bl | (bll << 16), 0u}; if (hi) w = u32x4{0u, 0u, 0u, 0u}; kx0 = *reinterpret_cast<bf16x8*>(&w);
    split3(-nc2 * (float)(32 + r32), bh, bl, bll); w = u32x4{0x3F803F80u, 0x3F80u | (bh << 16), bl | (bll << 16), 0u}; if (hi) w = u32x4{0u, 0u, 0u, 0u}; kx1 = *reinterpret_cast<bf16x8*>(&w); }
  bf16x8 qx; int mdA, mdB; bool skA, skB;
#define CTL(j, MD, SK) tile_ctl(rel0 + (j) * KVBLK, dqbase - (float)((j) * KVBLK), m_reg, nc2, smax, hi, qx, MD, SK)
  const int sr = tid >> 4, sc = (tid & 15) * 8, vst0 = v_st(sr, sc), vst1 = v_st(32 + sr, sc);
  const int krow = tid >> 3, kcol = (tid & 7) * 8, kst = KSWZ(krow, kcol * 2);
  const int vb0 = (int)(uintptr_t)V_lds + v_rd_base(lane);
  struct { bf16x8 vs0, vs1, ks0; } sg;
#define SLOAD(k0) do { sg.vs0 = *reinterpret_cast<const bf16x8*>(&Vh[(long)((k0) + sr) * LD + sc]); sg.vs1 = *reinterpret_cast<const bf16x8*>(&Vh[(long)((k0) + 32 + sr) * LD + sc]); \
    sg.ks0 = *reinterpret_cast<const bf16x8*>(&Kh[(long)((k0) + krow) * LD + kcol]); } while (0)
#define SWRITE(b) do { *(bf16x8*)(V_lds + (b) * SHM_V + vst0) = sg.vs0; *(bf16x8*)(V_lds + (b) * SHM_V + vst1) = sg.vs1; *(bf16x8*)(K_lds + (b) * SHM_K + kst) = sg.ks0; } while (0)
#define SWAIT() asm volatile("s_waitcnt vmcnt(0)" ::: "memory")
#define RESC(a) do { if (__any((a) < 1.f)) { if (hi == 0) al_l[r32] = (a); asm volatile("s_waitcnt lgkmcnt(0)" ::: "memory"); \
    _Pragma("unroll") for (int d = 0; d < 4; ++d) _Pragma("unroll") for (int r = 0; r < 16; ++r) o[d][r] *= al_l[crow(r, hi)]; } } while (0)
  f32x16 pA0, pA1, pB0, pB1; float alA, alB; bf16x8 pa0, pa1, pa2, pa3;
  int b_prev = 0, b_cur = 1, b_next = 2;
#define ROT() do { const int t_ = b_prev; b_prev = b_cur; b_cur = b_next; b_next = t_; } while (0)
#define STEP(j, X0, X1, Y0, Y1, MDX, SKX, ALX, ALY, WR, LD_) do { SBAR(); \
    if (WR) { SWAIT(); SWRITE(b_next); } if (LD_) SLOAD(((j) + 2) * KVBLK); SBAR(); \
    CTL(j, MDX, SKX); qkt(X0, X1, K_lds + b_cur * SHM_K, qr, r32, hi, kx0, kx1, qx); \
    finishSM(Y0, Y1, ALY, l_reg, pa0, pa1, pa2, pa3); SBAR(); \
    partialSM(X0, X1, m_reg, ALX, MDX, SKX, dqh0 - (float)((j) * KVBLK), nc2); SBAR(); \
    pv_d0<true>(o, vb0 + b_prev * SHM_V, pa0, pa1, pa2, pa3, X0); \
    RESC(ALX); __syncthreads(); } while (0)
  __syncthreads();
  SLOAD(0); SWAIT(); SWRITE(0); SLOAD(KVBLK); __syncthreads();
  SWAIT(); SWRITE(1); if (2 < NT) SLOAD(2 * KVBLK);
  CTL(0, mdA, skA); qkt(pA0, pA1, K_lds, qr, r32, hi, kx0, kx1, qx); partialSM(pA0, pA1, m_reg, alA, mdA, skA, dqh0, nc2); expP0(pA0);
  __syncthreads();
  for (int j = 1; j + 1 < NT; j += 2) {
    STEP(j, pB0, pB1, pA0, pA1, mdB, skB, alB, alA, true, true); ROT();
    STEP(j + 1, pA0, pA1, pB0, pB1, mdA, skA, alA, alB, true, (j + 3 < NT)); ROT();
  }
  STEP(NT - 1, pB0, pB1, pA0, pA1, mdB, skB, alB, alA, false, false); ROT();
  finishSM(pB0, pB1, alB, l_reg, pa0, pa1, pa2, pa3); SBAR();
  pv_d0<false>(o, vb0 + b_prev * SHM_V, pa0, pa1, pa2, pa3, pB0);
  if (hi == 0) li_l[r32] = l_reg; asm volatile("s_waitcnt lgkmcnt(0)" ::: "memory");
#pragma unroll
  for (int r = 0; r < 16; ++r) { const float rli = __builtin_amdgcn_rcpf(li_l[crow(r, hi)]);
#pragma unroll
    for (int d0 = 0; d0 < 4; ++d0) o[d0][r] *= rli; }
#undef CTL
#undef STEP
#undef ROT
#undef SLOAD
#undef SWRITE
#undef SWAIT
#undef RESC
}
}

typedef unsigned short bf16;
typedef unsigned v4u __attribute__((ext_vector_type(4)));
typedef unsigned v2u __attribute__((ext_vector_type(2)));
typedef float f32x4 __attribute__((ext_vector_type(4)));
#define LAS __attribute__((address_space(3)))
constexpr int NWAVES = 8, NTHREADS = 512;
constexpr int D = 1024, FF = 4096, MG = 16384, MTOT = 32768;
constexpr int DEPTH = 4;
constexpr float QSCALE = 0.125f * 1.4426950408889634f;
constexpr size_t MiB = 1u << 20;
constexpr size_t WS_CTL = 0, WS_ZERO_END = 64 * 1024;
constexpr size_t WS_WMI = 2 * MiB, WS_WMO = 10 * MiB, WS_WQKV = 14 * MiB, WS_WAO = 26 * MiB, WS_W1 = 30 * MiB, WS_W2 = 62 * MiB;
constexpr size_t WS_XB = 94 * MiB, WS_BIG = 126 * MiB, WS_ROWSQ = 254 * MiB, WS_END = WS_ROWSQ + 9 * (size_t)MG * 64;
static_assert(WS_ZERO_END <= WS_WMI, "ws map");
constexpr int CW_ATTCTR = 0;
constexpr int CW_ARR = 8192;
constexpr int CW_BAR = 4096;
constexpr int CW_NRM = 1024;

struct Args {
    const float* in[19]; float* out; unsigned char* ws; int ph_lo, ph_hi;
};

__device__ __forceinline__ unsigned f2bf(float f) { unsigned u = __builtin_bit_cast(unsigned, f); return (u + 0x7fffu + ((u >> 16) & 1u)) >> 16; }
__device__ __forceinline__ unsigned pk2(float lo, float hi) { return f2bf(lo) | (f2bf(hi) << 16); }
__device__ __forceinline__ float bflo(unsigned w) { return __uint_as_float(w << 16); }
__device__ __forceinline__ float bfhi(unsigned w) { return __uint_as_float(w & 0xffff0000u); }
__device__ __forceinline__ float wave_sum(float v) {
    v += xor_lt32<1>(v); v += xor_lt32<2>(v); v += xor_lt32<4>(v); v += xor_lt32<8>(v); v += xor_lt32<16>(v);
    return sum_x32(v);
}

__device__ __forceinline__ void transpose_item(const float* W, int ldw, int N, const float* gs, bf16* WT, int ldk, int koff, LAS float* scr, int item, int lane) {
    const int nblk = N / 32, kb = item / nblk, nb = item % nblk, k0 = 64 * kb, n0 = 32 * nb;
#pragma unroll
    for (int i = 0; i < 8; ++i) { const int kk = 8 * i + (lane >> 3), c4 = (lane & 7) * 4;
        f32x4 v = *(const f32x4*)(W + (size_t)(k0 + kk) * ldw + n0 + c4); if (gs) v = v * gs[k0 + kk];
        scr[kk * 33 + c4] = v[0]; scr[kk * 33 + c4 + 1] = v[1]; scr[kk * 33 + c4 + 2] = v[2]; scr[kk * 33 + c4 + 3] = v[3]; }
    asm volatile("s_waitcnt lgkmcnt(0)" ::: "memory");
    const int c = lane & 7;
#pragma unroll
    for (int j = 0; j < 4; ++j) { const int n = (lane >> 3) + 8 * j; const LAS float* s = scr + (8 * c) * 33 + n;
        v4u o; o.x = pk2(s[0 * 33], s[1 * 33]); o.y = pk2(s[2 * 33], s[3 * 33]); o.z = pk2(s[4 * 33], s[5 * 33]); o.w = pk2(s[6 * 33], s[7 * 33]);
        *(v4u*)(WT + (size_t)(n0 + n) * ldk + koff + k0 + 8 * c) = o; }
    asm volatile("s_waitcnt lgkmcnt(0)" ::: "memory");
}

__device__ __forceinline__ void phase_prologue(const Args& a, LAS unsigned char* lds) {
    const int tid = mk_tid(), lane = tid & 63, wave = tid >> 6;
    const int gt = blockIdx.x * NTHREADS + tid, NGT = gridDim.x * NTHREADS;
    const int gw = blockIdx.x * NWAVES + wave, NGW = gridDim.x * NWAVES;
    { v4u z = {0u, 0u, 0u, 0u}; v4u* p = (v4u*)(a.ws + WS_CTL); for (int i = gt; i < (int)(WS_ZERO_END / 16); i += NGT) p[i] = z; }
    LAS float* scr = (LAS float*)(lds + wave * 16384);
    const float* norm1_g = a.in[2]; const float* norm2_g = a.in[3];
    constexpr int I_MI = 16 * 64, I_MO = 8 * 32, I_QKV = 16 * 96, I_AO = 16 * 32, I_W1 = 16 * 128, I_W2 = 64 * 32;
    constexpr int T_MI = 2 * I_MI, T_MO = T_MI + 2 * I_MO, T_QKV = T_MO + 2 * I_QKV, T_AO = T_QKV + 2 * I_AO, T_W1 = T_AO + 4 * I_W1, T_W2 = T_W1 + 4 * I_W2;
    for (int it = gw; it < T_W2; it += NGW) {
        if (it < T_MI) { const int j = it / I_MI, r = it % I_MI;
            transpose_item(a.in[5] + (size_t)j * D * 2048, 2048, 2048, norm1_g + (2 * j) * D, (bf16*)(a.ws + WS_WMI) + (size_t)j * 2048 * D, D, 0, scr, r, lane); }
        else if (it < T_MO) { const int q = it - T_MI, j = q / I_MO, r = q % I_MO;
            transpose_item(a.in[9] + (size_t)j * D * D + (size_t)512 * D, D, D, nullptr, (bf16*)(a.ws + WS_WMO) + (size_t)j * D * D, D, 512, scr, r, lane); }
        else if (it < T_QKV) { const int q = it - T_MO, j = q / I_QKV, r = q % I_QKV;
            transpose_item(a.in[10] + (size_t)j * D * 3072, 3072, 3072, norm1_g + (2 * j + 1) * D, (bf16*)(a.ws + WS_WQKV) + (size_t)j * 3072 * D, D, 0, scr, r, lane); }
        else if (it < T_AO) { const int q = it - T_QKV, j = q / I_AO, r = q % I_AO;
            transpose_item(a.in[11] + (size_t)j * D * D, D, D, nullptr, (bf16*)(a.ws + WS_WAO) + (size_t)j * D * D, D, 0, scr, r, lane); }
        else if (it < T_W1) { const int q = it - T_AO, i = q / I_W1, r = q % I_W1;
            transpose_item(a.in[17] + (size_t)i * D * FF, FF, FF, norm2_g + i * D, (bf16*)(a.ws + WS_W1) + (size_t)i * FF * D, D, 0, scr, r, lane); }
        else { const int q = it - T_W1, i = q / I_W2, r = q % I_W2;
            transpose_item(a.in[18] + (size_t)i * FF * D, D, D, nullptr, (bf16*)(a.ws + WS_W2) + (size_t)i * D * FF, FF, 0, scr, r, lane); }
    }
    for (int it = gw; it < 2 * 4 * 16 * 16; it += NGW) {
        const int cb = it & 15, nb = (it >> 4) & 15, g = (it >> 8) & 3, j = it >> 10;
        const float* pw = a.in[6] + ((size_t)(j * 4 + g) * 128 + cb * 8) * 128;
        const float* ps = a.in[7] + j * 512 + g * 128;
        const float* mo = a.in[9] + (size_t)j * D * D + (size_t)(g * 128) * D + nb * 64 + lane;
        float acc[8];
#pragma unroll
        for (int c = 0; c < 8; ++c) acc[c] = 0.f;
#pragma unroll 8
        for (int d = 0; d < 128; ++d) {
            const float m = mo[(size_t)d * D] * ps[d];
#pragma unroll
            for (int c = 0; c < 8; ++c) acc[c] = fmaf(pw[c * 128 + d], m, acc[c]);
        }
        v4u o; o.x = pk2(acc[0], acc[1]); o.y = pk2(acc[2], acc[3]); o.z = pk2(acc[4], acc[5]); o.w = pk2(acc[6], acc[7]);
        *(v4u*)((bf16*)(a.ws + WS_WMO) + (size_t)j * D * D + (size_t)(nb * 64 + lane) * D + g * 128 + cb * 8) = o;
    }
}

__device__ __forceinline__ void phase_prep(const Args& a, int g) {
    const int tid = mk_tid(), lane = tid & 63, gw = blockIdx.x * NWAVES + (tid >> 6), NGW = gridDim.x * NWAVES;
    const float* xin = g ? a.in[1] : a.in[0]; bf16* xb = (bf16*)(a.ws + WS_XB); float* rsq = (float*)(a.ws + WS_ROWSQ);
    for (int m = gw; m < MG; m += NGW) {
        const f32x4* xr = (const f32x4*)(xin + (size_t)m * D) + lane; v2u* brow = (v2u*)(xb + (size_t)m * D) + lane;
        float s = 0.f;
#pragma unroll
        for (int j = 0; j < 4; ++j) { const f32x4 v = xr[64 * j]; v2u w; w.x = pk2(v[0], v[1]); w.y = pk2(v[2], v[3]); brow[64 * j] = w;
            const float e0 = bflo(w.x), e1 = bfhi(w.x), e2 = bflo(w.y), e3 = bfhi(w.y); s += (e0 * e0 + e1 * e1) + (e2 * e2 + e3 * e3); }
        s = wave_sum(s);
        if (lane < 16) rsq[(size_t)m * 16 + lane] = lane == 0 ? s : 0.f;
    }
}
__device__ __forceinline__ void phase_final(const Args& a, int g) {
    const int tid = mk_tid(), lane = tid & 63, gw = blockIdx.x * NWAVES + (tid >> 6), NGW = gridDim.x * NWAVES;
    float* xo = a.out + (size_t)g * MG * D; const bf16* xb = (const bf16*)(a.ws + WS_XB);
    const float* rsq = (const float*)(a.ws + WS_ROWSQ) + (size_t)8 * MG * 16; const f32x4* fg = (const f32x4*)a.in[4] + lane;
    for (int m = gw; m < MG; m += NGW) {
        float rsum;
        { const f32x4* rp = (const f32x4*)(rsq + (size_t)m * 16); const f32x4 a0 = rp[0], a1 = rp[1], a2 = rp[2], a3 = rp[3];
          rsum = (((a0[0] + a0[1]) + (a0[2] + a0[3])) + ((a1[0] + a1[1]) + (a1[2] + a1[3]))) + (((a2[0] + a2[1]) + (a2[2] + a2[3])) + ((a3[0] + a3[1]) + (a3[2] + a3[3]))); }
        const float rs = __builtin_amdgcn_rsqf(rsum * (1.0f / 1024.0f) + 1e-6f);
        f32x4* orow = (f32x4*)(xo + (size_t)m * D) + lane; const v2u* brow = (const v2u*)(xb + (size_t)m * D) + lane;
#pragma unroll
        for (int j = 0; j < 4; ++j) { const v2u w = brow[64 * j]; const f32x4 gg = fg[64 * j]; f32x4 v = {bflo(w.x), bfhi(w.x), bflo(w.y), bfhi(w.y)}; v = v * rs * gg; orow[64 * j] = v; }
    }
}

__device__ __forceinline__ void unpack8(const v4u w, float (&f)[8]) {
    f[0] = bflo(w.x); f[1] = bfhi(w.x); f[2] = bflo(w.y); f[3] = bfhi(w.y); f[4] = bflo(w.z); f[5] = bfhi(w.z); f[6] = bflo(w.w); f[7] = bfhi(w.w);
}
template <int HW> __device__ __forceinline__ void stencil_pool(const bf16* P, bf16* A2, int b0, int S, int t0, int c0) {
    constexpr int NR = 8 + 2 * HW;
    const char* Ub = (const char*)(P + (size_t)b0 * 2048);
#pragma unroll 1
    for (int half = 0; half < 2; ++half) {
        const int tb0 = t0 + 8 * half;
        v4u raw[NR];
#pragma unroll
        for (int i = 0; i < NR; ++i) { const int t = tb0 - HW + i, tc = min(max(t, 0), S - 1); raw[i] = *(const v4u*)(Ub + (unsigned)(tc * 4096 + c0 * 2)); }
        float sum[8];
#pragma unroll
        for (int e = 0; e < 8; ++e) sum[e] = 0.f;
#pragma unroll
        for (int k = 0; k < 2 * HW; ++k) { const int t = tb0 - HW + k; float f[8]; unpack8(raw[k], f); const float mk = (t >= 0 && t < S) ? 1.f : 0.f;
#pragma unroll
            for (int e = 0; e < 8; ++e) sum[e] = fmaf(f[e], mk, sum[e]); }
#pragma unroll
        for (int i = 0; i < 8; ++i) {
            const int t = tb0 + i; const int lo = max(t - HW, 0), hi = min(t + HW, S);
            const float rc = 1.0f / (float)(hi - lo);
            float f[8]; unpack8(raw[i + HW], f);
            v4u o; o.x = pk2(sum[0] * rc - f[0], sum[1] * rc - f[1]); o.y = pk2(sum[2] * rc - f[2], sum[3] * rc - f[3]);
            o.z = pk2(sum[4] * rc - f[4], sum[5] * rc - f[5]); o.w = pk2(sum[6] * rc - f[6], sum[7] * rc - f[7]);
            *(v4u*)(A2 + (size_t)(b0 + t) * 1024 + c0) = o;
            if (i < 7) {
                float n[8], q[8]; unpack8(raw[i + 2 * HW], n); unpack8(raw[i], q);
                const float ma = (t + HW < S) ? 1.f : 0.f, ms = (t - HW >= 0) ? 1.f : 0.f;
#pragma unroll
                for (int e = 0; e < 8; ++e) sum[e] = fmaf(n[e], ma, sum[e]) - q[e] * ms;
            }
        }
    }
}
__device__ __forceinline__ void stencil_conv(const bf16* P, bf16* A2, const float* cw, int b0, int S, int t0, int c0) {
    const char* Pb = (const char*)(P + (size_t)b0 * 2048);
    float w0[8], w1[8], w2[8];
#pragma unroll
    for (int e = 0; e < 8; ++e) { w0[e] = cw[e]; w1[e] = cw[512 + e]; w2[e] = cw[1024 + e]; }
#pragma unroll 1
    for (int half = 0; half < 2; ++half) {
        const int tb0 = t0 + 8 * half;
        v4u rh[10], rcv[10], rg[8];
#pragma unroll
        for (int i = 0; i < 10; ++i) { const int t = tb0 - 1 + i, tc = min(max(t, 0), S - 1); rh[i] = *(const v4u*)(Pb + (unsigned)(tc * 4096 + (512 + c0) * 2)); rcv[i] = *(const v4u*)(Pb + (unsigned)(tc * 4096 + (1536 + c0) * 2)); }
#pragma unroll
        for (int i = 0; i < 8; ++i) rg[i] = *(const v4u*)(Pb + (unsigned)((tb0 + i) * 4096 + (1024 + c0) * 2));
        float zp[8], zc[8];
        { float hh[8], cc[8]; unpack8(rh[0], hh); unpack8(rcv[0], cc); const float mk = (tb0 - 1 >= 0) ? 1.f : 0.f;
#pragma unroll
          for (int e = 0; e < 8; ++e) zp[e] = hh[e] * cc[e] * mk; }
        { float hh[8], cc[8]; unpack8(rh[1], hh); unpack8(rcv[1], cc);
#pragma unroll
          for (int e = 0; e < 8; ++e) zc[e] = hh[e] * cc[e]; }
#pragma unroll
        for (int i = 0; i < 8; ++i) {
            const int t = tb0 + i; float zn[8];
            { float hh[8], cc[8]; unpack8(rh[i + 2], hh); unpack8(rcv[i + 2], cc); const float mk = (t + 1 < S) ? 1.f : 0.f;
#pragma unroll
              for (int e = 0; e < 8; ++e) zn[e] = hh[e] * cc[e] * mk; }
            float gb[8], r[8]; unpack8(rg[i], gb);
#pragma unroll
            for (int e = 0; e < 8; ++e) r[e] = gb[e] * (w0[e] * zp[e] + w1[e] * zc[e] + w2[e] * zn[e]);
            v4u o; o.x = pk2(r[0], r[1]); o.y = pk2(r[2], r[3]); o.z = pk2(r[4], r[5]); o.w = pk2(r[6], r[7]);
            *(v4u*)(A2 + (size_t)(b0 + t) * 1024 + 512 + c0) = o;
#pragma unroll
            for (int e = 0; e < 8; ++e) { zp[e] = zc[e]; zc[e] = zn[e]; }
        }
    }
}
__device__ __forceinline__ void phase_stencil(const Args& a, int g, int j) {
    const int S = g ? 16384 : 8192;
    const bf16* P = (const bf16*)(a.ws + WS_BIG); bf16* A2 = (bf16*)(a.ws + WS_BIG + 64 * MiB);
    const int tid = mk_tid(), lane = tid & 63, wave = __builtin_amdgcn_readfirstlane(tid >> 6);
    for (int tile = blockIdx.x; tile < MG / 64; tile += gridDim.x) {
        if (wave < 4) {
            const int b0 = (tile * 64) & ~(S - 1), t0 = ((tile * 64) & (S - 1)) + (lane >> 4) * 16, c0 = (wave * 16 + (lane & 15)) * 8;
            if (wave == 0) stencil_pool<1>(P, A2, b0, S, t0, c0);
            else if (wave == 1) stencil_pool<2>(P, A2, b0, S, t0, c0);
            else if (wave == 2) stencil_pool<4>(P, A2, b0, S, t0, c0);
            else stencil_pool<8>(P, A2, b0, S, t0, c0);
        } else {
            const int b0 = (tile * 64) & ~(S - 1), t0 = ((tile * 64) & (S - 1)) + (wave - 4) * 16, c0 = lane * 8;
            stencil_conv(P, A2, a.in[8] + (size_t)j * 3 * 512 + c0, b0, S, t0, c0);
        }
    }
}

__device__ __forceinline__ void phase_attention(const Args& a, int g, int layer, char* lds) {
    using namespace att;
    const int S = g ? 16384 : 8192, logS = g ? 14 : 13; const int j = layer >> 1;
    const bf16* Qb = (const bf16*)(a.ws + WS_BIG); const bf16* Kb = Qb + (size_t)MG * 1024; const bf16* Vb = Kb + (size_t)MG * 1024; bf16* Ob = (bf16*)(a.ws + WS_BIG);
    unsigned* ctr = (unsigned*)(a.ws + WS_CTL) + CW_ATTCTR + 64 * (g * 2 + j);
    unsigned* arr = (unsigned*)(a.ws + WS_CTL) + CW_ARR + 1024 * (g * 2 + j);
    const unsigned* nrm = (const unsigned*)(a.ws + WS_CTL) + CW_NRM + 256 * (g * 2 + j);
    volatile unsigned* s_unit = (volatile unsigned*)(lds + OFF_UNIT);
    const float lambda_init = (layer == 1) ? 0.35550906759096926f : 0.5560582041556405f;
    float lam;
    { const float* q1 = a.in[12] + j * 64; const float* k1 = a.in[13] + j * 64; const float* q2 = a.in[14] + j * 64; const float* k2 = a.in[15] + j * 64;
      const int lane = mk_tid() & 63; float s1 = q1[lane] * k1[lane], s2 = q2[lane] * k2[lane]; s1 = wave_sum(s1); s2 = wave_sum(s2); lam = __expf(s1) - __expf(s2) + lambda_init; }
    const float* subg = a.in[16] + j * 128;
    for (;;) {
        const int tid = mk_tid(), wid = tid >> 6, lane = tid & 63, r32 = lane & 31, hi = lane >> 5;
        __syncthreads();
        if (tid == 0) s_unit[0] = atomicAdd(ctr, 1u);
        __syncthreads();
        const int tk = (int)s_unit[0];
        if (tk >= 1024 * MK_DUP_ATT) break;
        const int u = tk / MK_DUP_ATT; const bool dup = (tk % MK_DUP_ATT) != 0;
        const int h = 7 - (u >> 7), qbi = (u >> 1) & 63, pass = u & 1, uid = u >> 1;
        const int b = (qbi * 256) >> logS, q0 = (qbi * 256) & (S - 1);
        const size_t rowbase = (size_t)b * S;
        const float slope2 = __builtin_amdgcn_exp2f(-(float)(h + 1)) * 1.4426950408889634f;
        const int qpos = q0 + wid * QBLK + r32;
        f32x16 o[4];
        {
            const int map = 2 * h + pass;
            int klo = 0, khi = S; float smax;
            { const unsigned* nq = nrm + ((0 * 2 + b) * 16 + map) * 2; const unsigned* nk = nrm + ((1 * 2 + b) * 16 + map) * 2;
              const float qn2 = __uint_as_float(__hip_atomic_load(nq, __ATOMIC_RELAXED, __HIP_MEMORY_SCOPE_AGENT)) + __uint_as_float(__hip_atomic_load(nq + 1, __ATOMIC_RELAXED, __HIP_MEMORY_SCOPE_AGENT));
              const float kn2 = __uint_as_float(__hip_atomic_load(nk, __ATOMIC_RELAXED, __HIP_MEMORY_SCOPE_AGENT)) + __uint_as_float(__hip_atomic_load(nk + 1, __ATOMIC_RELAXED, __HIP_MEMORY_SCOPE_AGENT));
              smax = sqrtf(qn2 * kn2) * 1.02f;
#if MK_WINDOW
              float sown;
              { const bf16* qp = Qb + (rowbase + q0 + wid * QBLK + r32) * 1024 + map * 64 + hi * 32; const bf16* kp = Kb + (rowbase + q0 + wid * QBLK + r32) * 1024 + map * 64 + hi * 32;
                float acc = 0.f, qq = 0.f;
#pragma unroll
                for (int c = 0; c < 4; ++c) { const v4u qa = *(const v4u*)(qp + c * 8), ka = *(const v4u*)(kp + c * 8);
                    acc += bflo(qa.x) * bflo(ka.x) + bfhi(qa.x) * bfhi(ka.x) + bflo(qa.y) * bflo(ka.y) + bfhi(qa.y) * bfhi(ka.y)
                         + bflo(qa.z) * bflo(ka.z) + bfhi(qa.z) * bfhi(ka.z) + bflo(qa.w) * bflo(ka.w) + bfhi(qa.w) * bfhi(ka.w);
                    qq += bflo(qa.x) * bflo(qa.x) + bfhi(qa.x) * bfhi(qa.x) + bflo(qa.y) * bflo(qa.y) + bfhi(qa.y) * bfhi(qa.y)
                        + bflo(qa.z) * bflo(qa.z) + bfhi(qa.z) * bfhi(qa.z) + bflo(qa.w) * bflo(qa.w) + bfhi(qa.w) * bfhi(qa.w); }
                acc = sum_x32(acc); qq = sum_x32(qq);
                acc = fminf(acc, xor_lt32<1>(acc)); acc = fminf(acc, xor_lt32<2>(acc)); acc = fminf(acc, xor_lt32<4>(acc)); acc = fminf(acc, xor_lt32<8>(acc)); acc = fminf(acc, xor_lt32<16>(acc));
                qq = fmaxf(qq, xor_lt32<1>(qq)); qq = fmaxf(qq, xor_lt32<2>(qq)); qq = fmaxf(qq, xor_lt32<4>(qq)); qq = fmaxf(qq, xor_lt32<8>(qq)); qq = fmaxf(qq, xor_lt32<16>(qq));
                float* wmin = (float*)(lds + OFF_UNIT) + 8;
                if (lane == 0) { wmin[wid] = acc; wmin[8 + wid] = qq; }
                __syncthreads();
                sown = fminf(fminf(fminf(wmin[0], wmin[1]), fminf(wmin[2], wmin[3])), fminf(fminf(wmin[4], wmin[5]), fminf(wmin[6], wmin[7])));
                sown = fminf(sown, 0.f) - 0.25f;
                const float qu2 = fmaxf(fmaxf(fmaxf(wmin[8], wmin[9]), fmaxf(wmin[10], wmin[11])), fmaxf(fmaxf(wmin[12], wmin[13]), fmaxf(wmin[14], wmin[15])));
                smax = fminf(smax, sqrtf(qu2 * kn2) * 1.02f);
              }
              const float wf = (smax - sown + 24.f) / slope2;
              const int wi = (wf < (float)S) ? (int)wf + 1 : S;
              klo = max(q0 - wi, 0) & ~127; khi = min((q0 + 256 + wi + 127) & ~127, S);
#endif
            }
            const int NT = (khi - klo) >> 6;
            const bf16* Qw = Qb + (rowbase + q0 + wid * QBLK + r32) * 1024 + map * 64 + hi * 8;
            const bf16* Kh = Kb + (rowbase + klo) * 1024 + map * 64;
            const bf16* Vh = Vb + (rowbase + klo) * 1024 + h * 128;
            attn_pass(Qw, Kh, Vh, NT, (float)(qpos - klo), klo - (q0 + __builtin_amdgcn_readfirstlane(wid) * QBLK), -slope2, smax, o, lds);
        }
        if (dup) continue;
        const int t2 = mk_tid(); const int r32b = t2 & 31, hib = (t2 >> 5) & 1, widb = t2 >> 6;
        if (t2 == 0) s_unit[1] = atomicAdd(arr + 2 * uid, 1u);
        __syncthreads();
        const unsigned first = s_unit[1];
        f32x4* sp = (f32x4*)(a.out + (size_t)g * MG * D + (size_t)uid * 32768) + t2;
        if (first == 0u) {
#pragma unroll
            for (int d0 = 0; d0 < 4; ++d0)
#pragma unroll
                for (int q = 0; q < 4; ++q) {
                    const f32x4 w = {o[d0][4 * q], o[d0][4 * q + 1], o[d0][4 * q + 2], o[d0][4 * q + 3]};
                    asm volatile("global_store_dwordx4 %0, %1, off sc1" :: "v"(sp + (d0 * 4 + q) * 512), "v"(w) : "memory");
                }
            asm volatile("s_waitcnt vmcnt(0)" ::: "memory");
            __syncthreads();
            if (t2 == 0) __hip_atomic_store(arr + 2 * uid + 1, 1u, __ATOMIC_RELAXED, __HIP_MEMORY_SCOPE_AGENT);
            continue;
        }
        if (t2 == 0) { unsigned spn = 0; while (__hip_atomic_load(arr + 2 * uid + 1, __ATOMIC_RELAXED, __HIP_MEMORY_SCOPE_AGENT) == 0u) { __builtin_amdgcn_s_sleep(2); if (++spn > (1u << 24)) break; } }
        __syncthreads();
        float ssq[16];
#pragma unroll
        for (int r = 0; r < 16; ++r) ssq[r] = 0.f;
        f32x4 w[16];
#pragma unroll
        for (int i = 0; i < 16; ++i) asm volatile("global_load_dwordx4 %0, %1, off sc1" : "=v"(w[i]) : "v"(sp + i * 512) : "memory");
        asm volatile("s_waitcnt vmcnt(0)" : "+v"(w[0]), "+v"(w[1]), "+v"(w[2]), "+v"(w[3]), "+v"(w[4]), "+v"(w[5]), "+v"(w[6]), "+v"(w[7]),
                                             "+v"(w[8]), "+v"(w[9]), "+v"(w[10]), "+v"(w[11]), "+v"(w[12]), "+v"(w[13]), "+v"(w[14]), "+v"(w[15]) :: "memory");
#pragma unroll
        for (int d0 = 0; d0 < 4; ++d0)
#pragma unroll
            for (int q = 0; q < 4; ++q) {
#pragma unroll
                for (int e = 0; e < 4; ++e) { const int r = 4 * q + e; const float t = w[d0 * 4 + q][e]; const float v = pass ? (t - lam * o[d0][r]) : (o[d0][r] - lam * t);
                    o[d0][r] = v; ssq[r] = fmaf(v, v, ssq[r]); } }
#pragma unroll
        for (int r = 0; r < 16; ++r) {
            float s = ssq[r];
            s += xor_lt32<1>(s); s += xor_lt32<2>(s); s += xor_lt32<4>(s); s += xor_lt32<8>(s); s += xor_lt32<16>(s);
            ssq[r] = __builtin_amdgcn_rsqf(s * (1.0f / 128.0f) + 1e-5f) * (1.0f - lambda_init);
        }
        bf16* Ow = Ob + (rowbase + q0 + widb * QBLK + 4 * hib) * 1024 + h * 128 + r32b;
#pragma unroll
        for (int d0 = 0; d0 < 4; ++d0) { const float gg = subg[d0 * 32 + r32b];
#pragma unroll
            for (int r = 0; r < 16; ++r) Ow[(size_t)crow(r, 0) * 1024 + d0 * 32] = (bf16)f2bf(o[d0][r] * ssq[r] * gg); }
    }
}


#define XB_TMO      128
#define XB_XCNT(j)  (256  + 64 * (j))
#define XB_XSUB(j)  (1280 + 64 * (j))
#define XB_XGEN(j)  (2304 + 64 * (j))
#define XB_TOP      3328
#define XB_TOPGEN   3392
#define XCD_BAR_WORDS 3456
#define XB_SPIN_CAP (1u << 22)
__device__ __forceinline__ unsigned xb_ld(unsigned* p)              { return __hip_atomic_load(p, __ATOMIC_RELAXED, __HIP_MEMORY_SCOPE_AGENT); }
__device__ __forceinline__ unsigned xb_add(unsigned* p, unsigned v) { return __hip_atomic_fetch_add(p, v, __ATOMIC_RELAXED, __HIP_MEMORY_SCOPE_AGENT); }
__device__ __forceinline__ unsigned xb_xcc_id() { return (unsigned)__builtin_amdgcn_s_getreg((3 << 11) | 20) & 0xFu; }
#define XB_SPIN(cond, bar) do { unsigned _sp = 0; while (cond) { __builtin_amdgcn_s_sleep(1); \
    if ((++_sp & 255u) == 0u) { if (xb_ld(&(bar)[XB_TMO])) break; if (_sp > XB_SPIN_CAP) { atomicAdd(&(bar)[XB_TMO], 1u); break; } } } } while (0)
struct XcdBarrier { unsigned* bar; unsigned x; volatile LAS unsigned* st; };
__device__ __forceinline__ XcdBarrier xcd_barrier_post(unsigned* bar, volatile LAS unsigned* st) {
    XcdBarrier b; b.bar = bar; b.x = xb_xcc_id(); b.st = st;
    if (mk_tid() == 0) (void)xb_add(&bar[XB_XCNT(b.x)], 1u);
    return b;
}
__device__ __forceinline__ void xcd_barrier_complete(unsigned* bar, unsigned x, unsigned& nloc, unsigned& nx) {
    const unsigned G = gridDim.x * gridDim.y * gridDim.z;
    unsigned sum, cnt, mine, sp = 0u;
    for (;;) {
        sum = 0u; cnt = 0u; mine = 0u;
#pragma unroll
        for (unsigned j = 0; j < 16; ++j) { const unsigned c = xb_ld(&bar[XB_XCNT(j)]); sum += c; cnt += (c > 0u) ? 1u : 0u; mine = (j == x) ? c : mine; }
        if (sum == G) break;
        __builtin_amdgcn_s_sleep(1);
        if ((++sp & 255u) == 0u) { if (xb_ld(&bar[XB_TMO])) break; if (sp > XB_SPIN_CAP) { atomicAdd(&bar[XB_TMO], 1u); break; } }
    }
    nloc = mine > 0u ? mine : 1u; nx = cnt > 0u ? cnt : 1u;
}
__device__ __forceinline__ void xcd_barrier(const XcdBarrier& b) {
    asm volatile("s_waitcnt vmcnt(0)" ::: "memory");
    __syncthreads();
    if (mk_tid() == 0) {
        unsigned* bar = b.bar;
        __builtin_amdgcn_s_waitcnt(0);
        unsigned nloc = b.st[0], nx = b.st[1];
        if (nloc == 0u) { xcd_barrier_complete(bar, b.x, nloc, nx); b.st[0] = nloc; b.st[1] = nx; }
        const unsigned old = xb_add(&bar[XB_XSUB(b.x)], 1u);
        const unsigned gen = old / nloc;
        if (old + 1u == (gen + 1u) * nloc) {
            __builtin_amdgcn_fence(__ATOMIC_RELEASE, "agent");
            asm volatile("s_waitcnt vmcnt(0)" ::: "memory");
            const unsigned og = xb_add(&bar[XB_TOP], 1u);
            const unsigned tg = og / nx;
            if (og + 1u == (tg + 1u) * nx) xb_add(&bar[XB_TOPGEN], 1u);
            else XB_SPIN(xb_ld(&bar[XB_TOPGEN]) == tg, bar);
            __builtin_amdgcn_fence(__ATOMIC_ACQUIRE, "agent");
            xb_add(&bar[XB_XGEN(b.x)], 1u);
            asm volatile("s_waitcnt vmcnt(0)" ::: "memory");
        } else {
            XB_SPIN(xb_ld(&bar[XB_XGEN(b.x)]) == gen, bar);
            __builtin_amdgcn_fence(__ATOMIC_ACQUIRE, "agent");
            asm volatile("s_waitcnt vmcnt(0)" ::: "memory");
        }
    }
    __syncthreads();
}

constexpr int LDS_BYTES = 147456;
constexpr int N_PHASES = 1 + 2 * (4 * 5 + 1);
#ifndef MK_MASK
#define MK_MASK 0xFFFF
#endif
#define EN(k) ((MK_MASK >> (k)) & 1)

__global__ void __launch_bounds__(NTHREADS, 2) fwd_megakernel(Args args) {
    extern __shared__ __attribute__((aligned(16))) unsigned char lds[];
    cg::grid_group grid = cg::this_grid();
    const int lo = args.ph_lo, hi = args.ph_hi;
    int ph = 0;
#define RUN() (ph >= lo && ph < hi)
#if MK_PROBE
    unsigned long long t_last = __builtin_amdgcn_s_memrealtime(), t_a = 0, t_b = 0;
#define SEAMK(k) do { if (ph >= lo && ph + 1 < hi) grid.sync(); ++ph; { const unsigned long long t_now = __builtin_amdgcn_s_memrealtime(); \
        if ((MK_PROBE_A >> (k)) & 1) t_a += t_now - t_last; if ((MK_PROBE_B >> (k)) & 1) t_b += t_now - t_last; t_last = t_now; } } while (0)
#else
#define SEAMK(k) do { if (ph >= lo && ph + 1 < hi) { if (ph == 0) { grid.sync(); xbar = xcd_barrier_post((unsigned*)(ws + WS_CTL) + CW_BAR, xst); } else xcd_barrier(xbar); } ++ph; } while (0)
#endif
#define SEAM() SEAMK(0)
    unsigned char* ws = args.ws;
    volatile LAS unsigned* xst = (volatile LAS unsigned*)((LAS unsigned char*)lds + 131072 + 256);
    if (mk_tid() == 0) { xst[0] = 0u; xst[1] = 0u; }
    __syncthreads();
    XcdBarrier xbar; xbar.bar = (unsigned*)(ws + WS_CTL) + CW_BAR; xbar.x = 0; xbar.st = xst;
    PG8_LAS unsigned char* glds = (PG8_LAS unsigned char*)lds;
    const int G = gridDim.x, c = blockIdx.x;

    if (EN(0) && RUN()) { _Pragma("unroll 1") for (int rep = 0; rep < 1 + (MK_DUP_MISC & 1); ++rep) { phase_prologue(args, (LAS unsigned char*)lds); __syncthreads(); }
                          phase_prep(args, 0); }
    SEAMK(1);
#pragma unroll 1
    for (int g = 0; g < 2; ++g) {
        bf16* XB = (bf16*)(ws + WS_XB);
        float* rsq_base = (float*)(ws + WS_ROWSQ);
#pragma unroll 1
        for (int i = 0; i < DEPTH; ++i) {
            const int j = i >> 1;
            float* rsq_n1 = rsq_base + (size_t)(2 * i) * MG * 16; float* rsq_n2 = rsq_base + (size_t)(2 * i + 1) * MG * 16; float* rsq_nx = rsq_base + (size_t)(2 * i + 2) * MG * 16;
            if ((i & 1) == 0) {
                if (EN(2) && RUN()) {
                    pg8::Gemm gm{XB, (const bf16*)(ws + WS_WMI) + (size_t)j * 2048 * D, MG, 2048, D}; pg8::StaticOrder S; S.init(MG, 2048, G, c);
                    pg8::EpiProj<0> E{(bf16*)(ws + WS_BIG), 2048, rsq_n1, 0, 1.f, nullptr, 0, (PG8_LAS float*)(glds + 131072 + 1024)};
                    _Pragma("unroll 1") for (int rep = 0; rep < MK_DUP; ++rep) pg8::gemm_phase<pg8::EpiProj<0>, pg8::StaticOrder, true, true>(glds, gm, S, E);
                }
                SEAMK(3);
                if (EN(3) && RUN()) { _Pragma("unroll 1") for (int rep = 0; rep < 1 + ((MK_DUP_MISC >> 2) & 1); ++rep) phase_stencil(args, g, j); }
                SEAMK(4);
                if (EN(4) && RUN()) {
                    pg8::Gemm gm{(const bf16*)(ws + WS_BIG + 64 * MiB), (const bf16*)(ws + WS_WMO) + (size_t)j * D * D, MG, D, D}; pg8::StaticOrder S; S.init(MG, D, G, c);
                    pg8::EpiRes E{XB, rsq_n2, 0};
                    if (MK_DUP_RES == 1) { pg8::EpiNull E0; pg8::gemm_phase<pg8::EpiNull, pg8::StaticOrder, true, true>(glds, gm, S, E0); }
                    if (MK_DUP_RES == 2) { pg8::EpiRes E0 = E; E0.dry = 1; pg8::gemm_phase<pg8::EpiRes, pg8::StaticOrder, true, true>(glds, gm, S, E0); }
                    pg8::gemm_phase<pg8::EpiRes, pg8::StaticOrder, true, true>(glds, gm, S, E);
                }
                SEAMK(5);
            } else {
                if (EN(5) && RUN()) {
                    pg8::Gemm gm{XB, (const bf16*)(ws + WS_WQKV) + (size_t)j * 3072 * D, MG, 3072, D}; pg8::StaticOrder S; S.init(MG, 3072, G, c);
                    pg8::EpiProj<1> E{(bf16*)(ws + WS_BIG), 1024, rsq_n1, (size_t)MG * 1024, QSCALE, (unsigned*)(ws + WS_CTL) + CW_NRM + 256 * (g * 2 + j), g ? 14 : 13, (PG8_LAS float*)(glds + 131072 + 1024)};
                    _Pragma("unroll 1") for (int rep = 0; rep < MK_DUP; ++rep) pg8::gemm_phase<pg8::EpiProj<1>, pg8::StaticOrder, true, true>(glds, gm, S, E);
                }
                SEAMK(6);
                if (EN(6) && RUN()) phase_attention(args, g, i, (char*)lds);
                SEAMK(7);
                if (EN(7) && RUN()) {
                    pg8::Gemm gm{(const bf16*)(ws + WS_BIG), (const bf16*)(ws + WS_WAO) + (size_t)j * D * D, MG, D, D}; pg8::StaticOrder S; S.init(MG, D, G, c);
                    pg8::EpiRes E{XB, rsq_n2, 0};
                    if (MK_DUP_RES == 1) { pg8::EpiNull E0; pg8::gemm_phase<pg8::EpiNull, pg8::StaticOrder, true, true>(glds, gm, S, E0); }
                    if (MK_DUP_RES == 2) { pg8::EpiRes E0 = E; E0.dry = 1; pg8::gemm_phase<pg8::EpiRes, pg8::StaticOrder, true, true>(glds, gm, S, E0); }
                    pg8::gemm_phase<pg8::EpiRes, pg8::StaticOrder, true, true>(glds, gm, S, E);
                }
                SEAMK(8);
            }
            if (EN(8) && RUN()) {
                pg8::Gemm gm{XB, (const bf16*)(ws + WS_W1) + (size_t)i * FF * D, MG, FF, D}; pg8::StaticOrder S; S.init(MG, FF, G, c);
                pg8::EpiProj<2> E{(bf16*)(ws + WS_BIG), FF, rsq_n2, 0, 1.f, nullptr, 0, (PG8_LAS float*)(glds + 131072 + 1024)};
                _Pragma("unroll 1") for (int rep = 0; rep < MK_DUP; ++rep) pg8::gemm_phase<pg8::EpiProj<2>, pg8::StaticOrder, true, true>(glds, gm, S, E);
            }
            SEAMK(9);
            if (EN(9) && RUN()) {
                pg8::Gemm gm{(const bf16*)(ws + WS_BIG), (const bf16*)(ws + WS_W2) + (size_t)i * D * FF, MG, D, FF}; pg8::StaticOrder S; S.init(MG, D, G, c);
                pg8::EpiRes E{XB, rsq_nx, 0};
                if (MK_DUP_RES == 1) { pg8::EpiNull E0; pg8::gemm_phase<pg8::EpiNull, pg8::StaticOrder, true, true>(glds, gm, S, E0); }
                    if (MK_DUP_RES == 2) { pg8::EpiRes E0 = E; E0.dry = 1; pg8::gemm_phase<pg8::EpiRes, pg8::StaticOrder, true, true>(glds, gm, S, E0); }
                    pg8::gemm_phase<pg8::EpiRes, pg8::StaticOrder, true, true>(glds, gm, S, E);
            }
            SEAMK(10);
        }
        if (EN(10) && RUN()) { phase_final(args, g); if (g == 0) phase_prep(args, 1); }
        SEAMK(11);
    }
#if MK_PROBE
    if (blockIdx.x == 0 && (mk_tid() >> 6) == 0) {
        const float da = (float)t_a * 1e-5f / 1.5f, db = (float)t_b * 1e-5f;
        for (int g = 0; g < 2; ++g) { float* r0 = args.out + (size_t)g * MG * D; const int lane = mk_tid() & 63;
            for (int q = 0; q < 16; ++q) r0[q * 64 + lane] += da;
            if (lane == 0) r0[(size_t)2048 * D] += db; }
    }
#endif
#undef RUN
#undef SEAM
}

extern "C" void kernel_launch(void* const* d_in, const int* in_sizes, int n_in, void* d_out, int out_size, void* d_ws, size_t ws_size, hipStream_t stream) {
    static int grid = 0;
    if (grid == 0) {
        if (n_in != 19 || in_sizes[0] != MG * D || in_sizes[1] != MG * D || out_size != MTOT * D || ws_size < WS_END) {
            fprintf(stderr, "kernel_launch: unexpected shapes: n_in %d in0 %d in1 %d out %d ws %zu (need %zu); nothing launched\n", n_in, n_in > 0 ? in_sizes[0] : -1, n_in > 1 ? in_sizes[1] : -1, out_size, ws_size, (size_t)WS_END);
            grid = -1; return; }
        int dev = 0, cus = 0, per_cu = 0;
        hipGetDevice(&dev);
        hipDeviceGetAttribute(&cus, hipDeviceAttributeMultiprocessorCount, dev);
        if (hipFuncSetAttribute((const void*)fwd_megakernel, hipFuncAttributeMaxDynamicSharedMemorySize, LDS_BYTES) != hipSuccess) { fprintf(stderr, "kernel_launch: hipFuncSetAttribute failed\n"); grid = -1; return; }
        if (hipOccupancyMaxActiveBlocksPerMultiprocessor(&per_cu, (const void*)fwd_megakernel, NTHREADS, LDS_BYTES) != hipSuccess || per_cu < 1) { fprintf(stderr, "kernel_launch: occupancy query failed (%d)\n", per_cu); per_cu = 1; }
        (void)hipGetLastError();
        grid = cus * per_cu;
        if (grid > 256) grid = 256;
    }
    if (grid < 0) return;
    Args a{};
    for (int i = 0; i < 19; ++i) a.in[i] = (const float*)d_in[i];
    a.out = (float*)d_out; a.ws = (unsigned char*)d_ws;
#if MK_PER_PHASE
    for (int p = 0; p < N_PHASES; ++p) {
        a.ph_lo = p; a.ph_hi = p + 1;
        void* kargs[] = {&a};
        hipError_t e = hipLaunchCooperativeKernel((const void*)fwd_megakernel, dim3(grid), dim3(NTHREADS), kargs, LDS_BYTES, stream);
        if (e != hipSuccess) { fprintf(stderr, "kernel_launch: cooperative launch %d failed: %s\n", p, hipGetErrorString(e)); break; }
    }
#else
    a.ph_lo = 0; a.ph_hi = N_PHASES;
    void* kargs[] = {&a};
    hipError_t e = hipLaunchCooperativeKernel((const void*)fwd_megakernel, dim3(grid), dim3(NTHREADS), kargs, LDS_BYTES, stream);
    if (e != hipSuccess) fprintf(stderr, "kernel_launch: cooperative launch failed: %s (grid %d)\n", hipGetErrorString(e), grid);
#endif
}
```
